# Optimizing an MI355X kernel written in HIP

```python
import jax, jax.numpy as jnp
from jax import lax
import numpy as np

D_MODEL = 1024
BATCH = 8
SEQ = 2048
DEPTH = 1

GRID_W = 64
CTX_LEN = 256
HEAD_DIM = 128
N_Q_HEADS = D_MODEL // HEAD_DIM
N_KV_HEADS = N_Q_HEADS // 4
GQA_GROUP = N_Q_HEADS // N_KV_HEADS
Q_WIDTH = N_Q_HEADS * HEAD_DIM
KV_WIDTH = N_KV_HEADS * HEAD_DIM
FOURIER_GROUP = 128
N_FOURIER_GROUPS = 4
FOURIER_WIDTH = N_FOURIER_GROUPS * FOURIER_GROUP
N_BRANCHES = 2
IN_WIDTH = Q_WIDTH + 2 * KV_WIDTH + FOURIER_WIDTH + N_BRANCHES * D_MODEL
D_FF = 2816
Q_BLOCK = 128
AXIS_ROPE_DIM = HEAD_DIM // 2
ROPE_THETA = 10000.0
EPS = 1e-6
N_MOD = 9
ATTN_SCALE = HEAD_DIM ** -0.5

kernel_name = 'hybrid_gqa_fourier_macaron_dit_layer'


def _rmsnorm(t, g):
    t32 = t.astype(jnp.float32)
    r = t32 * lax.rsqrt(jnp.mean(t32 * t32, axis=-1, keepdims=True) + EPS)
    return (r * g.astype(jnp.float32)).astype(t.dtype)


def _modulate(h, shift, scale):
    return h * (1.0 + scale) + shift


def _adaln(cond, w, b):
    return jax.nn.silu(cond) @ w + b


def _swiglu(h, w_in, w_out):
    gate, up = jnp.split(h @ w_in, 2, axis=-1)
    return (jax.nn.silu(gate) * up) @ w_out


def _axial_rope_tables(n_tokens, dtype):
    rows = n_tokens // GRID_W
    row_ids = jnp.repeat(jnp.arange(rows, dtype=jnp.float32), GRID_W)
    col_ids = jnp.tile(jnp.arange(GRID_W, dtype=jnp.float32), rows)
    inv_freq = ROPE_THETA ** (-jnp.arange(0, AXIS_ROPE_DIM, 2, dtype=jnp.float32) / AXIS_ROPE_DIM)
    ang = jnp.concatenate([row_ids[:, None] * inv_freq, col_ids[:, None] * inv_freq], axis=-1)
    return jnp.cos(ang).astype(dtype), jnp.sin(ang).astype(dtype)


def _apply_rope(t, cos, sin):
    t1, t2 = t[..., :AXIS_ROPE_DIM], t[..., AXIS_ROPE_DIM:]
    c, s = cos[None, :, None, :], sin[None, :, None, :]
    return jnp.concatenate([t1 * c - t2 * s, t2 * c + t1 * s], axis=-1)


def _heads_norm(t, n_heads, g):
    b, n = t.shape[:2]
    return _rmsnorm(t.reshape(b, n, n_heads, HEAD_DIM), g)


def _split_in(p):
    q, k, v, f, ga, gf = jnp.split(
        p,
        [Q_WIDTH, Q_WIDTH + KV_WIDTH, Q_WIDTH + 2 * KV_WIDTH,
         Q_WIDTH + 2 * KV_WIDTH + FOURIER_WIDTH,
         Q_WIDTH + 2 * KV_WIDTH + FOURIER_WIDTH + D_MODEL],
        axis=-1)
    return q, k, v, f, ga, gf


def _attend(q, k, v):
    s = jnp.einsum('bqkgd,bskd->bkgqs', q, k).astype(jnp.float32) * ATTN_SCALE
    p = jax.nn.softmax(s, axis=-1).astype(v.dtype)
    return jnp.einsum('bkgqs,bskd->bqkgd', p, v)


def _latent_attention(q, k, v, k_c, v_c):
    b, n = q.shape[:2]
    k_all = jnp.concatenate([k_c, k], axis=1)
    v_all = jnp.concatenate([v_c, v], axis=1)
    n_blk = n // Q_BLOCK
    qb = q.reshape(b, n_blk, Q_BLOCK, N_KV_HEADS, GQA_GROUP, HEAD_DIM)
    qb = jnp.moveaxis(qb, 1, 0)
    out = lax.map(lambda qblk: _attend(qblk, k_all, v_all), qb)
    return jnp.moveaxis(out, 0, 1).reshape(b, n, Q_WIDTH)


def _context_attention(q_c, k_c, v_c):
    b, n = q_c.shape[:2]
    qg = q_c.reshape(b, n, N_KV_HEADS, GQA_GROUP, HEAD_DIM)
    return _attend(qg, k_c, v_c).reshape(b, n, Q_WIDTH)


def _fourier_mix(f):
    b, n = f.shape[:2]
    fg = f.reshape(b, n, N_FOURIER_GROUPS, FOURIER_GROUP).astype(jnp.float32)
    y = jnp.fft.fft2(fg, axes=(1, 3), norm='ortho').real
    return y.reshape(b, n, FOURIER_WIDTH).astype(f.dtype)


def _merge(y_attn, y_four, ga, gf, w_ab, w_fb, w_o):
    merged = jax.nn.sigmoid(ga) * (y_attn @ w_ab) + jax.nn.sigmoid(gf) * (y_four @ w_fb)
    return merged @ w_o


def setup_inputs(seed: int = 0) -> dict:
    key = jax.random.key(seed)
    ks = jax.random.split(key, 20)
    L = DEPTH

    def w(k, shape, fan_in):
        return jax.random.normal(k, shape, jnp.float32) * fan_in ** -0.5

    def gain(k, shape):
        return 1.0 + 0.05 * jax.random.normal(k, shape, jnp.float32)

    return {
        'x': jax.random.normal(ks[0], (BATCH, SEQ, D_MODEL), jnp.float32),
        'c': jax.random.normal(ks[1], (BATCH, D_MODEL), jnp.float32),
        'ctx': jax.random.normal(ks[2], (BATCH, CTX_LEN, D_MODEL), jnp.float32),
        'c_ctx': jax.random.normal(ks[3], (D_MODEL,), jnp.float32),
        'w_ada': w(ks[4], (L, D_MODEL, N_MOD * D_MODEL), D_MODEL),
        'b_ada': 0.02 * jax.random.normal(ks[5], (L, N_MOD * D_MODEL), jnp.float32),
        'norm_ffn1': gain(ks[6], (L, D_MODEL)),
        'w_ffn1_in': w(ks[7], (L, D_MODEL, 2 * D_FF), D_MODEL),
        'w_ffn1_out': w(ks[8], (L, D_FF, D_MODEL), D_FF),
        'norm_mix': gain(ks[9], (L, D_MODEL)),
        'w_in': w(ks[10], (L, D_MODEL, IN_WIDTH), D_MODEL),
        'q_norm': gain(ks[11], (L, HEAD_DIM)),
        'k_norm': gain(ks[12], (L, HEAD_DIM)),
        'w_attn_branch': w(ks[13], (L, Q_WIDTH, D_MODEL), Q_WIDTH),
        'w_fourier_branch': w(ks[14], (L, FOURIER_WIDTH, D_MODEL), FOURIER_WIDTH),
        'w_out': w(ks[15], (L, D_MODEL, D_MODEL), D_MODEL),
        'norm_ffn2': gain(ks[16], (L, D_MODEL)),
        'w_ffn2_in': w(ks[17], (L, D_MODEL, 2 * D_FF), D_MODEL),
        'w_ffn2_out': w(ks[18], (L, D_FF, D_MODEL), D_FF),
    }


def reference(x, c, ctx, c_ctx, w_ada, b_ada, norm_ffn1, w_ffn1_in, w_ffn1_out, norm_mix,
              w_in, q_norm, k_norm, w_attn_branch, w_fourier_branch, w_out, norm_ffn2,
              w_ffn2_in, w_ffn2_out):
    n_lat = x.shape[1]
    cos, sin = _axial_rope_tables(n_lat, x.dtype)
    for i in range(DEPTH):
        last = i == DEPTH - 1
        mod = _adaln(c, w_ada[i], b_ada[i])[:, None, :]
        mod_c = _adaln(c_ctx, w_ada[i], b_ada[i])
        sh1, sc1, g1, sh2, sc2, g2, sh3, sc3, g3 = jnp.split(mod, N_MOD, axis=-1)
        csh1, csc1, cg1, csh2, csc2, cg2, csh3, csc3, cg3 = jnp.split(mod_c, N_MOD, axis=-1)

        x = x + 0.5 * g1 * _swiglu(_modulate(_rmsnorm(x, norm_ffn1[i]), sh1, sc1),
                                   w_ffn1_in[i], w_ffn1_out[i])
        ctx = ctx + 0.5 * cg1 * _swiglu(_modulate(_rmsnorm(ctx, norm_ffn1[i]), csh1, csc1),
                                        w_ffn1_in[i], w_ffn1_out[i])

        h = _modulate(_rmsnorm(x, norm_mix[i]), sh2, sc2)
        hc = _modulate(_rmsnorm(ctx, norm_mix[i]), csh2, csc2)
        q, k, v, f, ga, gf = _split_in(h @ w_in[i])
        q = _apply_rope(_heads_norm(q, N_Q_HEADS, q_norm[i]), cos, sin)
        k = _apply_rope(_heads_norm(k, N_KV_HEADS, k_norm[i]), cos, sin)
        v = v.reshape(v.shape[0], n_lat, N_KV_HEADS, HEAD_DIM)
        if last:
            k_c, v_c = jnp.split(hc @ w_in[i][:, Q_WIDTH:Q_WIDTH + 2 * KV_WIDTH], 2, axis=-1)
        else:
            q_c, k_c, v_c, f_c, ga_c, gf_c = _split_in(hc @ w_in[i])
        k_c = _heads_norm(k_c, N_KV_HEADS, k_norm[i])
        v_c = v_c.reshape(v_c.shape[0], v_c.shape[1], N_KV_HEADS, HEAD_DIM)

        y_attn = _latent_attention(q, k, v, k_c, v_c)
        mix = _merge(y_attn, _fourier_mix(f), ga, gf,
                     w_attn_branch[i], w_fourier_branch[i], w_out[i])
        if not last:
            q_c = _heads_norm(q_c, N_Q_HEADS, q_norm[i])
            mix_c = _merge(_context_attention(q_c, k_c, v_c), _fourier_mix(f_c), ga_c, gf_c,
                           w_attn_branch[i], w_fourier_branch[i], w_out[i])
            ctx = ctx + cg2 * mix_c
            ctx = ctx + 0.5 * cg3 * _swiglu(_modulate(_rmsnorm(ctx, norm_ffn2[i]), csh3, csc3),
                                            w_ffn2_in[i], w_ffn2_out[i])
        x = x + g2 * mix

        x = x + 0.5 * g3 * _swiglu(_modulate(_rmsnorm(x, norm_ffn2[i]), sh3, sc3),
                                   w_ffn2_in[i], w_ffn2_out[i])
    return x
```

```cpp
#include <hip/hip_runtime.h>
#include <hip/hip_cooperative_groups.h>
#include <hip/hip_bf16.h>
#include <cstdio>
#include <cstdint>
namespace cg = cooperative_groups;

#ifndef MK_MULTI
#define MK_MULTI 0
#endif

#define LAS __attribute__((address_space(3)))
typedef unsigned short bf16_t;
typedef short bf16x8 __attribute__((ext_vector_type(8)));
typedef float f32x4 __attribute__((ext_vector_type(4)));
typedef float f32x16 __attribute__((ext_vector_type(16)));
typedef unsigned u32x4 __attribute__((ext_vector_type(4)));
typedef unsigned u32x2 __attribute__((ext_vector_type(2)));
typedef short s16x4 __attribute__((ext_vector_type(4)));

constexpr int DM = 1024, NB = 8, SEQ = 2048, CTXL = 256, NLAT = NB * SEQ, NCTX = NB * CTXL, NTOK = NLAT + NCTX;
constexpr int DFF = 2816, NMOD = 9 * DM, SKV = CTXL + SEQ;
constexpr float EPS = 1e-6f;

constexpr size_t MiB = 1u << 20;
constexpr size_t WS_MOD = 0, WS_ROPE = 384 * 1024, WS_BAR = 512 * 1024, BAR_BYTES = 16384;
constexpr size_t WS_W1IN = 1 * MiB, WS_W1OUT = 12 * MiB, WS_WIN = 18 * MiB, WS_WF = 25 * MiB, WS_WAB = 27 * MiB, WS_WFB = 29 * MiB, WS_WO = 30 * MiB;
constexpr size_t WS_W2IN = 32 * MiB, WS_W2OUT = 43 * MiB, WS_DFT = 49 * MiB, WS_A = 65 * MiB, WS_CTX1 = 101 * MiB, WS_H = 109 * MiB;
constexpr size_t WS_Q = 109 * MiB, WS_K = 141 * MiB, WS_V = 150 * MiB, WS_GA = 159 * MiB, WS_GF = 191 * MiB, WS_FT = 223 * MiB, WS_YF = WS_A, WS_CTX1B = WS_FT, WS_X2 = WS_FT, WS_WFB2 = WS_W1IN, WS_ST3 = WS_CTX1, WS_SW3 = WS_CTX1 + 2 * MiB, WS_END = 255 * MiB;

constexpr int LDS_BYTES = 147456;
constexpr int LDS_MISC = 131072;

__device__ __forceinline__ unsigned cvt_pk_bf16(float lo, float hi) { unsigned r; asm volatile("v_cvt_pk_bf16_f32 %0, %1, %2" : "=v"(r) : "v"(lo), "v"(hi)); return r; }
__device__ __forceinline__ u32x4 pack8(f32x4 a, f32x4 b) { u32x4 w; w.x = cvt_pk_bf16(a[0], a[1]); w.y = cvt_pk_bf16(a[2], a[3]); w.z = cvt_pk_bf16(b[0], b[1]); w.w = cvt_pk_bf16(b[2], b[3]); return w; }
__device__ __forceinline__ void unpack8(u32x4 w, f32x4& a, f32x4& b) {
    a[0] = __uint_as_float(w.x << 16); a[1] = __uint_as_float(w.x & 0xffff0000u); a[2] = __uint_as_float(w.y << 16); a[3] = __uint_as_float(w.y & 0xffff0000u);
    b[0] = __uint_as_float(w.z << 16); b[1] = __uint_as_float(w.z & 0xffff0000u); b[2] = __uint_as_float(w.w << 16); b[3] = __uint_as_float(w.w & 0xffff0000u); }
__device__ __forceinline__ float bf2f(bf16_t v) { return __uint_as_float((unsigned)v << 16); }
__device__ __forceinline__ bf16_t f2bf(float f) { unsigned u = __float_as_uint(f); return (bf16_t)((u + 0x7fffu + ((u >> 16) & 1u)) >> 16); }
__device__ __forceinline__ float sigmoidf_(float v) { return __builtin_amdgcn_rcpf(1.f + __builtin_amdgcn_exp2f(-1.4426950408889634f * v)); }
__device__ __forceinline__ float wave_sum(float v) {
#pragma unroll
    for (int o = 1; o < 64; o <<= 1) v += __shfl_xor(v, o);
    return v;
}

namespace pg8 {
constexpr int BM = 256, BK = 64, HALF = 128, HTB = HALF * BK * 2, STAGE_BYTES = 8 * HTB, NXCD = 8, WGM = 8;
__host__ __device__ __forceinline__ int lds_byte(int r, int c) { const int st = (r >> 4) * 2 + (c >> 5), rr = r & 15, cc = c & 31, ob = rr * 64 + cc * 2; return st * 1024 + (ob ^ (((ob >> 9) & 1) << 5)); }
__host__ __device__ __forceinline__ void stage_rc(int b, int& R, int& C) { const int st = b / 1024, sb = b % 1024, swz = sb ^ (((sb >> 9) & 1) << 5); R = (st >> 1) * 16 + swz / 64; C = (st & 1) * 32 + (swz % 64) / 2; }
__host__ __device__ __forceinline__ int perm32(int rho) { const int n = rho >> 4, i = rho & 15; return 8 * (i >> 2) + 4 * n + (i & 3); }

struct Unit { int pm, pn, sub; };
enum Kind { K_SWIGLU = 0, K_RES = 1, K_INPROJ = 2, K_FTSWAP = 3, K_CTXKV = 4, K_FOUR2 = 5, K_BRA = 6, K_BRB = 7, K_RESC0 = 8, K_RESC1 = 9 };

struct Sched {
    const bf16_t *A0, *A1, *A2, *B0, *B1, *B2; int nM0, nM1, nM2, nN0, nN1, nN2, k0, k1, k2; int n0, n1, n2; int G, c, K, direct; int kt0, kt1, kt2, ko1, ko2;
    static __device__ __forceinline__ int sel3(int sub, int v0, int v1, int v2) { const int m1 = -(int)(sub == 1), m2 = -(int)(sub == 2); return v0 ^ ((v0 ^ v1) & m1) ^ ((v0 ^ v2) & m2); }
    static __device__ __forceinline__ unsigned long long sel3p(int sub, const void* p0, const void* p1, const void* p2) {
        const unsigned long long v0 = (unsigned long long)p0, v1 = (unsigned long long)p1, v2 = (unsigned long long)p2, m1 = -(unsigned long long)(sub == 1), m2 = -(unsigned long long)(sub == 2);
        return v0 ^ ((v0 ^ v1) & m1) ^ ((v0 ^ v2) & m2); }
    __device__ __forceinline__ bool next(int i, Unit& u) const {
        if (direct == 1) { if (i > 0) return false; const int x = c & 7, s = c >> 3; u.sub = s >> 4; u.pm = s & 7; u.pn = 2 * x + ((s >> 3) & 1); return true; }
        if (direct == 2) {
            if (i > 1 || c >= n0) return false; u.sub = i;
            const int nwg = nM0 * nN0; int wgid; { const int q = nwg / NXCD, r = nwg % NXCD, xcd = c % NXCD, off = c / NXCD; wgid = (xcd < r ? xcd * (q + 1) : r * (q + 1) + (xcd - r) * q) + off; }
            const int nig = WGM * nN0, gid = wgid / nig, fm = gid * WGM, gsz = (nM0 - fm) < WGM ? (nM0 - fm) : WGM;
            u.pm = fm + ((wgid % nig) % gsz); u.pn = (wgid % nig) / gsz; return true; }
        const long L = (long)i * G + c;
        if (L >= n0 + n1 + n2) return false;
        const int sub = (L >= n0) + (L >= n0 + n1); u.sub = sub;
        const int l = (int)L - sel3(sub, 0, n0, n0 + n1), nM = sel3(sub, nM0, nM1, nM2), nN = sel3(sub, nN0, nN1, nN2);
        const int nwg = nM * nN; int wgid; { const int q = nwg / NXCD, r = nwg % NXCD, xcd = l % NXCD, off = l / NXCD; wgid = (xcd < r ? xcd * (q + 1) : r * (q + 1) + (xcd - r) * q) + off; }
        const int nig = WGM * nN, gid = wgid / nig, fm = gid * WGM, gsz = (nM - fm) < WGM ? (nM - fm) : WGM;
        u.pm = fm + ((wgid % nig) % gsz); u.pn = (wgid % nig) / gsz; return true;
    }
    __device__ __forceinline__ const char* aptr(const Unit& u) const { return (const char*)sel3p(u.sub, A0, A1, A2) + (size_t)u.pm * (size_t)(512 * K) + 2 * sel3(u.sub, 0, ko1, ko2); }
    __device__ __forceinline__ const char* bptr(const Unit& u) const { return (const char*)sel3p(u.sub, B0, B1, B2) + (size_t)u.pn * (size_t)(512 * K) + 2 * sel3(u.sub, 0, ko1, ko2); }
    __device__ __forceinline__ int ktiles(const Unit& u) const { return sel3(u.sub, kt0, kt1, kt2); }
    __device__ __forceinline__ int kind(const Unit& u) const { return sel3(u.sub, k0, k1, k2); }
};

struct Epi {
    unsigned char* ws; float* out; const float* x; const float* ctx; int res_mode; const float* kg; const float* ng; const LAS float* rs;
    template <bool PERM> __device__ __forceinline__ void run(f32x4 (&acc)[2][2][4][2], const Unit& u, int kind, int wr, int wc, int fr_in, int fq_in) const {
        int fr = fr_in, fq = fq_in; asm volatile("" : "+v"(fr), "+v"(fq));
        const int rowt = u.pm * 256 + wr * 64 + fr;
        const int cw = wc * 32 + 8 * fq;
        if (kind == K_SWIGLU) {
            bf16_t* H = (bf16_t*)(ws + WS_H);
            const bool fn = (res_mode == 3);
            f32x4 sg[2], su[2];
            if (fn) { const float* sw = (const float*)(ws + WS_SW3) + (u.pm >> 3) * (2 * DFF) + u.pn * 256 + cw;
#pragma unroll
                for (int n = 0; n < 2; ++n) { sg[n] = *(const f32x4*)(sw + 4 * n); su[n] = *(const f32x4*)(sw + 128 + 4 * n); } }
#pragma unroll
            for (int ai = 0; ai < 2; ++ai)
#pragma unroll
                for (int m = 0; m < 4; ++m) {
                    const int row = rowt + ai * 128 + m * 16; f32x4 h[2];
                    const float rstd = fn ? rs[row & 2047] : 1.f;
#pragma unroll
                    for (int n = 0; n < 2; ++n) { f32x4 g = acc[ai][0][m][n], up = acc[ai][1][m][n]; if (fn) { g = g * rstd + sg[n]; up = up * rstd + su[n]; }
#pragma unroll
                        for (int e = 0; e < 4; ++e) h[n][e] = g[e] * sigmoidf_(g[e]) * up[e]; }
                    *(u32x4*)(H + (size_t)row * DFF + u.pn * 128 + cw) = pack8(h[0], h[1]);
                }
        } else if (kind == K_RES || kind == K_RESC0 || kind == K_RESC1) {
            const float* mod = (const float*)(ws + WS_MOD);
            const bool isctx = kind != K_RES, nobase = kind == K_RESC1;
            const bool in_bf = (res_mode != 0), out_bf = (res_mode == 1) || (res_mode == 0 && !isctx);
            const float* basef = isctx ? ctx : x; float* dstf = isctx ? (float*)(ws + (nobase ? WS_CTX1B : WS_CTX1)) : out;
            const bf16_t* baseb = res_mode == 1 ? (const bf16_t*)out : (const bf16_t*)(ws + WS_X2); bf16_t* dstb = res_mode == 0 ? (bf16_t*)out : (bf16_t*)(ws + WS_X2);
            const int gate_off = res_mode == 0 ? 2 * DM : (res_mode == 1 ? 5 * DM : 8 * DM); const float coef = res_mode == 1 ? 1.f : 0.5f;
            const int mrow = isctx ? 8 : (u.pm >> 3);
            const float* gp = mod + mrow * NMOD + gate_off + u.pn * 256 + cw;
            f32x4 gv[2][2], gg[2][2];
#pragma unroll
            for (int bj = 0; bj < 2; ++bj)
#pragma unroll
                for (int n = 0; n < 2; ++n) { gv[bj][n] = *(const f32x4*)(gp + bj * 128 + 4 * n) * coef; gg[bj][n] = gv[bj][n];
                    if (res_mode == 1) gg[bj][n] = *(const f32x4*)(ng + u.pn * 256 + cw + bj * 128 + 4 * n) * (*(const f32x4*)(mod + mrow * NMOD + 7 * DM + u.pn * 256 + cw + bj * 128 + 4 * n) + 1.0f); }
#pragma unroll
            for (int ai = 0; ai < 2; ++ai) {
                f32x4 bv[4][2][2];
#pragma unroll
                for (int m = 0; m < 4; ++m) { const size_t off = (size_t)(rowt + ai * 128 + m * 16) * DM + u.pn * 256 + cw;
#pragma unroll
                    for (int bj = 0; bj < 2; ++bj) {
                        if (in_bf) unpack8(__builtin_nontemporal_load((const u32x4*)(baseb + off + bj * 128)), bv[m][bj][0], bv[m][bj][1]);
                        else if (nobase) { bv[m][bj][0] = (f32x4){0.f, 0.f, 0.f, 0.f}; bv[m][bj][1] = bv[m][bj][0]; }
                        else { bv[m][bj][0] = __builtin_nontemporal_load((const f32x4*)(basef + off + bj * 128)); bv[m][bj][1] = __builtin_nontemporal_load((const f32x4*)(basef + off + bj * 128 + 4)); } } }
#pragma unroll
                for (int m = 0; m < 4; ++m) { const size_t off = (size_t)(rowt + ai * 128 + m * 16) * DM + u.pn * 256 + cw; float ss = 0.f;
#pragma unroll
                    for (int bj = 0; bj < 2; ++bj) { const f32x4 v0 = bv[m][bj][0] + gv[bj][0] * acc[ai][bj][m][0], v1 = bv[m][bj][1] + gv[bj][1] * acc[ai][bj][m][1];
                        if (out_bf) *(u32x4*)(dstb + off + bj * 128) = pack8(v0, v1);
                        else { *(f32x4*)(dstf + off + bj * 128) = v0; *(f32x4*)(dstf + off + bj * 128 + 4) = v1; }
                        if (res_mode == 1) {
                            *(u32x4*)((bf16_t*)(ws + WS_A) + off + bj * 128) = pack8(v0 * gg[bj][0], v1 * gg[bj][1]);
                            ss += (v0[0] * v0[0] + v0[1] * v0[1]) + (v0[2] * v0[2] + v0[3] * v0[3]) + (v1[0] * v1[0] + v1[1] * v1[1]) + (v1[2] * v1[2] + v1[3] * v1[3]); } }
                    if (res_mode == 1) { ss += __shfl_xor(ss, 16); ss += __shfl_xor(ss, 32);
                        if (fq == 0) ((float*)(ws + WS_ST3))[(size_t)(rowt + ai * 128 + m * 16) * 16 + u.pn * 4 + wc] = ss; } }
            }
        } else if (kind == K_INPROJ || kind == K_CTXKV) {
            bf16_t* dstb; int ld, rowadd, colb; bool sig = false;
            if (kind == K_INPROJ) {
                const int pn = u.pn;
                if (pn < 4) { dstb = (bf16_t*)(ws + WS_Q); ld = DM; rowadd = 0; colb = pn * 256; }
                else if (pn < 6) { dstb = (bf16_t*)(ws + (pn == 4 ? WS_K : WS_V)); ld = 256; rowadd = 256 * ((u.pm >> 3) + 1); colb = 0; }
                else if (pn < 10) { dstb = (bf16_t*)(ws + WS_GA); ld = DM; rowadd = 0; colb = (pn - 6) * 256; sig = true; }
                else { dstb = (bf16_t*)(ws + WS_GF); ld = DM; rowadd = 0; colb = (pn - 10) * 256; sig = true; }
            } else { dstb = (bf16_t*)(ws + (u.pn == 0 ? WS_K : WS_V)); ld = 256; rowadd = u.pm * (SKV - CTXL); colb = 0; }
#pragma unroll
            for (int ai = 0; ai < 2; ++ai)
#pragma unroll
                for (int m = 0; m < 4; ++m) {
                    const int row = rowt + ai * 128 + m * 16 + rowadd;
#pragma unroll
                    for (int bj = 0; bj < 2; ++bj) { f32x4 a = acc[ai][bj][m][0], b = acc[ai][bj][m][1];
                        if (sig) {
#pragma unroll
                            for (int e = 0; e < 4; ++e) { a[e] = sigmoidf_(a[e]); b[e] = sigmoidf_(b[e]); } }
                        *(u32x4*)(dstb + (size_t)row * ld + colb + bj * 128 + cw) = pack8(a, b); }
                }
            const bool isk = (kind == K_INPROJ) ? (u.pn == 4) : (u.pn == 0);
            if (isk) {
                asm volatile("s_waitcnt vmcnt(0)" ::: "memory"); __builtin_amdgcn_s_barrier(); asm volatile("" ::: "memory");
                const float* rt = (const float*)(ws + WS_ROPE); const bool rope = (kind == K_INPROJ);
                const int lane = fq * 16 + fr, wid = wr * 4 + wc, l16 = lane & 15;
                const f32x4 g1 = *(const f32x4*)(kg + 4 * l16), g2 = *(const f32x4*)(kg + 64 + 4 * l16);
#pragma unroll 4
                for (int it = 0; it < 16; ++it) { const int item = it * 32 + wid * 4 + (lane >> 4), r = item >> 1, hd = item & 1;
                    bf16_t* hp = dstb + (size_t)(u.pm * 256 + r + rowadd) * 256 + hd * 128 + 4 * l16;
                    const u32x2 w1 = *(const u32x2*)hp, w2 = *(const u32x2*)(hp + 64);
                    f32x4 t1 = {__uint_as_float(w1.x << 16), __uint_as_float(w1.x & 0xffff0000u), __uint_as_float(w1.y << 16), __uint_as_float(w1.y & 0xffff0000u)};
                    f32x4 t2 = {__uint_as_float(w2.x << 16), __uint_as_float(w2.x & 0xffff0000u), __uint_as_float(w2.y << 16), __uint_as_float(w2.y & 0xffff0000u)};
                    float ss = (t1[0] * t1[0] + t1[1] * t1[1]) + (t1[2] * t1[2] + t1[3] * t1[3]) + (t2[0] * t2[0] + t2[1] * t2[1]) + (t2[2] * t2[2] + t2[3] * t2[3]);
                    ss += __shfl_xor(ss, 1); ss += __shfl_xor(ss, 2); ss += __shfl_xor(ss, 4); ss += __shfl_xor(ss, 8);
                    const float rstd = 1.0f / sqrtf(ss * (1.0f / 128.0f) + EPS);
                    t1 = t1 * rstd * g1; t2 = t2 * rstd * g2;
                    if (rope) { const int n = ((u.pm & 7) * 256 + r); const int pos = l16 < 8 ? (n >> 6) : (n & 63); const float* rp = rt + 2 * (pos * 32 + ((4 * l16) & 31));
                        const f32x4 c0 = *(const f32x4*)rp, c1 = *(const f32x4*)(rp + 4); f32x4 o1, o2;
                        o1[0] = t1[0] * c0[0] - t2[0] * c0[1]; o2[0] = t2[0] * c0[0] + t1[0] * c0[1]; o1[1] = t1[1] * c0[2] - t2[1] * c0[3]; o2[1] = t2[1] * c0[2] + t1[1] * c0[3];
                        o1[2] = t1[2] * c1[0] - t2[2] * c1[1]; o2[2] = t2[2] * c1[0] + t1[2] * c1[1]; o1[3] = t1[3] * c1[2] - t2[3] * c1[3]; o2[3] = t2[3] * c1[2] + t1[3] * c1[3];
                        t1 = o1; t2 = o2; }
                    u32x2 q1, q2; q1.x = cvt_pk_bf16(t1[0], t1[1]); q1.y = cvt_pk_bf16(t1[2], t1[3]); q2.x = cvt_pk_bf16(t2[0], t2[1]); q2.y = cvt_pk_bf16(t2[2], t2[3]);
                    *(u32x2*)hp = q1; *(u32x2*)(hp + 64) = q2; }
            }
        } else if (kind == K_FTSWAP) {
            bf16_t* FT = (bf16_t*)(ws + WS_FT);
#pragma unroll
            for (int ai = 0; ai < 2; ++ai)
#pragma unroll
                for (int m = 0; m < 4; ++m) {
                    const int j = rowt + ai * 128 + m * 16; const int cs = j >> 9, g = (j >> 7) & 3, mm = j & 127;
#pragma unroll
                    for (int bj = 0; bj < 2; ++bj) { const int t0 = u.pn * 256 + bj * 128 + cw; const int b = t0 >> 11, n = t0 & 2047;
                        *(u32x4*)(FT + ((size_t)((b * 4 + g) * 128 + mm)) * 4096 + cs * 2048 + n) = pack8(acc[ai][bj][m][0], acc[ai][bj][m][1]); }
                }
        } else if (kind == K_FOUR2) {
            bf16_t* YF = (bf16_t*)(ws + WS_YF);
#pragma unroll
            for (int ai = 0; ai < 2; ++ai)
#pragma unroll
                for (int m = 0; m < 4; ++m) {
                    const int k = rowt + ai * 128 + m * 16;
#pragma unroll
                    for (int bj = 0; bj < 2; ++bj) { const int c = u.pn * 256 + bj * 128 + cw; const int b = c >> 9, cc = c & 511;
                        *(u32x4*)(YF + (size_t)(b * SEQ + k) * 1024 + u.sub * 512 + cc) = pack8(acc[ai][bj][m][0], acc[ai][bj][m][1]); }
                }
        } else {
            bf16_t* GA = (bf16_t*)(ws + WS_GA); const bf16_t* GF = (const bf16_t*)(ws + WS_GF);
#pragma unroll
            for (int ai = 0; ai < 2; ++ai) {
                u32x4 ra[4][2], rf[4][2];
#pragma unroll
                for (int m = 0; m < 4; ++m) { const size_t off = (size_t)(rowt + ai * 128 + m * 16) * DM + u.pn * 256 + cw;
#pragma unroll
                    for (int bj = 0; bj < 2; ++bj) { if (kind == K_BRA) { rf[m][bj] = *(const u32x4*)(GF + off + bj * 128); ra[m][bj] = __builtin_nontemporal_load((const u32x4*)(GA + off + bj * 128)); } else { rf[m][bj] = __builtin_nontemporal_load((const u32x4*)(GF + off + bj * 128)); ra[m][bj] = rf[m][bj]; } } }
#pragma unroll
                for (int m = 0; m < 4; ++m) { const size_t off = (size_t)(rowt + ai * 128 + m * 16) * DM + u.pn * 256 + cw;
#pragma unroll
                    for (int bj = 0; bj < 2; ++bj) { f32x4 g0, g1; unpack8(rf[m][bj], g0, g1);
                        if (kind == K_BRA) { f32x4 a0, a1; unpack8(ra[m][bj], a0, a1);
#pragma unroll
                            for (int e = 0; e < 4; ++e) { acc[ai][bj][m][0][e] *= a0[e] * __builtin_amdgcn_rcpf(g0[e]); acc[ai][bj][m][1][e] *= a1[e] * __builtin_amdgcn_rcpf(g1[e]); } }
                        else *(u32x4*)(GA + off + bj * 128) = pack8(g0 * acc[ai][bj][m][0], g1 * acc[ai][bj][m][1]); } }
            }
        }
    }
};

template <bool ALIGN_EPI, bool SP2, bool PERM = true>
__device__ __forceinline__ void gemm_phase(LAS unsigned char* lds, const Sched& S, const Epi& E, const int tid) {
    const int wid = __builtin_amdgcn_readfirstlane(tid >> 6), lane = tid & 63, wr = wid >> 2, wc = wid & 3, fr = lane & 15, fq = lane >> 4;
    const int K = S.K;
    unsigned voffA[2], voffB[2];
#pragma unroll
    for (int i = 0; i < 2; ++i) { int R, C; stage_rc(tid * 16 + i * 8192, R, C); const int Rb = PERM ? ((R & ~31) + perm32(R & 31)) : R;
        voffA[i] = (unsigned)(R * K + C) * 2u; voffB[i] = (unsigned)(Rb * K + C) * 2u; }
    const size_t kstep = (size_t)(BK * 2);
    const size_t hstep = (size_t)HALF * K * 2;
    const unsigned ldsw = (unsigned)wid * 1024u;
    const int aoff = lds_byte(wr * 64 + fr, fq * 8), boff = lds_byte(wc * 32 + fr, fq * 8);
#define PG8_SA(b, h) (((b) * 2 + (h)) * HTB)
#define PG8_SB(b, h) ((4 + (b) * 2 + (h)) * HTB)
#define PG8_STAGE(bufoff, gbase, voff) do { _Pragma("unroll") for (int _i = 0; _i < 2; ++_i) \
        __builtin_amdgcn_global_load_lds((const unsigned*)((const char*)(gbase) + (voff)[_i]), (LAS unsigned*)(lds + (bufoff) + ldsw + _i * 8192), 16, 0, 0); } while (0)
#define PG8_LDA(dst, b, h) do { _Pragma("unroll") for (int m = 0; m < 4; ++m) _Pragma("unroll") for (int k = 0; k < 2; ++k) dst[m][k] = *(const LAS bf16x8*)(lds + PG8_SA(b, h) + aoff + m * 2048 + k * 1024); } while (0)
#define PG8_LDB(dst, b, h) do { _Pragma("unroll") for (int n = 0; n < 2; ++n) _Pragma("unroll") for (int k = 0; k < 2; ++k) dst[n][k] = *(const LAS bf16x8*)(lds + PG8_SB(b, h) + boff + n * 2048 + k * 1024); } while (0)
#define PG8_MMA(ai, bj, At, Bt) do { __builtin_amdgcn_s_setprio(1); _Pragma("unroll") for (int m = 0; m < 4; ++m) _Pragma("unroll") for (int n = 0; n < 2; ++n) _Pragma("unroll") for (int k = 0; k < 2; ++k) \
        acc[ai][bj][m][n] = __builtin_amdgcn_mfma_f32_16x16x32_bf16(Bt[n][k], At[m][k], acc[ai][bj][m][n], 0, 0, 0); __builtin_amdgcn_s_setprio(0); } while (0)
#define PG8_WAIT_V(n) asm volatile("s_waitcnt vmcnt(" #n ")" ::: "memory")
#define PG8_WAIT_L(n) asm volatile("s_waitcnt lgkmcnt(" #n ")" ::: "memory")
#define PG8_BAR __builtin_amdgcn_s_barrier()
#define PG8_SCHED __builtin_amdgcn_sched_barrier(0)
    Unit cur, nxt; int ui = 0;
    if (!S.next(0, cur)) return;
    f32x4 acc[2][2][4][2];
#pragma unroll
    for (int a = 0; a < 2; ++a)
#pragma unroll
        for (int b = 0; b < 2; ++b)
#pragma unroll
            for (int m = 0; m < 4; ++m)
#pragma unroll
                for (int n = 0; n < 2; ++n) acc[a][b][m][n] = (f32x4){0.f, 0.f, 0.f, 0.f};
    bf16x8 At[4][2], B0[2][2], B1[2][2];
    const char* cA = S.aptr(cur); const char* cB = S.bptr(cur);
    if constexpr (SP2) {
        PG8_STAGE(PG8_SB(0, 0), cB, voffB); PG8_STAGE(PG8_SB(0, 1), cB + hstep, voffB); PG8_STAGE(PG8_SA(0, 0), cA, voffA); PG8_STAGE(PG8_SA(0, 1), cA + hstep, voffA);
        if (wr == 1) PG8_BAR;
        PG8_WAIT_V(2); PG8_BAR;
        PG8_STAGE(PG8_SB(1, 0), cB + kstep, voffB); PG8_STAGE(PG8_SA(1, 0), cA + kstep, voffA); PG8_STAGE(PG8_SB(1, 1), cB + hstep + kstep, voffB);
        PG8_WAIT_V(6); PG8_BAR;
    } else {
        PG8_STAGE(PG8_SB(0, 0), cB, voffB); PG8_STAGE(PG8_SA(0, 0), cA, voffA); PG8_STAGE(PG8_SB(0, 1), cB + hstep, voffB); PG8_STAGE(PG8_SA(0, 1), cA + hstep, voffA);
        if (wr == 1) PG8_BAR;
        PG8_WAIT_V(4); PG8_BAR;
        PG8_STAGE(PG8_SB(1, 0), cB + kstep, voffB); PG8_STAGE(PG8_SA(1, 0), cA + kstep, voffA); PG8_STAGE(PG8_SB(1, 1), cB + hstep + kstep, voffB);
        PG8_WAIT_V(6); PG8_BAR;
    }
    for (;;) {
        const bool has_next = S.next(ui + 1, nxt); const int nt = S.ktiles(cur);
        const char* nA = has_next ? S.aptr(nxt) : cA; const char* nB = has_next ? S.bptr(nxt) : cB;
        for (int t = 0; t < nt; t += 2) {
            const bool last = (t == nt - 2);
            const char* a1 = cA + (size_t)(t + 1) * kstep;
            const char* a2 = last ? nA : cA + (size_t)(t + 2) * kstep; const char* b2 = last ? nB : cB + (size_t)(t + 2) * kstep;
            const char* a3 = a2 + kstep; const char* b3 = b2 + kstep;
            if constexpr (SP2) {
            PG8_LDB(B0, 0, 0); PG8_LDB(B1, 0, 1); PG8_SCHED; PG8_LDA(At, 0, 0); PG8_STAGE(PG8_SA(1, 1), a1 + hstep, voffA);
            PG8_WAIT_V(8); PG8_WAIT_L(0); PG8_BAR; PG8_MMA(0, 0, At, B0); PG8_MMA(0, 1, At, B1); PG8_BAR; PG8_SCHED;
            PG8_LDA(At, 0, 1); PG8_STAGE(PG8_SB(0, 0), b2, voffB); PG8_STAGE(PG8_SB(0, 1), b2 + hstep, voffB); PG8_STAGE(PG8_SA(0, 0), a2, voffA);
            PG8_WAIT_V(8); PG8_WAIT_L(0); PG8_BAR; PG8_MMA(1, 0, At, B0); PG8_MMA(1, 1, At, B1); PG8_BAR; PG8_SCHED;
            PG8_LDB(B0, 1, 0); PG8_LDB(B1, 1, 1); PG8_SCHED; PG8_LDA(At, 1, 0); PG8_STAGE(PG8_SA(0, 1), a2 + hstep, voffA);
            PG8_WAIT_V(8); PG8_WAIT_L(0); PG8_BAR; PG8_MMA(0, 0, At, B0); PG8_MMA(0, 1, At, B1); PG8_BAR; PG8_SCHED;
            PG8_LDA(At, 1, 1); PG8_STAGE(PG8_SB(1, 0), b3, voffB); PG8_STAGE(PG8_SB(1, 1), b3 + hstep, voffB); PG8_STAGE(PG8_SA(1, 0), a3, voffA);
            PG8_WAIT_V(8); PG8_WAIT_L(0); PG8_BAR; PG8_MMA(1, 0, At, B0); PG8_MMA(1, 1, At, B1); PG8_BAR; PG8_SCHED;
            } else {
            PG8_LDB(B0, 0, 0); PG8_SCHED; PG8_LDA(At, 0, 0); PG8_STAGE(PG8_SA(1, 1), a1 + hstep, voffA);
            PG8_WAIT_L(8); PG8_BAR; PG8_WAIT_L(0); PG8_MMA(0, 0, At, B0); PG8_BAR; PG8_SCHED;
            PG8_LDB(B1, 0, 1); PG8_STAGE(PG8_SB(0, 0), b2, voffB);
            PG8_BAR; PG8_WAIT_L(0); PG8_MMA(0, 1, At, B1); PG8_BAR;
            PG8_LDA(At, 0, 1); PG8_STAGE(PG8_SA(0, 0), a2, voffA);
            PG8_BAR; PG8_WAIT_L(0); PG8_MMA(1, 0, At, B0); PG8_BAR; PG8_SCHED;
            PG8_STAGE(PG8_SB(0, 1), b2 + hstep, voffB);
            PG8_WAIT_V(6); PG8_BAR; PG8_MMA(1, 1, At, B1); PG8_BAR;
            PG8_LDB(B0, 1, 0); PG8_SCHED; PG8_LDA(At, 1, 0); PG8_STAGE(PG8_SA(0, 1), a2 + hstep, voffA);
            PG8_WAIT_L(8); PG8_BAR; PG8_WAIT_L(0); PG8_MMA(0, 0, At, B0); PG8_BAR; PG8_SCHED;
            PG8_LDB(B1, 1, 1); PG8_STAGE(PG8_SB(1, 0), b3, voffB);
            PG8_BAR; PG8_WAIT_L(0); PG8_MMA(0, 1, At, B1); PG8_BAR;
            PG8_LDA(At, 1, 1); PG8_STAGE(PG8_SA(1, 0), a3, voffA);
            PG8_BAR; PG8_WAIT_L(0); PG8_MMA(1, 0, At, B0); PG8_BAR; PG8_SCHED;
            PG8_STAGE(PG8_SB(1, 1), b3 + hstep, voffB);
            PG8_WAIT_V(6); PG8_BAR; PG8_MMA(1, 1, At, B1); PG8_BAR;
            }
        }
        if constexpr (ALIGN_EPI) { if (wr == 0) PG8_BAR; }
        E.template run<PERM>(acc, cur, S.kind(cur), wr, wc, fr, fq);
        if (!has_next) break;
        if (S.kind(cur) != K_BRA) {
#pragma unroll
        for (int a = 0; a < 2; ++a)
#pragma unroll
            for (int b = 0; b < 2; ++b)
#pragma unroll
                for (int m = 0; m < 4; ++m)
#pragma unroll
                    for (int n = 0; n < 2; ++n) acc[a][b][m][n] = (f32x4){0.f, 0.f, 0.f, 0.f};
        }
        cur = nxt; cA = nA; cB = nB; ++ui;
        if constexpr (ALIGN_EPI) { if (wr == 1) PG8_BAR; }
    }
    PG8_WAIT_V(0);
    if constexpr (!ALIGN_EPI) { if (wr == 0) PG8_BAR; }
    PG8_BAR;
#undef PG8_SA
#undef PG8_SB
#undef PG8_STAGE
#undef PG8_LDA
#undef PG8_LDB
#undef PG8_MMA
#undef PG8_WAIT_V
#undef PG8_WAIT_L
#undef PG8_BAR
#undef PG8_SCHED
}
}

namespace att {
using bf16 = __hip_bfloat16;
constexpr int D = 128, NW = 8, QBLK = 32, KVBLK = 64;
constexpr float SCALE = 0.088388347648318440f;
constexpr float THR = 8.f;
constexpr int LDQ = DM, LDK = 256, LDO = DM;
constexpr size_t SHM_V = KVBLK * D * 2, SHM_K = KVBLK * D * 2, SHM_ATTN = 2 * SHM_V + 2 * SHM_K + NW * 64 * 4;
#define KSWZ(row, colB) ((row) * 256 + ((colB) ^ (((row) & 7) << 4)))
#define SBAR() __builtin_amdgcn_sched_barrier(0)
__device__ __forceinline__ int crow(int r, int hi) { return (r & 3) + 8 * (r >> 2) + 4 * hi; }
__device__ __forceinline__ unsigned cvtpk(float lo, float hi) { unsigned r; asm volatile("v_cvt_pk_bf16_f32 %0, %1, %2" : "=v"(r) : "v"(lo), "v"(hi)); return r; }
__device__ __forceinline__ void partialSM(f32x16& p0, f32x16& p1, float& m_reg, float& mn, float& alpha) {
  constexpr float C = SCALE * 1.4426950408889634f;
  float pmax = p0[0];
  _Pragma("unroll") for (int r = 1; r < 16; ++r) pmax = fmaxf(pmax, p0[r]);
  _Pragma("unroll") for (int r = 0; r < 16; ++r) pmax = fmaxf(pmax, p1[r]);
  { auto rr = __builtin_amdgcn_permlane32_swap(__float_as_uint(pmax), __float_as_uint(pmax), false, false);
    pmax = fmaxf(__uint_as_float(rr[0]), __uint_as_float(rr[1])); }
  if (__builtin_expect(__all(pmax - m_reg <= THR / SCALE), 1)) { mn = m_reg; alpha = 1.f; }
  else { mn = fmaxf(m_reg, pmax); alpha = __builtin_amdgcn_exp2f((m_reg - mn) * C); m_reg = mn; }
  float mnC = -mn * C;
  _Pragma("unroll") for (int r = 0; r < 16; ++r) p0[r] = fmaf(p0[r], C, mnC);
  _Pragma("unroll") for (int r = 0; r < 16; ++r) p1[r] = fmaf(p1[r], C, mnC);
  _Pragma("unroll") for (int r = 0; r < 16; ++r) p0[r] = __builtin_amdgcn_exp2f(p0[r]);
}
__device__ __forceinline__ void finishSM(f32x16& p0, f32x16& p1, float alpha, float& l_reg, bf16x8& pa0, bf16x8& pa1, bf16x8& pa2, bf16x8& pa3) {
  _Pragma("unroll") for (int r = 0; r < 16; ++r) p1[r] = __builtin_amdgcn_exp2f(p1[r]);
  float ps = 0;
  _Pragma("unroll") for (int r = 0; r < 16; ++r) ps += p0[r];
  _Pragma("unroll") for (int r = 0; r < 16; ++r) ps += p1[r];
  { auto rr = __builtin_amdgcn_permlane32_swap(__float_as_uint(ps), __float_as_uint(ps), false, false);
    ps = __uint_as_float(rr[0]) + __uint_as_float(rr[1]); }
  l_reg = l_reg * alpha + ps;
#define PK4(P, BASE, OUT) do { unsigned a0 = cvtpk(P[BASE + 0], P[BASE + 1]), a1 = cvtpk(P[BASE + 2], P[BASE + 3]);   \
    unsigned b0 = cvtpk(P[BASE + 4], P[BASE + 5]), b1 = cvtpk(P[BASE + 6], P[BASE + 7]);                              \
    auto r0 = __builtin_amdgcn_permlane32_swap(a0, b0, false, false); auto r1 = __builtin_amdgcn_permlane32_swap(a1, b1, false, false); \
    u32x4 w = {r0[0], r1[0], r0[1], r1[1]}; OUT = *reinterpret_cast<bf16x8*>(&w); } while (0)
  PK4(p0, 0, pa0); PK4(p0, 8, pa1); PK4(p1, 0, pa2); PK4(p1, 8, pa3);
#undef PK4
}
__device__ __forceinline__ void qkt(f32x16& p0, f32x16& p1, const bf16* Ks, const bf16x8* qr, int r32, int hi) {
  p0 = f32x16{}; p1 = f32x16{};
  _Pragma("unroll") for (int d0 = 0; d0 < 8; ++d0) { int cb = (d0 * 16 + hi * 8) * 2;
    bf16x8 b0 = *reinterpret_cast<const bf16x8*>((const char*)Ks + KSWZ(r32, cb));
    bf16x8 b1 = *reinterpret_cast<const bf16x8*>((const char*)Ks + KSWZ(32 + r32, cb));
    p0 = __builtin_amdgcn_mfma_f32_32x32x16_bf16(b0, qr[d0], p0, 0, 0, 0);
    p1 = __builtin_amdgcn_mfma_f32_32x32x16_bf16(b1, qr[d0], p1, 0, 0, 0); }
}
__device__ __forceinline__ int v_st(int k, int c) { const int kk = (k & ~0xC) | ((k & 4) << 1) | ((k & 8) >> 1); return ((kk >> 3) * 4 + (c >> 5)) * 512 + ((kk & 7) * 32 + (c & 31)) * 2; }
__device__ __forceinline__ int v_rd_base(int lane) { return ((lane & 3) << 3) | (((lane >> 2) & 3) << 6) | (((lane >> 4) & 1) << 5) | (((lane >> 5) & 1) << 8); }
constexpr int v_rd_off(int d0, int ks, int half) { return d0 * 512 + ks * 4096 + half * 2048; }
template <int OFF> __device__ __forceinline__ s16x4 tr_read(int vb) {
  s16x4 r; asm volatile("ds_read_b64_tr_b16 %0, %1 offset:%2" : "=&v"(r) : "v"(vb), "i"(OFF) : "memory"); return r;
}
template <int D0> __device__ __forceinline__ void pv_one(f32x16& od, int vb, bf16x8 pa0, bf16x8 pa1, bf16x8 pa2, bf16x8 pa3) {
  const s16x4 l0 = tr_read<v_rd_off(D0, 0, 0)>(vb), h0 = tr_read<v_rd_off(D0, 0, 1)>(vb), l1 = tr_read<v_rd_off(D0, 1, 0)>(vb), h1 = tr_read<v_rd_off(D0, 1, 1)>(vb);
  const s16x4 l2 = tr_read<v_rd_off(D0, 2, 0)>(vb), h2 = tr_read<v_rd_off(D0, 2, 1)>(vb), l3 = tr_read<v_rd_off(D0, 3, 0)>(vb), h3 = tr_read<v_rd_off(D0, 3, 1)>(vb);
  asm volatile("s_waitcnt lgkmcnt(0)" ::: "memory"); SBAR();
#define PK(L, H) (bf16x8){L[0], L[1], L[2], L[3], H[0], H[1], H[2], H[3]}
  od = __builtin_amdgcn_mfma_f32_32x32x16_bf16(pa0, PK(l0, h0), od, 0, 0, 0);
  od = __builtin_amdgcn_mfma_f32_32x32x16_bf16(pa1, PK(l1, h1), od, 0, 0, 0);
  od = __builtin_amdgcn_mfma_f32_32x32x16_bf16(pa2, PK(l2, h2), od, 0, 0, 0);
  od = __builtin_amdgcn_mfma_f32_32x32x16_bf16(pa3, PK(l3, h3), od, 0, 0, 0);
#undef PK
}
__device__ __forceinline__ void pv_d0(f32x16* o, int vb, bf16x8 pa0, bf16x8 pa1, bf16x8 pa2, bf16x8 pa3) {
  pv_one<0>(o[0], vb, pa0, pa1, pa2, pa3); pv_one<1>(o[1], vb, pa0, pa1, pa2, pa3); pv_one<2>(o[2], vb, pa0, pa1, pa2, pa3); pv_one<3>(o[3], vb, pa0, pa1, pa2, pa3);
}
__device__ __forceinline__ void attn_unit(const bf16* Qb, const bf16* __restrict__ Kh, const bf16* __restrict__ Vh, bf16* Ob, int seq, char* lds, const int tid,
                                          const float* __restrict__ qg, const float* __restrict__ ropetab, int n0) {
  const int wid = __builtin_amdgcn_readfirstlane(tid >> 6), lane = tid & 63, r32 = lane & 31, hi = lane >> 5;
  bf16* V_lds = (bf16*)lds; bf16* K_lds = (bf16*)(lds + 2 * SHM_V);
  float* ws = (float*)(lds + 2 * SHM_V + 2 * SHM_K) + wid * 64; float* li_l = ws; float* al_l = ws + 32;
  bf16x8 qr[8];
  const bf16* Qw = Qb + (long)(wid * QBLK + r32) * LDQ + hi * 8;
#pragma unroll
  for (int d0 = 0; d0 < 8; ++d0) qr[d0] = *reinterpret_cast<const bf16x8*>(Qw + d0 * 16);
#ifndef NO_QFIX
  {
    float qf[8][8]; float ss = 0.f;
#pragma unroll
    for (int d0 = 0; d0 < 8; ++d0)
#pragma unroll
      for (int e = 0; e < 8; ++e) { const float v = __uint_as_float(((unsigned)(unsigned short)qr[d0][e]) << 16); qf[d0][e] = v; ss += v * v; }
    { auto rr = __builtin_amdgcn_permlane32_swap(__float_as_uint(ss), __float_as_uint(ss), false, false); ss = __uint_as_float(rr[0]) + __uint_as_float(rr[1]); }
    const float rstd = 1.0f / sqrtf(ss * (1.0f / 128.0f) + EPS);
    const int n = n0 + wid * QBLK + r32;
#pragma unroll
    for (int d0 = 0; d0 < 8; ++d0) { const f32x4 g0 = *(const f32x4*)(qg + d0 * 16 + hi * 8), g1 = *(const f32x4*)(qg + d0 * 16 + hi * 8 + 4);
#pragma unroll
      for (int e = 0; e < 4; ++e) { qf[d0][e] *= rstd * g0[e]; qf[d0][4 + e] *= rstd * g1[e]; } }
#pragma unroll
    for (int d0 = 0; d0 < 4; ++d0) { const int pos = d0 < 2 ? (n >> 6) : (n & 63); const float* rp = ropetab + 2 * (pos * 32 + (d0 & 1) * 16 + hi * 8);
#pragma unroll
      for (int e = 0; e < 8; e += 2) { const f32x4 cs = *(const f32x4*)(rp + 2 * e);
        { const float t1 = qf[d0][e], t2 = qf[d0 + 4][e]; qf[d0][e] = t1 * cs[0] - t2 * cs[1]; qf[d0 + 4][e] = t2 * cs[0] + t1 * cs[1]; }
        { const float t1 = qf[d0][e + 1], t2 = qf[d0 + 4][e + 1]; qf[d0][e + 1] = t1 * cs[2] - t2 * cs[3]; qf[d0 + 4][e + 1] = t2 * cs[2] + t1 * cs[3]; } } }
#pragma unroll
    for (int d0 = 0; d0 < 8; ++d0) { u32x4 w = {cvtpk(qf[d0][0], qf[d0][1]), cvtpk(qf[d0][2], qf[d0][3]), cvtpk(qf[d0][4], qf[d0][5]), cvtpk(qf[d0][6], qf[d0][7])}; qr[d0] = *reinterpret_cast<bf16x8*>(&w); }
  }
#endif
  float m_reg = -1e30f, l_reg = 0; f32x16 o[4] = {};
  const int sr = tid >> 4, sc = (tid & 15) * 8, vst0 = v_st(sr, sc), vst1 = v_st(32 + sr, sc);
  const int vb0 = (int)(uintptr_t)V_lds + v_rd_base(lane);
  bf16x8 sr_0vs0, sr_0vs1, sr_0ks0, sr_0ks1, sr_1vs0, sr_1vs1, sr_1ks0, sr_1ks1;
#define LD8(p) (*reinterpret_cast<const bf16x8*>(p))
#define SLOAD(i, k0) do { sr_##i##vs0 = LD8(&Vh[(long)((k0) + sr) * LDK + sc]); sr_##i##vs1 = LD8(&Vh[(long)((k0) + 32 + sr) * LDK + sc]); \
    sr_##i##ks0 = LD8(&Kh[(long)((k0) + sr) * LDK + sc]); sr_##i##ks1 = LD8(&Kh[(long)((k0) + 32 + sr) * LDK + sc]); } while (0)
#define SWRITE(b, i) do { *(bf16x8*)((char*)V_lds + (b) * SHM_V + vst0) = sr_##i##vs0;          \
    *(bf16x8*)((char*)V_lds + (b) * SHM_V + vst1) = sr_##i##vs1; int kc = sc * 2;               \
    *(bf16x8*)((char*)K_lds + (b) * SHM_K + KSWZ(sr, kc)) = sr_##i##ks0;                       \
    *(bf16x8*)((char*)K_lds + (b) * SHM_K + KSWZ(32 + sr, kc)) = sr_##i##ks1; } while (0)
#define SWAIT() asm volatile("s_waitcnt vmcnt(4)" ::: "memory")
#define RESC(a) do { if (__any((a) < 1.f)) { if (hi == 0) al_l[r32] = (a); asm volatile("s_waitcnt lgkmcnt(0)" ::: "memory"); \
    _Pragma("unroll") for (int d = 0; d < 4; ++d) _Pragma("unroll") for (int r = 0; r < 16; ++r) o[d][r] *= al_l[crow(r, hi)]; } } while (0)
  f32x16 pA0, pA1, pB0, pB1; float mnA, mnB, alA, alB; bf16x8 pa0, pa1, pa2, pa3; const int NT = seq / KVBLK;
  SLOAD(0, 0); asm volatile("s_waitcnt vmcnt(0)" ::: "memory"); SWRITE(0, 0); __syncthreads();
  qkt(pA0, pA1, K_lds, qr, r32, hi); partialSM(pA0, pA1, m_reg, mnA, alA);
  SLOAD(1, KVBLK); if (2 < NT) SLOAD(0, 2 * KVBLK);
  SWAIT(); SWRITE(1, 1); __syncthreads();
  for (int j = 1; j + 1 < NT; j += 2) {
    SBAR(); qkt(pB0, pB1, (bf16*)((char*)K_lds + SHM_K), qr, r32, hi);
    finishSM(pA0, pA1, alA, l_reg, pa0, pa1, pa2, pa3); SBAR();
    SLOAD(1, (j + 2) * KVBLK); SBAR();
    pv_d0(o, vb0, pa0, pa1, pa2, pa3); partialSM(pB0, pB1, m_reg, mnB, alB);
    __syncthreads(); SWAIT(); SWRITE(0, 0);
    RESC(alB); __syncthreads();
    SBAR(); qkt(pA0, pA1, K_lds, qr, r32, hi);
    finishSM(pB0, pB1, alB, l_reg, pa0, pa1, pa2, pa3); SBAR();
    if (j + 3 < NT) SLOAD(0, (j + 3) * KVBLK); SBAR();
    pv_d0(o, vb0 + (int)SHM_V, pa0, pa1, pa2, pa3); partialSM(pA0, pA1, m_reg, mnA, alA);
    __syncthreads(); SWAIT(); SWRITE(1, 1);
    RESC(alA); __syncthreads();
  }
  SBAR(); qkt(pB0, pB1, (bf16*)((char*)K_lds + SHM_K), qr, r32, hi);
  finishSM(pA0, pA1, alA, l_reg, pa0, pa1, pa2, pa3); SBAR();
  pv_d0(o, vb0, pa0, pa1, pa2, pa3); partialSM(pB0, pB1, m_reg, mnB, alB);
  __syncthreads(); RESC(alB);
  finishSM(pB0, pB1, alB, l_reg, pa0, pa1, pa2, pa3); SBAR();
  pv_d0(o, vb0 + (int)SHM_V, pa0, pa1, pa2, pa3);
  if (hi == 0) li_l[r32] = l_reg; asm volatile("s_waitcnt lgkmcnt(0)" ::: "memory");
  float rli[16];
#pragma unroll
  for (int r = 0; r < 16; ++r) rli[r] = __builtin_amdgcn_rcpf(li_l[crow(r, hi)]);
  int l2 = __builtin_amdgcn_mbcnt_hi(~0u, __builtin_amdgcn_mbcnt_lo(~0u, 0u)); asm volatile("" : "+v"(l2));
  const int r32b = l2 & 31, hib = l2 >> 5;
  bf16* Ow = Ob + (long)(wid * QBLK) * LDO;
#pragma unroll
  for (int r = 0; r < 16; ++r) { int orow = crow(r, hib);
    _Pragma("unroll") for (int d0 = 0; d0 < 4; ++d0) Ow[(long)orow * LDO + d0 * 32 + r32b] = __float2bfloat16(o[d0][r] * rli[r]); }
  __syncthreads();
#undef LD8
#undef SLOAD
#undef SWRITE
#undef SWAIT
#undef RESC
}
#undef SBAR
}

#define XB_TMO      128
#define XB_XCNT(j)  (256  + 64 * (j))
#define XB_XSUB(j)  (1280 + 64 * (j))
#define XB_XGEN(j)  (2304 + 64 * (j))
#define XB_TOP      3328
#define XB_TOPGEN   3392
#define XCD_BAR_WORDS 3456
#define XB_SPIN_CAP (1u << 18)
__device__ __forceinline__ unsigned xb_ld(unsigned* p)              { return __hip_atomic_load(p, __ATOMIC_RELAXED, __HIP_MEMORY_SCOPE_AGENT); }
__device__ __forceinline__ unsigned xb_add(unsigned* p, unsigned v) { return __hip_atomic_fetch_add(p, v, __ATOMIC_RELAXED, __HIP_MEMORY_SCOPE_AGENT); }
__device__ __forceinline__ unsigned xb_xcc_id() { return (unsigned)__builtin_amdgcn_s_getreg((3 << 11) | 20) & 0xFu; }
#define XB_SPIN(cond, bar) do { unsigned _sp = 0; while (cond) { __builtin_amdgcn_s_sleep(1); \
    if ((++_sp & 255u) == 0u) { if (xb_ld(&(bar)[XB_TMO])) break; if (_sp > XB_SPIN_CAP) { atomicAdd(&(bar)[XB_TMO], 1u); break; } } } } while (0)
struct XcdBarrier { unsigned* bar; unsigned x; volatile LAS unsigned* st; };
__device__ __forceinline__ XcdBarrier xcd_barrier_post(unsigned* bar, volatile LAS unsigned* st) {
    XcdBarrier b; b.bar = bar; b.x = xb_xcc_id(); b.st = st;
    if (threadIdx.x == 0) (void)xb_add(&bar[XB_XCNT(b.x)], 1u);
    return b;
}
__device__ __forceinline__ void xcd_barrier_complete(unsigned* bar, unsigned x, unsigned& nloc, unsigned& nx) {
    const unsigned G = gridDim.x * gridDim.y * gridDim.z;
    unsigned sum, cnt, mine, sp = 0u;
    for (;;) {
        sum = 0u; cnt = 0u; mine = 0u;
#pragma unroll
        for (unsigned j = 0; j < 16; ++j) { const unsigned c = xb_ld(&bar[XB_XCNT(j)]); sum += c; cnt += (c > 0u) ? 1u : 0u; mine = (j == x) ? c : mine; }
        if (sum == G) break;
        __builtin_amdgcn_s_sleep(1);
        if ((++sp & 255u) == 0u) { if (xb_ld(&bar[XB_TMO])) break; if (sp > XB_SPIN_CAP) { atomicAdd(&bar[XB_TMO], 1u); break; } }
    }
    nloc = mine > 0u ? mine : 1u; nx = cnt > 0u ? cnt : 1u;
}
__device__ __forceinline__ void xcd_barrier(const XcdBarrier& b) {
    asm volatile("s_waitcnt vmcnt(0)" ::: "memory");
    __syncthreads();
    if (threadIdx.x == 0) {
        unsigned* bar = b.bar;
        __builtin_amdgcn_s_waitcnt(0);
        unsigned nloc = b.st[0], nx = b.st[1];
        if (nloc == 0u) { xcd_barrier_complete(bar, b.x, nloc, nx); b.st[0] = nloc; b.st[1] = nx; }
        const unsigned old = xb_add(&bar[XB_XSUB(b.x)], 1u);
        const unsigned gen = old / nloc;
        if (old + 1u == (gen + 1u) * nloc) {
            __builtin_amdgcn_fence(__ATOMIC_RELEASE, "agent");
            asm volatile("s_waitcnt vmcnt(0)" ::: "memory");
            const unsigned og = xb_add(&bar[XB_TOP], 1u);
            const unsigned tg = og / nx;
            if (og + 1u == (tg + 1u) * nx) xb_add(&bar[XB_TOPGEN], 1u);
            else XB_SPIN(xb_ld(&bar[XB_TOPGEN]) == tg, bar);
            __builtin_amdgcn_fence(__ATOMIC_ACQUIRE, "agent");
            xb_add(&bar[XB_XGEN(b.x)], 1u);
            asm volatile("s_waitcnt vmcnt(0)" ::: "memory");
        } else {
            XB_SPIN(xb_ld(&bar[XB_XGEN(b.x)]) == gen, bar);
            __builtin_amdgcn_fence(__ATOMIC_ACQUIRE, "agent");
            asm volatile("s_waitcnt vmcnt(0)" ::: "memory");
        }
    }
    __syncthreads();
}

struct Params {
    const float *x, *c, *ctx, *c_ctx, *w_ada, *b_ada, *norm_ffn1, *w_ffn1_in, *w_ffn1_out, *norm_mix, *w_in, *q_norm, *k_norm, *w_ab, *w_fb, *w_out, *norm_ffn2, *w_ffn2_in, *w_ffn2_out;
    float* out; unsigned char* ws; int st_lo, st_hi;
};

__device__ __forceinline__ void transpose_item(const float* __restrict__ W, int K, int N, bf16_t* __restrict__ WT, int kb, int n0, int drow0, int lane, int ldd = 0) {
    if (ldd == 0) ldd = K;
    const int ng = lane & 15, kq = lane >> 4, k0 = 32 * kb + 8 * kq;
    const float* src = W + (size_t)k0 * N + n0 + 4 * ng;
    f32x4 v[8];
#pragma unroll
    for (int i = 0; i < 8; ++i) v[i] = __builtin_nontemporal_load((const f32x4*)(src + (size_t)i * N));
    bf16_t* dst = WT + (size_t)(drow0 + 4 * ng) * ldd + k0;
#pragma unroll
    for (int j = 0; j < 4; ++j) { u32x4 o; o.x = cvt_pk_bf16(v[0][j], v[1][j]); o.y = cvt_pk_bf16(v[2][j], v[3][j]); o.z = cvt_pk_bf16(v[4][j], v[5][j]); o.w = cvt_pk_bf16(v[6][j], v[7][j]);
        *(u32x4*)(dst + (size_t)j * ldd) = o; }
}

__device__ __forceinline__ void prep_phase(const Params& kp_, LAS unsigned char* lds, int tid, int lane, int wave, int G) {
    const Params* kp = &kp_; unsigned char* ws = kp->ws;
    LAS float* tab2048 = (LAS float*)(lds + LDS_MISC);
    LAS float* tab128 = (LAS float*)(lds + LDS_MISC + 8192);
    if (blockIdx.x < 144) {
        LAS float* s_l = (LAS float*)lds;
        LAS float* red = (LAS float*)(lds + 36864);
        for (int i = tid; i < 9216; i += 512) { const int r = i >> 10, k = i & 1023; const float v = (r < 8) ? kp->c[r * 1024 + k] : kp->c_ctx[k]; s_l[i] = v / (1.f + expf(-v)); }
        __syncthreads();
        const int c0 = blockIdx.x * 64, kr = lane >> 4, cgp = lane & 15;
        f32x4 a0 = {}, a1 = {}, a2 = {}, a3 = {}, a4 = {}, a5 = {}, a6 = {}, a7 = {}, a8 = {};
        const float* wp = kp->w_ada + (size_t)(wave * 128 + kr) * NMOD + c0 + 4 * cgp;
#pragma unroll 8
        for (int i = 0; i < 32; ++i) { const f32x4 w = __builtin_nontemporal_load((const f32x4*)(wp + (size_t)i * 4 * NMOD)); const int k = wave * 128 + 4 * i + kr;
            a0 += w * s_l[k]; a1 += w * s_l[1024 + k]; a2 += w * s_l[2048 + k]; a3 += w * s_l[3072 + k]; a4 += w * s_l[4096 + k];
            a5 += w * s_l[5120 + k]; a6 += w * s_l[6144 + k]; a7 += w * s_l[7168 + k]; a8 += w * s_l[8192 + k]; }
#define RED9(a, r) do { _Pragma("unroll") for (int e = 0; e < 4; ++e) { float v = a[e]; v += __shfl_xor(v, 16); v += __shfl_xor(v, 32); if (lane < 16) red[(wave * 9 + r) * 64 + 4 * cgp + e] = v; } } while (0)
        RED9(a0, 0); RED9(a1, 1); RED9(a2, 2); RED9(a3, 3); RED9(a4, 4); RED9(a5, 5); RED9(a6, 6); RED9(a7, 7); RED9(a8, 8);
#undef RED9
        __syncthreads();
        float* mod = (float*)(ws + WS_MOD);
        for (int i = tid; i < 576; i += 512) { const int r = i >> 6, col = i & 63; float s = 0.f;
#pragma unroll
            for (int w = 0; w < 8; ++w) s += red[(w * 9 + r) * 64 + col];
            mod[r * NMOD + c0 + col] = s + kp->b_ada[c0 + col]; }
    }
    __syncthreads();
    const int gw = blockIdx.x * 8 + wave, NGW = G * 8;
    if (blockIdx.x == G - 1) {
        float* rt = (float*)(ws + WS_ROPE);
        for (int i = tid; i < 2048; i += 512) { const int pos = i >> 5, j = i & 31; const float invf = powf(10000.0f, -(float)(2 * j) / 64.0f); const float ang = (float)pos * invf;
            rt[2 * i] = cosf(ang); rt[2 * i + 1] = sinf(ang); }
    }
    constexpr int I_1IN = 32 * 88;
    for (int r = (gw + 1152) % NGW; r < I_1IN; r += NGW) { const int kb = r / 88, n0 = (r % 88) * 64; const int isup = n0 >= DFF, j = isup ? n0 - DFF : n0;
        transpose_item(kp->w_ffn1_in, 1024, 2 * DFF, (bf16_t*)(ws + WS_W1IN), kb, n0, 256 * (j >> 7) + (j & 127) + 128 * isup, lane); }
}

__device__ __forceinline__ void late_weights(const Params& kp_, LAS unsigned char* lds, int tid, int lane, int widx, int nw) {
    const Params* kp = &kp_; unsigned char* ws = kp->ws;
    LAS float* tab2048 = (LAS float*)(lds + LDS_MISC);
    LAS float* tab128 = (LAS float*)(lds + LDS_MISC + 8192);
    for (int i = tid; i < 2048; i += 512) tab2048[i] = cospif((float)i * (1.0f / 1024.0f));
    if (tid < 128) tab128[tid] = cospif((float)tid * (1.0f / 64.0f));
    __syncthreads();
    constexpr int I_FOLD = 1024, I_IN = 32 * 64, I_AB = 32 * 16, I_FB = 16 * 16, I_O = 32 * 16, I_1OUT = 88 * 16;
    for (int r = widx; r < I_1OUT; r += nw) { const int kb = r >> 4, n0 = (r & 15) * 64; transpose_item(kp->w_ffn1_out, DFF, 1024, (bf16_t*)(ws + WS_W1OUT), kb, n0, n0, lane); }
    {
        bf16_t* dft = (bf16_t*)(ws + WS_DFT);
        for (int e8 = widx * 64 + lane; e8 < 2048 * 512; e8 += nw * 64) {
            const int k = e8 >> 9, kp0 = (e8 & 511) * 8, cs = kp0 >> 11, n0 = kp0 & 2047; float v[8];
#pragma unroll
            for (int e = 0; e < 8; ++e) { int idx = (k * (n0 + e)) & 2047; if (cs) idx = (idx + 512) & 2047; v[e] = tab2048[idx] * (1.0f / 512.0f); }
            u32x4 o; o.x = cvt_pk_bf16(v[0], v[1]); o.y = cvt_pk_bf16(v[2], v[3]); o.z = cvt_pk_bf16(v[4], v[5]); o.w = cvt_pk_bf16(v[6], v[7]);
            *(u32x4*)(dft + (size_t)e8 * 8) = o;
        }
    }
    for (int r = widx; r < I_FOLD; r += nw) {
        const int jt = r & 7, g = (r >> 3) & 3, kb = r >> 5, k0 = kb * 32;
        const int jj = jt * 32 + (lane & 31), cs = jj >> 7, m = jj & 127, hi = lane >> 5;
        const float* wrow = kp->w_in + (size_t)(k0 + (lane & 31)) * 4096 + 1536 + g * 128 + hi;
        f32x16 acc = {};
#pragma unroll 8
        for (int s2 = 0; s2 < 64; ++s2) { const int c = 2 * s2 + hi; const float a = wrow[2 * s2]; int idx = (c * m) & 127; if (cs) idx = (idx + 96) & 127;
            acc = __builtin_amdgcn_mfma_f32_32x32x2f32(a, tab128[idx], acc, 0, 0, 0); }
        bf16_t* WfT = (bf16_t*)(ws + WS_WF) + (size_t)(cs * 512 + g * 128 + m) * 1024 + k0 + 4 * hi;
#pragma unroll
        for (int q = 0; q < 4; ++q) { u32x2 o; o.x = cvt_pk_bf16(acc[4 * q], acc[4 * q + 1]); o.y = cvt_pk_bf16(acc[4 * q + 2], acc[4 * q + 3]); *(u32x2*)(WfT + 8 * q) = o; }
    }
    for (int r = widx; r < I_IN; r += nw) { const int kb = r >> 6, n0 = (r & 63) * 64; if (n0 < 1536 || n0 >= 2048) transpose_item(kp->w_in, 1024, 4096, (bf16_t*)(ws + WS_WIN), kb, n0, n0 < 1536 ? n0 : n0 - 512, lane); }
    for (int r = widx; r < I_AB; r += nw) { const int kb = r >> 4, n0 = (r & 15) * 64; transpose_item(kp->w_ab, 1024, 1024, (bf16_t*)(ws + WS_WAB), kb, n0, n0, lane); }
    for (int r = widx; r < I_O; r += nw) { const int kb = r >> 4, n0 = (r & 15) * 64; transpose_item(kp->w_out, 1024, 1024, (bf16_t*)(ws + WS_WO), kb, n0, n0, lane); }
}

template <bool LAT_BF> __device__ __forceinline__ void norm_phase(const float* lat, const float* ctxp, const float* ctxp2, int nrows, const float* gain, const float* mod, int sh_off, int sc_off, bf16_t* A, int gw, int NGW, int lane) {
    for (int it = gw; it < nrows; it += NGW) {
        int r = it;
        if (LAT_BF && NGW == 2048 && it < NLAT) { const int j = it >> 11, g = it & 2047, cc = g >> 3, w = g & 7; r = (cc & 7) * 2048 + ((cc >> 3) * 8 + w) + 256 * j; }
        const bool isctx = r >= NLAT; const float* src = isctx ? ctxp + (size_t)(r - NLAT) * DM : lat + (size_t)r * DM; const int mrow = isctx ? 8 : (r >> 11);
        f32x4 v[4]; float ss = 0.f;
#pragma unroll
        for (int j = 0; j < 4; ++j) { if (LAT_BF && !isctx) { const u32x2 w = __builtin_nontemporal_load((const u32x2*)((const bf16_t*)lat + (size_t)r * DM + 4 * lane + 256 * j)); v[j] = (f32x4){__uint_as_float(w.x << 16), __uint_as_float(w.x & 0xffff0000u), __uint_as_float(w.y << 16), __uint_as_float(w.y & 0xffff0000u)}; } else v[j] = __builtin_nontemporal_load((const f32x4*)(src + 4 * lane + 256 * j)); if (isctx && ctxp2) v[j] += *(const f32x4*)(ctxp2 + (size_t)(r - NLAT) * DM + 4 * lane + 256 * j); ss += (v[j][0] * v[j][0] + v[j][1] * v[j][1]) + (v[j][2] * v[j][2] + v[j][3] * v[j][3]); }
        const float rstd = 1.0f / sqrtf(wave_sum(ss) * (1.0f / DM) + EPS);
        const float* mp = mod + mrow * NMOD;
#pragma unroll
        for (int j = 0; j < 4; ++j) { const int c = 4 * lane + 256 * j; const f32x4 g = *(const f32x4*)(gain + c), sh = *(const f32x4*)(mp + sh_off + c), sc = *(const f32x4*)(mp + sc_off + c);
            const f32x4 o = (v[j] * rstd) * g * (sc + 1.0f) + sh; u32x2 w; w.x = cvt_pk_bf16(o[0], o[1]); w.y = cvt_pk_bf16(o[2], o[3]);
            *(u32x2*)(A + (size_t)r * DM + c) = w; }
    }
}

__device__ __forceinline__ void fix_head(bf16_t* hp, const float* g, const float* ropetab, int n, bool rope, int lane) {
    float t1 = bf2f(hp[lane]), t2 = bf2f(hp[lane + 64]);
    const float rstd = 1.0f / sqrtf(wave_sum(t1 * t1 + t2 * t2) * (1.0f / 128.0f) + EPS);
    t1 = t1 * rstd * g[lane]; t2 = t2 * rstd * g[lane + 64];
    float o1 = t1, o2 = t2;
    if (rope) { const int pos = lane < 32 ? (n >> 6) : (n & 63); const float c = ropetab[2 * (pos * 32 + (lane & 31))], s = ropetab[2 * (pos * 32 + (lane & 31)) + 1]; o1 = t1 * c - t2 * s; o2 = t2 * c + t1 * s; }
    hp[lane] = f2bf(o1); hp[lane + 64] = f2bf(o2);
}
__device__ __forceinline__ void fixup_phase(unsigned char* ws, const float* q_norm, const float* k_norm, int gw, int NGW, int lane) {
    bf16_t* Q = (bf16_t*)(ws + WS_Q); bf16_t* Kb = (bf16_t*)(ws + WS_K); const float* rt = (const float*)(ws + WS_ROPE);
    for (int r = gw; r < NTOK; r += NGW) {
        if (r < NLAT) { const int b = r >> 11, n = r & 2047;
            for (int h = 0; h < 8; ++h) fix_head(Q + (size_t)r * DM + h * 128, q_norm, rt, n, true, lane);
            for (int h = 0; h < 2; ++h) fix_head(Kb + (size_t)(b * SKV + CTXL + n) * 256 + h * 128, k_norm, rt, n, true, lane);
        } else { const int rc = r - NLAT, b = rc >> 8, n = rc & 255;
            for (int h = 0; h < 2; ++h) fix_head(Kb + (size_t)(b * SKV + n) * 256 + h * 128, k_norm, rt, 0, false, lane); }
    }
}

constexpr int NSTEPS = 15;
__host__ __device__ constexpr bool sync_after(int st) { return !(st == 7 || st == 9); }

__global__ void __launch_bounds__(512, 2) mk_fwd(Params p) {
    extern __shared__ __attribute__((aligned(16))) unsigned char lds_raw[];
    LAS unsigned char* lds = (LAS unsigned char*)lds_raw;
    const int G = gridDim.x, c = blockIdx.x, NGW = G * 8;
    const int lo = p.st_lo, hi = p.st_hi;
    unsigned char* const ws = p.ws;
    const float* const mod = (const float*)(ws + WS_MOD);
    bf16_t* const Abuf = (bf16_t*)(ws + WS_A);
#define IN(k) (lo <= (k) && (k) < hi)
    volatile LAS unsigned* bst = (volatile LAS unsigned*)(lds + LDS_MISC + 12288);
    if (threadIdx.x < 2) bst[threadIdx.x] = 0u;
    __syncthreads();
    XcdBarrier gbar; gbar.bar = (unsigned*)(ws + WS_BAR); gbar.x = 0; gbar.st = bst;
    if (hi - lo > 1) gbar = xcd_barrier_post((unsigned*)(ws + WS_BAR), bst);
    if (hi < 0) cg::this_grid().sync();
#define SEAM(k) do { if (IN(k) && IN((k) + 1)) { if (sync_after(k)) xcd_barrier(gbar); else { __syncthreads(); } } } while (0)
#define TIDS() int tid = threadIdx.x; asm volatile("" : "+v"(tid)); const int lane = tid & 63, wave = __builtin_amdgcn_readfirstlane(tid >> 6), gw = c * 8 + wave; (void)lane; (void)gw
#define GEMM1P(PRM, KK, a, b, nm, nn, kd, rm) do { const pg8::Sched S{(a), nullptr, nullptr, (b), nullptr, nullptr, (nm), 1, 1, (nn), 1, 1, (kd), (kd), (kd), (nm) * (nn), 0, 0, G, c, (KK), 0, (KK) / 64, (KK) / 64, (KK) / 64, 0, 0}; \
        const pg8::Epi E{ws, p.out, p.x, p.ctx, (rm), p.k_norm, p.norm_ffn2, (const LAS float*)(lds + LDS_MISC)}; pg8::gemm_phase<true, true, PRM>(lds, S, E, tid); } while (0)
#define GEMM1(KK, a, b, nm, nn, kd, rm) GEMM1P(true, KK, a, b, nm, nn, kd, rm)
    if (IN(0)) { TIDS(); prep_phase(p, lds, tid, lane, wave, G); }
    SEAM(0);
    if (IN(1)) { TIDS(); norm_phase<false>(p.x, p.ctx, nullptr, NTOK, p.norm_ffn1, mod, 0 * DM, 1 * DM, Abuf, gw, NGW, lane); }
    SEAM(1);
    if (IN(2)) { TIDS(); GEMM1(1024, Abuf, (const bf16_t*)(ws + WS_W1IN), NTOK / 256, 22, pg8::K_SWIGLU, 0);
        constexpr int NBUSY = (NTOK / 256) * 22 - 6 * 256;
        int t2 = threadIdx.x; asm volatile("" : "+v"(t2)); const int w2 = __builtin_amdgcn_readfirstlane(t2 >> 6);
        if (G == 256 && c >= NBUSY) late_weights(p, lds, t2, t2 & 63, (c - NBUSY) * 8 + w2, (256 - NBUSY) * 8);
        else if (G != 256) late_weights(p, lds, t2, t2 & 63, c * 8 + w2, NGW); }
    SEAM(2);
    if (IN(3)) { TIDS();
        const bf16_t* Hc = (const bf16_t*)(ws + WS_H) + (size_t)NLAT * DFF;
        const pg8::Sched S{(const bf16_t*)(ws + WS_H), Hc, Hc, (const bf16_t*)(ws + WS_W1OUT), (const bf16_t*)(ws + WS_W1OUT), (const bf16_t*)(ws + WS_W1OUT),
                           64, 8, 8, 4, 4, 4, pg8::K_RES, pg8::K_RESC0, pg8::K_RESC1, 256, 32, 32, G, c, DFF, 0, 44, 22, 22, 0, DFF / 2};
        const pg8::Epi E{ws, p.out, p.x, p.ctx, 0, p.k_norm, p.norm_ffn2, (const LAS float*)(lds + LDS_MISC)}; pg8::gemm_phase<true, true>(lds, S, E, tid); }
    SEAM(3);
    if (IN(4)) { TIDS(); norm_phase<true>(p.out, (const float*)(ws + WS_CTX1), (const float*)(ws + WS_CTX1B), NTOK, p.norm_mix, mod, 3 * DM, 4 * DM, Abuf, gw, NGW, lane); }
    SEAM(4);
    if (IN(5)) { TIDS();
        const pg8::Sched S{Abuf, (const bf16_t*)(ws + WS_WF), Abuf + (size_t)NLAT * DM, (const bf16_t*)(ws + WS_WIN), Abuf, (const bf16_t*)(ws + WS_WIN) + (size_t)1024 * DM,
                           64, 4, 8, 14, 64, 2, pg8::K_INPROJ, pg8::K_FTSWAP, pg8::K_CTXKV, 64 * 14, 256, 16, G, c, 1024, 0, 16, 16, 16, 0, 0};
        const pg8::Epi E{ws, p.out, p.x, p.ctx, 0, p.k_norm, p.norm_ffn2, (const LAS float*)(lds + LDS_MISC)}; pg8::gemm_phase<true, true>(lds, S, E, tid);
        if (G == 256 && c >= 144) {
            int t2 = threadIdx.x; asm volatile("" : "+v"(t2)); const int lane = t2 & 63;
            const int w2 = (c - 144) * 8 + __builtin_amdgcn_readfirstlane(t2 >> 6), nw2 = 112 * 8;
            for (int r = w2; r < 32 * 88; r += nw2) { const int kb = r / 88, n0 = (r % 88) * 64; const int isup = n0 >= DFF, j = isup ? n0 - DFF : n0;
                transpose_item(p.w_ffn2_in, 1024, 2 * DFF, (bf16_t*)(ws + WS_W2IN), kb, n0, 256 * (j >> 7) + (j & 127) + 128 * isup, lane); }
            for (int r = w2; r < 88 * 16; r += nw2) { const int kb = r >> 4, n0 = (r & 15) * 64; transpose_item(p.w_ffn2_out, DFF, 1024, (bf16_t*)(ws + WS_W2OUT), kb, n0, n0, lane); }
            for (int r = w2; r < 2 * 16 * 16; r += nw2) { const int hf = r >> 8, q = r & 255, kb = q >> 4, n0 = (q & 15) * 64;
                transpose_item(p.w_fb, 512, 1024, (bf16_t*)(ws + WS_WFB2) + hf * 512, kb, n0, n0, lane, 1024); }
        } }
    if (IN(5) && IN(7)) xcd_barrier(gbar);
    if (IN(7)) { TIDS();
        const pg8::Sched S{(const bf16_t*)(ws + WS_DFT), (const bf16_t*)(ws + WS_DFT), nullptr, (const bf16_t*)(ws + WS_FT), (const bf16_t*)(ws + WS_FT), nullptr, 8, 8, 1, 16, 16, 1, pg8::K_FOUR2, pg8::K_FOUR2, pg8::K_FOUR2, 128, 128, 0, G, c, 4096, 1, 32, 32, 32, 2048, 0};
        const pg8::Epi E{ws, p.out, p.x, p.ctx, 0, p.k_norm, p.norm_ffn2, (const LAS float*)(lds + LDS_MISC)}; pg8::gemm_phase<true, true>(lds, S, E, tid); }
    SEAM(7);
    if (IN(8)) { TIDS();
        const int x = c & 7, s = c >> 3; const int j0 = 2 * s; int nj = 2; asm volatile("" : "+s"(nj));
#pragma unroll 1
        for (int i = 0; i < nj; ++i) { const int j = j0 + i, kvh = j >> 5, h = kvh * 4 + ((j >> 3) & 3), qb = j & 7;
            att::bf16* Qb = (att::bf16*)(ws + WS_Q) + (size_t)(x * SEQ + qb * 256) * DM + h * 128;
            const att::bf16* Kh = (const att::bf16*)(ws + WS_K) + (size_t)x * SKV * 256 + kvh * 128;
            const att::bf16* Vh = (const att::bf16*)(ws + WS_V) + (size_t)x * SKV * 256 + kvh * 128;
            const int tu = tid;
            att::attn_unit(Qb, Kh, Vh, Qb, SKV, (char*)lds_raw, tu, p.q_norm, (const float*)(ws + WS_ROPE), qb * 256); }
        {
            int t2 = threadIdx.x; asm volatile("" : "+v"(t2)); const int ln = t2 & 63, wv = __builtin_amdgcn_readfirstlane(t2 >> 6);
            const bf16_t* W2 = (const bf16_t*)(ws + WS_W2IN); float* sw3 = (float*)(ws + WS_SW3);
            for (int n = c * 8 + wv; n < 2 * DFF; n += NGW) {
                const u32x4 w0 = *(const u32x4*)(W2 + (size_t)n * DM + 8 * ln), w1 = *(const u32x4*)(W2 + (size_t)n * DM + 512 + 8 * ln);
                f32x4 a0, a1, a2, a3; unpack8(w0, a0, a1); unpack8(w1, a2, a3);
#pragma unroll
                for (int b = 0; b < 8; ++b) { const float* sh = mod + b * NMOD + 6 * DM + 8 * ln;
                    const f32x4 s0 = *(const f32x4*)sh, s1 = *(const f32x4*)(sh + 4), s2 = *(const f32x4*)(sh + 512), s3 = *(const f32x4*)(sh + 516);
                    const f32x4 pr = a0 * s0 + a1 * s1 + a2 * s2 + a3 * s3; const float d = wave_sum((pr[0] + pr[1]) + (pr[2] + pr[3]));
                    if (ln == 0) sw3[b * (2 * DFF) + n] = d; }
            }
        }
    }
    SEAM(8);
    if (IN(9)) { TIDS();
        const pg8::Sched S{(const bf16_t*)(ws + WS_Q), (const bf16_t*)(ws + WS_YF), nullptr, (const bf16_t*)(ws + WS_WAB), (const bf16_t*)(ws + WS_WFB2), nullptr,
                           64, 64, 1, 4, 4, 1, pg8::K_BRA, pg8::K_BRB, pg8::K_BRB, 256, 256, 0, G, c, 1024, 2, 16, 16, 16, 0, 0};
        const pg8::Epi E{ws, p.out, p.x, p.ctx, 0, p.k_norm, p.norm_ffn2, (const LAS float*)(lds + LDS_MISC)}; pg8::gemm_phase<true, true>(lds, S, E, tid); }
    SEAM(9);
    SEAM(10);
    if (IN(11)) { TIDS(); GEMM1(1024, (const bf16_t*)(ws + WS_GA), (const bf16_t*)(ws + WS_WO), 64, 4, pg8::K_RES, 1); }
    if (IN(11) && IN(13)) xcd_barrier(gbar);
    if (IN(13)) { TIDS();
        {
            LAS float* rs = (LAS float*)(lds + LDS_MISC); const float* st3 = (const float*)(ws + WS_ST3) + (size_t)(c & 7) * 2048 * 16;
            for (int r = tid; r < 2048; r += 512) { const f32x4* sp = (const f32x4*)(st3 + (size_t)r * 16); const f32x4 q = (sp[0] + sp[1]) + (sp[2] + sp[3]);
                rs[r] = 1.0f / sqrtf(((q[0] + q[1]) + (q[2] + q[3])) * (1.0f / DM) + EPS); }
            __syncthreads();
        }
        GEMM1(1024, Abuf, (const bf16_t*)(ws + WS_W2IN), 64, 22, pg8::K_SWIGLU, 3); }
    SEAM(13);
    if (IN(14)) { TIDS(); GEMM1(DFF, (const bf16_t*)(ws + WS_H), (const bf16_t*)(ws + WS_W2OUT), 64, 4, pg8::K_RES, 2); }
#undef IN
#undef SEAM
#undef TIDS
#undef GEMM1
#undef GEMM1P
}

extern "C" void kernel_launch(void* const* d_in, const int* in_sizes, int n_in, void* d_out, int out_size, void* d_ws, size_t ws_size, hipStream_t stream) {
    static int grid = 0;
    if (grid == 0) {
        if (n_in != 19 || out_size != NLAT * DM || ws_size < WS_END) { fprintf(stderr, "kernel_launch: unexpected shapes (n_in %d out %d ws %zu)\n", n_in, out_size, ws_size); grid = -1; return; }
        int dev = 0, cus = 0, per_cu = 0;
        hipGetDevice(&dev); hipDeviceGetAttribute(&cus, hipDeviceAttributeMultiprocessorCount, dev);
        if (hipFuncSetAttribute((const void*)mk_fwd, hipFuncAttributeMaxDynamicSharedMemorySize, LDS_BYTES) != hipSuccess) { fprintf(stderr, "kernel_launch: hipFuncSetAttribute failed\n"); grid = -1; return; }
        hipOccupancyMaxActiveBlocksPerMultiprocessor(&per_cu, (const void*)mk_fwd, 512, LDS_BYTES);
        (void)hipGetLastError();
        if (cus != 256 || per_cu < 1) fprintf(stderr, "kernel_launch: note: cus %d per_cu %d (built for 256 x 1)\n", cus, per_cu);
        grid = 256;
    }
    if (grid < 0) return;
    Params p{};
    const float** pp = (const float**)&p;
    for (int i = 0; i < 19; ++i) pp[i] = (const float*)d_in[i];
    p.out = (float*)d_out; p.ws = (unsigned char*)d_ws;
    if (hipMemsetAsync((char*)d_ws + WS_BAR, 0, BAR_BYTES, stream) != hipSuccess) { fprintf(stderr, "kernel_launch: memset failed\n"); return; }
#if MK_MULTI
    int lo = 0;
    for (int st = 0; st < NSTEPS; ++st) {
        if (sync_after(st) || st == NSTEPS - 1) { p.st_lo = lo; p.st_hi = st + 1; hipLaunchKernelGGL(mk_fwd, dim3(grid), dim3(512), LDS_BYTES, stream, p); lo = st + 1; }
    }
#else
    p.st_lo = 0; p.st_hi = NSTEPS;
    void* args[] = {&p};
    hipError_t e = hipLaunchCooperativeKernel((const void*)mk_fwd, dim3(grid), dim3(512), args, LDS_BYTES, stream);
    if (e != hipSuccess) fprintf(stderr, "cooperative launch failed: %s\n", hipGetErrorString(e));
#endif
}
```

```cpp
#include <hip/hip_runtime.h>
#include <hip/hip_cooperative_groups.h>
#include <hip/hip_bf16.h>
#include <cstdio>
#include <cstdint>
namespace cg = cooperative_groups;

#ifndef MK_MULTI
#define MK_MULTI 0
#endif

#define LAS __attribute__((address_space(3)))
typedef unsigned short bf16_t;
typedef short bf16x8 __attribute__((ext_vector_type(8)));
typedef float f32x4 __attribute__((ext_vector_type(4)));
typedef float f32x16 __attribute__((ext_vector_type(16)));
typedef unsigned u32x4 __attribute__((ext_vector_type(4)));
typedef unsigned u32x2 __attribute__((ext_vector_type(2)));
typedef short s16x4 __attribute__((ext_vector_type(4)));

constexpr int DM = 1024, NB = 8, SEQ = 2048, CTXL = 256, NLAT = NB * SEQ, NCTX = NB * CTXL, NTOK = NLAT + NCTX;
constexpr int DFF = 2816, NMOD = 9 * DM, SKV = CTXL + SEQ;
constexpr float EPS = 1e-6f;

constexpr size_t MiB = 1u << 20;
constexpr size_t WS_MOD = 0, WS_ROPE = 384 * 1024, WS_BAR = 512 * 1024, WS_CNT = WS_BAR + 16384, BAR_BYTES = 16384 + 65536;
constexpr size_t WS_W1IN = 1 * MiB, WS_W1OUT = 12 * MiB, WS_WIN = 18 * MiB, WS_WF = 25 * MiB, WS_WAB = 27 * MiB, WS_WFB = 29 * MiB, WS_WO = 30 * MiB;
constexpr size_t WS_W2IN = 32 * MiB, WS_W2OUT = 43 * MiB, WS_DFT = 49 * MiB, WS_A = 65 * MiB, WS_CTX1 = 101 * MiB, WS_H = 109 * MiB;
constexpr size_t WS_Q = 109 * MiB, WS_K = 141 * MiB, WS_V = 150 * MiB, WS_GA = 159 * MiB, WS_GF = 191 * MiB, WS_FT = 223 * MiB, WS_YF = WS_A, WS_CTX1B = WS_FT, WS_X2 = WS_FT, WS_WFB2 = WS_W1IN, WS_ST3 = WS_CTX1, WS_SW3 = WS_CTX1 + 2 * MiB, WS_END = 255 * MiB;

constexpr int LDS_BYTES = 147456;
constexpr int LDS_MISC = 131072;

__device__ __forceinline__ unsigned cvt_pk_bf16(float lo, float hi) { unsigned r; asm volatile("v_cvt_pk_bf16_f32 %0, %1, %2" : "=v"(r) : "v"(lo), "v"(hi)); return r; }
__device__ __forceinline__ u32x4 pack8(f32x4 a, f32x4 b) { u32x4 w; w.x = cvt_pk_bf16(a[0], a[1]); w.y = cvt_pk_bf16(a[2], a[3]); w.z = cvt_pk_bf16(b[0], b[1]); w.w = cvt_pk_bf16(b[2], b[3]); return w; }
__device__ __forceinline__ void st16_wt(void* p, u32x4 v) {
    asm volatile("global_store_dwordx4 %0, %1, off sc1\n\ts_nop 1" :: "v"(p), "v"(v) : "memory");
}
__device__ __forceinline__ void unpack8(u32x4 w, f32x4& a, f32x4& b) {
    a[0] = __uint_as_float(w.x << 16); a[1] = __uint_as_float(w.x & 0xffff0000u); a[2] = __uint_as_float(w.y << 16); a[3] = __uint_as_float(w.y & 0xffff0000u);
    b[0] = __uint_as_float(w.z << 16); b[1] = __uint_as_float(w.z & 0xffff0000u); b[2] = __uint_as_float(w.w << 16); b[3] = __uint_as_float(w.w & 0xffff0000u); }
__device__ __forceinline__ float bf2f(bf16_t v) { return __uint_as_float((unsigned)v << 16); }
__device__ __forceinline__ bf16_t f2bf(float f) { unsigned u = __float_as_uint(f); return (bf16_t)((u + 0x7fffu + ((u >> 16) & 1u)) >> 16); }
__device__ __forceinline__ float sigmoidf_(float v) { return __builtin_amdgcn_rcpf(1.f + __builtin_amdgcn_exp2f(-1.4426950408889634f * v)); }
__device__ __forceinline__ float wave_sum(float v) {
#pragma unroll
    for (int o = 1; o < 64; o <<= 1) v += __shfl_xor(v, o);
    return v;
}

namespace pg8 {
constexpr int BM = 256, BK = 64, HALF = 128, HTB = HALF * BK * 2, STAGE_BYTES = 8 * HTB, NXCD = 8, WGM = 8;
__host__ __device__ __forceinline__ int lds_byte(int r, int c) { const int st = (r >> 4) * 2 + (c >> 5), rr = r & 15, cc = c & 31, ob = rr * 64 + cc * 2; return st * 1024 + (ob ^ (((ob >> 9) & 1) << 5)); }
__host__ __device__ __forceinline__ void stage_rc(int b, int& R, int& C) { const int st = b / 1024, sb = b % 1024, swz = sb ^ (((sb >> 9) & 1) << 5); R = (st >> 1) * 16 + swz / 64; C = (st & 1) * 32 + (swz % 64) / 2; }
__host__ __device__ __forceinline__ int perm32(int rho) { const int n = rho >> 4, i = rho & 15; return 8 * (i >> 2) + 4 * n + (i & 3); }

struct Unit { int pm, pn, sub; };
enum Kind { K_SWIGLU = 0, K_RES = 1, K_INPROJ = 2, K_FTSWAP = 3, K_CTXKV = 4, K_FOUR2 = 5, K_BRA = 6, K_BRB = 7, K_RESC0 = 8, K_RESC1 = 9 };

struct Sched {
    const bf16_t *A0, *A1, *A2, *B0, *B1, *B2; int nM0, nM1, nM2, nN0, nN1, nN2, k0, k1, k2; int n0, n1, n2; int G, c, K, direct; int kt0, kt1, kt2, ko1, ko2;
    static __device__ __forceinline__ int sel3(int sub, int v0, int v1, int v2) { const int m1 = -(int)(sub == 1), m2 = -(int)(sub == 2); return v0 ^ ((v0 ^ v1) & m1) ^ ((v0 ^ v2) & m2); }
    static __device__ __forceinline__ unsigned long long sel3p(int sub, const void* p0, const void* p1, const void* p2) {
        const unsigned long long v0 = (unsigned long long)p0, v1 = (unsigned long long)p1, v2 = (unsigned long long)p2, m1 = -(unsigned long long)(sub == 1), m2 = -(unsigned long long)(sub == 2);
        return v0 ^ ((v0 ^ v1) & m1) ^ ((v0 ^ v2) & m2); }
    __device__ __forceinline__ bool next(int i, Unit& u) const {
        if (direct == 1) { if (i > 0) return false; const int x = c & 7, s = c >> 3; u.sub = s >> 4; u.pm = s & 7; u.pn = 2 * x + ((s >> 3) & 1); return true; }
        if (direct == 2) {
            if (i > 1 || c >= n0) return false; u.sub = i;
            const int nwg = nM0 * nN0; int wgid; { const int q = nwg / NXCD, r = nwg % NXCD, xcd = c % NXCD, off = c / NXCD; wgid = (xcd < r ? xcd * (q + 1) : r * (q + 1) + (xcd - r) * q) + off; }
            const int nig = WGM * nN0, gid = wgid / nig, fm = gid * WGM, gsz = (nM0 - fm) < WGM ? (nM0 - fm) : WGM;
            u.pm = fm + ((wgid % nig) % gsz); u.pn = (wgid % nig) / gsz; return true; }
        const long L = (long)i * G + c;
        if (L >= n0 + n1 + n2) return false;
        const int sub = (L >= n0) + (L >= n0 + n1); u.sub = sub;
        const int l = (int)L - sel3(sub, 0, n0, n0 + n1), nM = sel3(sub, nM0, nM1, nM2), nN = sel3(sub, nN0, nN1, nN2);
        const int nwg = nM * nN; int wgid; { const int q = nwg / NXCD, r = nwg % NXCD, xcd = l % NXCD, off = l / NXCD; wgid = (xcd < r ? xcd * (q + 1) : r * (q + 1) + (xcd - r) * q) + off; }
        const int nig = WGM * nN, gid = wgid / nig, fm = gid * WGM, gsz = (nM - fm) < WGM ? (nM - fm) : WGM;
        u.pm = fm + ((wgid % nig) % gsz); u.pn = (wgid % nig) / gsz; return true;
    }
    __device__ __forceinline__ const char* aptr(const Unit& u) const { return (const char*)sel3p(u.sub, A0, A1, A2) + (size_t)u.pm * (size_t)(512 * K) + 2 * sel3(u.sub, 0, ko1, ko2); }
    __device__ __forceinline__ const char* bptr(const Unit& u) const { return (const char*)sel3p(u.sub, B0, B1, B2) + (size_t)u.pn * (size_t)(512 * K) + 2 * sel3(u.sub, 0, ko1, ko2); }
    __device__ __forceinline__ int ktiles(const Unit& u) const { return sel3(u.sub, kt0, kt1, kt2); }
    __device__ __forceinline__ int kind(const Unit& u) const { return sel3(u.sub, k0, k1, k2); }
};

struct Epi {
    unsigned char* ws; float* out; const float* x; const float* ctx; int res_mode; const float* kg; const float* ng; const LAS float* rs;
    template <bool PERM> __device__ __forceinline__ void run(f32x4 (&acc)[2][2][4][2], const Unit& u, int kind, int wr, int wc, int fr_in, int fq_in) const {
        int fr = fr_in, fq = fq_in; asm volatile("" : "+v"(fr), "+v"(fq));
        const int rowt = u.pm * 256 + wr * 64 + fr;
        const int cw = wc * 32 + 8 * fq;
        if (kind == K_SWIGLU) {
            bf16_t* H = (bf16_t*)(ws + WS_H);
            const bool fn = (res_mode == 3);
            f32x4 sg[2], su[2];
            if (fn) { const float* sw = (const float*)(ws + WS_SW3) + (u.pm >> 3) * (2 * DFF) + u.pn * 256 + cw;
#pragma unroll
                for (int n = 0; n < 2; ++n) { sg[n] = *(const f32x4*)(sw + 4 * n); su[n] = *(const f32x4*)(sw + 128 + 4 * n); } }
#pragma unroll
            for (int ai = 0; ai < 2; ++ai)
#pragma unroll
                for (int m = 0; m < 4; ++m) {
                    const int row = rowt + ai * 128 + m * 16; f32x4 h[2];
                    const float rstd = fn ? rs[row & 2047] : 1.f;
#pragma unroll
                    for (int n = 0; n < 2; ++n) { f32x4 g = acc[ai][0][m][n], up = acc[ai][1][m][n]; if (fn) { g = g * rstd + sg[n]; up = up * rstd + su[n]; }
#pragma unroll
                        for (int e = 0; e < 4; ++e) h[n][e] = g[e] * sigmoidf_(g[e]) * up[e]; }
                    *(u32x4*)(H + (size_t)row * DFF + u.pn * 128 + cw) = pack8(h[0], h[1]);
                }
        } else if (kind == K_RES || kind == K_RESC0 || kind == K_RESC1) {
            const float* mod = (const float*)(ws + WS_MOD);
            const bool isctx = kind != K_RES, nobase = kind == K_RESC1;
            const bool in_bf = (res_mode != 0), out_bf = (res_mode == 1) || (res_mode == 0 && !isctx);
            const float* basef = isctx ? ctx : x; float* dstf = isctx ? (float*)(ws + (nobase ? WS_CTX1B : WS_CTX1)) : out;
            const bf16_t* baseb = res_mode == 1 ? (const bf16_t*)out : (const bf16_t*)(ws + WS_X2); bf16_t* dstb = res_mode == 0 ? (bf16_t*)out : (bf16_t*)(ws + WS_X2);
            const int gate_off = res_mode == 0 ? 2 * DM : (res_mode == 1 ? 5 * DM : 8 * DM); const float coef = res_mode == 1 ? 1.f : 0.5f;
            const int mrow = isctx ? 8 : (u.pm >> 3);
            const float* gp = mod + mrow * NMOD + gate_off + u.pn * 256 + cw;
            f32x4 gv[2][2], gg[2][2];
#pragma unroll
            for (int bj = 0; bj < 2; ++bj)
#pragma unroll
                for (int n = 0; n < 2; ++n) { gv[bj][n] = *(const f32x4*)(gp + bj * 128 + 4 * n) * coef; gg[bj][n] = gv[bj][n];
                    if (res_mode == 1) gg[bj][n] = *(const f32x4*)(ng + u.pn * 256 + cw + bj * 128 + 4 * n) * (*(const f32x4*)(mod + mrow * NMOD + 7 * DM + u.pn * 256 + cw + bj * 128 + 4 * n) + 1.0f); }
#pragma unroll
            for (int ai = 0; ai < 2; ++ai) {
                f32x4 bv[4][2][2];
#pragma unroll
                for (int m = 0; m < 4; ++m) { const size_t off = (size_t)(rowt + ai * 128 + m * 16) * DM + u.pn * 256 + cw;
#pragma unroll
                    for (int bj = 0; bj < 2; ++bj) {
                        if (in_bf) unpack8(__builtin_nontemporal_load((const u32x4*)(baseb + off + bj * 128)), bv[m][bj][0], bv[m][bj][1]);
                        else if (nobase) { bv[m][bj][0] = (f32x4){0.f, 0.f, 0.f, 0.f}; bv[m][bj][1] = bv[m][bj][0]; }
                        else { bv[m][bj][0] = __builtin_nontemporal_load((const f32x4*)(basef + off + bj * 128)); bv[m][bj][1] = __builtin_nontemporal_load((const f32x4*)(basef + off + bj * 128 + 4)); } } }
#pragma unroll
                for (int m = 0; m < 4; ++m) { const size_t off = (size_t)(rowt + ai * 128 + m * 16) * DM + u.pn * 256 + cw; float ss = 0.f;
#pragma unroll
                    for (int bj = 0; bj < 2; ++bj) { const f32x4 v0 = bv[m][bj][0] + gv[bj][0] * acc[ai][bj][m][0], v1 = bv[m][bj][1] + gv[bj][1] * acc[ai][bj][m][1];
                        if (out_bf) *(u32x4*)(dstb + off + bj * 128) = pack8(v0, v1);
                        else { *(f32x4*)(dstf + off + bj * 128) = v0; *(f32x4*)(dstf + off + bj * 128 + 4) = v1; }
                        if (res_mode == 1) {
                            *(u32x4*)((bf16_t*)(ws + WS_A) + off + bj * 128) = pack8(v0 * gg[bj][0], v1 * gg[bj][1]);
                            ss += (v0[0] * v0[0] + v0[1] * v0[1]) + (v0[2] * v0[2] + v0[3] * v0[3]) + (v1[0] * v1[0] + v1[1] * v1[1]) + (v1[2] * v1[2] + v1[3] * v1[3]); } }
                    if (res_mode == 1) { ss += __shfl_xor(ss, 16); ss += __shfl_xor(ss, 32);
                        if (fq == 0) ((float*)(ws + WS_ST3))[(size_t)(rowt + ai * 128 + m * 16) * 16 + u.pn * 4 + wc] = ss; } }
            }
        } else if (kind == K_INPROJ || kind == K_CTXKV) {
            bf16_t* dstb; int ld, rowadd, colb; bool sig = false;
            if (kind == K_INPROJ) {
                const int pn = u.pn;
                if (pn < 4) { dstb = (bf16_t*)(ws + WS_Q); ld = DM; rowadd = 0; colb = pn * 256; }
                else if (pn < 6) { dstb = (bf16_t*)(ws + (pn == 4 ? WS_K : WS_V)); ld = 256; rowadd = 256 * ((u.pm >> 3) + 1); colb = 0; }
                else if (pn < 10) { dstb = (bf16_t*)(ws + WS_GA); ld = DM; rowadd = 0; colb = (pn - 6) * 256; sig = true; }
                else { dstb = (bf16_t*)(ws + WS_GF); ld = DM; rowadd = 0; colb = (pn - 10) * 256; sig = true; }
            } else { dstb = (bf16_t*)(ws + (u.pn == 0 ? WS_K : WS_V)); ld = 256; rowadd = u.pm * (SKV - CTXL); colb = 0; }
#pragma unroll
            for (int ai = 0; ai < 2; ++ai)
#pragma unroll
                for (int m = 0; m < 4; ++m) {
                    const int row = rowt + ai * 128 + m * 16 + rowadd;
#pragma unroll
                    for (int bj = 0; bj < 2; ++bj) { f32x4 a = acc[ai][bj][m][0], b = acc[ai][bj][m][1];
                        if (sig) {
#pragma unroll
                            for (int e = 0; e < 4; ++e) { a[e] = sigmoidf_(a[e]); b[e] = sigmoidf_(b[e]); } }
                        *(u32x4*)(dstb + (size_t)row * ld + colb + bj * 128 + cw) = pack8(a, b); }
                }
            const bool isk = (kind == K_INPROJ) ? (u.pn == 4) : (u.pn == 0);
            if (isk) {
                asm volatile("s_waitcnt vmcnt(0)" ::: "memory"); __builtin_amdgcn_s_barrier(); asm volatile("" ::: "memory");
                const float* rt = (const float*)(ws + WS_ROPE); const bool rope = (kind == K_INPROJ);
                const int lane = fq * 16 + fr, wid = wr * 4 + wc, l16 = lane & 15;
                const f32x4 g1 = *(const f32x4*)(kg + 4 * l16), g2 = *(const f32x4*)(kg + 64 + 4 * l16);
#pragma unroll 4
                for (int it = 0; it < 16; ++it) { const int item = it * 32 + wid * 4 + (lane >> 4), r = item >> 1, hd = item & 1;
                    bf16_t* hp = dstb + (size_t)(u.pm * 256 + r + rowadd) * 256 + hd * 128 + 4 * l16;
                    const u32x2 w1 = *(const u32x2*)hp, w2 = *(const u32x2*)(hp + 64);
                    f32x4 t1 = {__uint_as_float(w1.x << 16), __uint_as_float(w1.x & 0xffff0000u), __uint_as_float(w1.y << 16), __uint_as_float(w1.y & 0xffff0000u)};
                    f32x4 t2 = {__uint_as_float(w2.x << 16), __uint_as_float(w2.x & 0xffff0000u), __uint_as_float(w2.y << 16), __uint_as_float(w2.y & 0xffff0000u)};
                    float ss = (t1[0] * t1[0] + t1[1] * t1[1]) + (t1[2] * t1[2] + t1[3] * t1[3]) + (t2[0] * t2[0] + t2[1] * t2[1]) + (t2[2] * t2[2] + t2[3] * t2[3]);
                    ss += __shfl_xor(ss, 1); ss += __shfl_xor(ss, 2); ss += __shfl_xor(ss, 4); ss += __shfl_xor(ss, 8);
                    const float rstd = 1.0f / sqrtf(ss * (1.0f / 128.0f) + EPS);
                    t1 = t1 * rstd * g1; t2 = t2 * rstd * g2;
                    if (rope) { const int n = ((u.pm & 7) * 256 + r); const int pos = l16 < 8 ? (n >> 6) : (n & 63); const float* rp = rt + 2 * (pos * 32 + ((4 * l16) & 31));
                        const f32x4 c0 = *(const f32x4*)rp, c1 = *(const f32x4*)(rp + 4); f32x4 o1, o2;
                        o1[0] = t1[0] * c0[0] - t2[0] * c0[1]; o2[0] = t2[0] * c0[0] + t1[0] * c0[1]; o1[1] = t1[1] * c0[2] - t2[1] * c0[3]; o2[1] = t2[1] * c0[2] + t1[1] * c0[3];
                        o1[2] = t1[2] * c1[0] - t2[2] * c1[1]; o2[2] = t2[2] * c1[0] + t1[2] * c1[1]; o1[3] = t1[3] * c1[2] - t2[3] * c1[3]; o2[3] = t2[3] * c1[2] + t1[3] * c1[3];
                        t1 = o1; t2 = o2; }
                    u32x2 q1, q2; q1.x = cvt_pk_bf16(t1[0], t1[1]); q1.y = cvt_pk_bf16(t1[2], t1[3]); q2.x = cvt_pk_bf16(t2[0], t2[1]); q2.y = cvt_pk_bf16(t2[2], t2[3]);
                    *(u32x2*)hp = q1; *(u32x2*)(hp + 64) = q2; }
            }
        } else if (kind == K_FTSWAP) {
            bf16_t* FT = (bf16_t*)(ws + WS_FT);
#pragma unroll
            for (int ai = 0; ai < 2; ++ai)
#pragma unroll
                for (int m = 0; m < 4; ++m) {
                    const int j = rowt + ai * 128 + m * 16; const int cs = j >> 9, g = (j >> 7) & 3, mm = j & 127;
#pragma unroll
                    for (int bj = 0; bj < 2; ++bj) { const int t0 = u.pn * 256 + bj * 128 + cw; const int b = t0 >> 11, n = t0 & 2047;
                        *(u32x4*)(FT + ((size_t)((b * 4 + g) * 128 + mm)) * 4096 + cs * 2048 + n) = pack8(acc[ai][bj][m][0], acc[ai][bj][m][1]); }
                }
        } else if (kind == K_FOUR2) {
            bf16_t* YF = (bf16_t*)(ws + WS_YF);
            unsigned* flag = (unsigned*)(ws + WS_CNT) + (size_t)(u.pm * 16 + u.pn) * 64;
            const int lane = fq * 16 + fr, wid = wr * 4 + wc;
            if (u.sub == 0) {
#pragma unroll
                for (int ai = 0; ai < 2; ++ai)
#pragma unroll
                    for (int m = 0; m < 4; ++m) { const int k = rowt + ai * 128 + m * 16;
#pragma unroll
                        for (int bj = 0; bj < 2; ++bj) { const int c = u.pn * 256 + bj * 128 + cw; const int b = c >> 9, cc = c & 511;
                            st16_wt(YF + (size_t)(b * SEQ + k) * 1024 + 512 + cc, pack8(acc[ai][bj][m][0], acc[ai][bj][m][1])); } }
                asm volatile("s_waitcnt vmcnt(0)" ::: "memory");
                if (lane == 0) __hip_atomic_fetch_add(flag, 1u, __ATOMIC_RELAXED, __HIP_MEMORY_SCOPE_AGENT);
            } else {
                if (wid == 0) { unsigned sp = 0;
                    while ((unsigned)__builtin_amdgcn_readfirstlane(__hip_atomic_load(flag, __ATOMIC_RELAXED, __HIP_MEMORY_SCOPE_AGENT)) < 8u) { __builtin_amdgcn_s_sleep(2); if (++sp > (1u << 13)) break; }
                    __builtin_amdgcn_fence(__ATOMIC_ACQUIRE, "agent"); asm volatile("s_waitcnt vmcnt(0)" ::: "memory"); }
                asm volatile("" ::: "memory"); __builtin_amdgcn_s_barrier(); asm volatile("" ::: "memory");
#pragma unroll
                for (int ai = 0; ai < 2; ++ai) {
                    u32x4 pc[4][2];
#pragma unroll
                    for (int m = 0; m < 4; ++m) { const int k = rowt + ai * 128 + m * 16;
#pragma unroll
                        for (int bj = 0; bj < 2; ++bj) { const int c = u.pn * 256 + bj * 128 + cw; const int b = c >> 9, cc = c & 511;
                            pc[m][bj] = __builtin_nontemporal_load((const u32x4*)(YF + (size_t)(b * SEQ + k) * 1024 + 512 + cc)); } }
#pragma unroll
                    for (int m = 0; m < 4; ++m) { const int k = rowt + ai * 128 + m * 16;
#pragma unroll
                        for (int bj = 0; bj < 2; ++bj) { const int c = u.pn * 256 + bj * 128 + cw; const int b = c >> 9, cc = c & 511; f32x4 p0, p1; unpack8(pc[m][bj], p0, p1);
                            *(u32x4*)(YF + (size_t)(b * SEQ + k) * 1024 + cc) = pack8(p0 + acc[ai][bj][m][0], p1 + acc[ai][bj][m][1]); } }
                }
            }
        } else {
            bf16_t* GA = (bf16_t*)(ws + WS_GA); const bf16_t* GF = (const bf16_t*)(ws + WS_GF);
#pragma unroll
            for (int ai = 0; ai < 2; ++ai) {
                u32x4 ra[4][2], rf[4][2];
#pragma unroll
                for (int m = 0; m < 4; ++m) { const size_t off = (size_t)(rowt + ai * 128 + m * 16) * DM + u.pn * 256 + cw;
#pragma unroll
                    for (int bj = 0; bj < 2; ++bj) { if (kind == K_BRA) { rf[m][bj] = *(const u32x4*)(GF + off + bj * 128); ra[m][bj] = __builtin_nontemporal_load((const u32x4*)(GA + off + bj * 128)); } else { rf[m][bj] = __builtin_nontemporal_load((const u32x4*)(GF + off + bj * 128)); ra[m][bj] = rf[m][bj]; } } }
#pragma unroll
                for (int m = 0; m < 4; ++m) { const size_t off = (size_t)(rowt + ai * 128 + m * 16) * DM + u.pn * 256 + cw;
#pragma unroll
                    for (int bj = 0; bj < 2; ++bj) { f32x4 g0, g1; unpack8(rf[m][bj], g0, g1);
                        if (kind == K_BRA) { f32x4 a0, a1; unpack8(ra[m][bj], a0, a1);
#pragma unroll
                            for (int e = 0; e < 4; ++e) { acc[ai][bj][m][0][e] *= a0[e] * __builtin_amdgcn_rcpf(g0[e]); acc[ai][bj][m][1][e] *= a1[e] * __builtin_amdgcn_rcpf(g1[e]); } }
                        else *(u32x4*)(GA + off + bj * 128) = pack8(g0 * acc[ai][bj][m][0], g1 * acc[ai][bj][m][1]); } }
            }
        }
    }
};

template <bool ALIGN_EPI, bool SP2, bool PERM = true>
__device__ __forceinline__ void gemm_phase(LAS unsigned char* lds, const Sched& S, const Epi& E, const int tid) {
    const int wid = __builtin_amdgcn_readfirstlane(tid >> 6), lane = tid & 63, wr = wid >> 2, wc = wid & 3, fr = lane & 15, fq = lane >> 4;
    const int K = S.K;
    unsigned voffA[2], voffB[2];
#pragma unroll
    for (int i = 0; i < 2; ++i) { int R, C; stage_rc(tid * 16 + i * 8192, R, C); const int Rb = PERM ? ((R & ~31) + perm32(R & 31)) : R;
        voffA[i] = (unsigned)(R * K + C) * 2u; voffB[i] = (unsigned)(Rb * K + C) * 2u; }
    const size_t kstep = (size_t)(BK * 2);
    const size_t hstep = (size_t)HALF * K * 2;
    const unsigned ldsw = (unsigned)wid * 1024u;
    const int aoff = lds_byte(wr * 64 + fr, fq * 8), boff = lds_byte(wc * 32 + fr, fq * 8);
#define PG8_SA(b, h) (((b) * 2 + (h)) * HTB)
#define PG8_SB(b, h) ((4 + (b) * 2 + (h)) * HTB)
#define PG8_STAGE(bufoff, gbase, voff) do { _Pragma("unroll") for (int _i = 0; _i < 2; ++_i) \
        __builtin_amdgcn_global_load_lds((const unsigned*)((const char*)(gbase) + (voff)[_i]), (LAS unsigned*)(lds + (bufoff) + ldsw + _i * 8192), 16, 0, 0); } while (0)
#define PG8_LDA(dst, b, h) do { _Pragma("unroll") for (int m = 0; m < 4; ++m) _Pragma("unroll") for (int k = 0; k < 2; ++k) dst[m][k] = *(const LAS bf16x8*)(lds + PG8_SA(b, h) + aoff + m * 2048 + k * 1024); } while (0)
#define PG8_LDB(dst, b, h) do { _Pragma("unroll") for (int n = 0; n < 2; ++n) _Pragma("unroll") for (int k = 0; k < 2; ++k) dst[n][k] = *(const LAS bf16x8*)(lds + PG8_SB(b, h) + boff + n * 2048 + k * 1024); } while (0)
#define PG8_MMA(ai, bj, At, Bt) do { __builtin_amdgcn_s_setprio(1); _Pragma("unroll") for (int m = 0; m < 4; ++m) _Pragma("unroll") for (int n = 0; n < 2; ++n) _Pragma("unroll") for (int k = 0; k < 2; ++k) \
        acc[ai][bj][m][n] = __builtin_amdgcn_mfma_f32_16x16x32_bf16(Bt[n][k], At[m][k], acc[ai][bj][m][n], 0, 0, 0); __builtin_amdgcn_s_setprio(0); } while (0)
#define PG8_WAIT_V(n) asm volatile("s_waitcnt vmcnt(" #n ")" ::: "memory")
#define PG8_WAIT_L(n) asm volatile("s_waitcnt lgkmcnt(" #n ")" ::: "memory")
#define PG8_BAR __builtin_amdgcn_s_barrier()
#define PG8_SCHED __builtin_amdgcn_sched_barrier(0)
    Unit cur, nxt; int ui = 0;
    if (!S.next(0, cur)) return;
    f32x4 acc[2][2][4][2];
#pragma unroll
    for (int a = 0; a < 2; ++a)
#pragma unroll
        for (int b = 0; b < 2; ++b)
#pragma unroll
            for (int m = 0; m < 4; ++m)
#pragma unroll
                for (int n = 0; n < 2; ++n) acc[a][b][m][n] = (f32x4){0.f, 0.f, 0.f, 0.f};
    bf16x8 At[4][2], B0[2][2], B1[2][2];
    const char* cA = S.aptr(cur); const char* cB = S.bptr(cur);
    if constexpr (SP2) {
        PG8_STAGE(PG8_SB(0, 0), cB, voffB); PG8_STAGE(PG8_SB(0, 1), cB + hstep, voffB); PG8_STAGE(PG8_SA(0, 0), cA, voffA); PG8_STAGE(PG8_SA(0, 1), cA + hstep, voffA);
        if (wr == 1) PG8_BAR;
        PG8_WAIT_V(2); PG8_BAR;
        PG8_STAGE(PG8_SB(1, 0), cB + kstep, voffB); PG8_STAGE(PG8_SA(1, 0), cA + kstep, voffA); PG8_STAGE(PG8_SB(1, 1), cB + hstep + kstep, voffB);
        PG8_WAIT_V(6); PG8_BAR;
    } else {
        PG8_STAGE(PG8_SB(0, 0), cB, voffB); PG8_STAGE(PG8_SA(0, 0), cA, voffA); PG8_STAGE(PG8_SB(0, 1), cB + hstep, voffB); PG8_STAGE(PG8_SA(0, 1), cA + hstep, voffA);
        if (wr == 1) PG8_BAR;
        PG8_WAIT_V(4); PG8_BAR;
        PG8_STAGE(PG8_SB(1, 0), cB + kstep, voffB); PG8_STAGE(PG8_SA(1, 0), cA + kstep, voffA); PG8_STAGE(PG8_SB(1, 1), cB + hstep + kstep, voffB);
        PG8_WAIT_V(6); PG8_BAR;
    }
    for (;;) {
        const bool has_next = S.next(ui + 1, nxt); const int nt = S.ktiles(cur);
        const char* nA = has_next ? S.aptr(nxt) : cA; const char* nB = has_next ? S.bptr(nxt) : cB;
        for (int t = 0; t < nt; t += 2) {
            const bool last = (t == nt - 2);
            const char* a1 = cA + (size_t)(t + 1) * kstep;
            const char* a2 = last ? nA : cA + (size_t)(t + 2) * kstep; const char* b2 = last ? nB : cB + (size_t)(t + 2) * kstep;
            const char* a3 = a2 + kstep; const char* b3 = b2 + kstep;
            if constexpr (SP2) {
            PG8_LDB(B0, 0, 0); PG8_LDB(B1, 0, 1); PG8_SCHED; PG8_LDA(At, 0, 0); PG8_STAGE(PG8_SA(1, 1), a1 + hstep, voffA);
            PG8_WAIT_V(8); PG8_WAIT_L(0); PG8_BAR; PG8_MMA(0, 0, At, B0); PG8_MMA(0, 1, At, B1); PG8_BAR; PG8_SCHED;
            PG8_LDA(At, 0, 1); PG8_STAGE(PG8_SB(0, 0), b2, voffB); PG8_STAGE(PG8_SB(0, 1), b2 + hstep, voffB); PG8_STAGE(PG8_SA(0, 0), a2, voffA);
            PG8_WAIT_V(8); PG8_WAIT_L(0); PG8_BAR; PG8_MMA(1, 0, At, B0); PG8_MMA(1, 1, At, B1); PG8_BAR; PG8_SCHED;
            PG8_LDB(B0, 1, 0); PG8_LDB(B1, 1, 1); PG8_SCHED; PG8_LDA(At, 1, 0); PG8_STAGE(PG8_SA(0, 1), a2 + hstep, voffA);
            PG8_WAIT_V(8); PG8_WAIT_L(0); PG8_BAR; PG8_MMA(0, 0, At, B0); PG8_MMA(0, 1, At, B1); PG8_BAR; PG8_SCHED;
            PG8_LDA(At, 1, 1); PG8_STAGE(PG8_SB(1, 0), b3, voffB); PG8_STAGE(PG8_SB(1, 1), b3 + hstep, voffB); PG8_STAGE(PG8_SA(1, 0), a3, voffA);
            PG8_WAIT_V(8); PG8_WAIT_L(0); PG8_BAR; PG8_MMA(1, 0, At, B0); PG8_MMA(1, 1, At, B1); PG8_BAR; PG8_SCHED;
            } else {
            PG8_LDB(B0, 0, 0); PG8_SCHED; PG8_LDA(At, 0, 0); PG8_STAGE(PG8_SA(1, 1), a1 + hstep, voffA);
            PG8_WAIT_L(8); PG8_BAR; PG8_WAIT_L(0); PG8_MMA(0, 0, At, B0); PG8_BAR; PG8_SCHED;
            PG8_LDB(B1, 0, 1); PG8_STAGE(PG8_SB(0, 0), b2, voffB);
            PG8_BAR; PG8_WAIT_L(0); PG8_MMA(0, 1, At, B1); PG8_BAR;
            PG8_LDA(At, 0, 1); PG8_STAGE(PG8_SA(0, 0), a2, voffA);
            PG8_BAR; PG8_WAIT_L(0); PG8_MMA(1, 0, At, B0); PG8_BAR; PG8_SCHED;
            PG8_STAGE(PG8_SB(0, 1), b2 + hstep, voffB);
            PG8_WAIT_V(6); PG8_BAR; PG8_MMA(1, 1, At, B1); PG8_BAR;
            PG8_LDB(B0, 1, 0); PG8_SCHED; PG8_LDA(At, 1, 0); PG8_STAGE(PG8_SA(0, 1), a2 + hstep, voffA);
            PG8_WAIT_L(8); PG8_BAR; PG8_WAIT_L(0); PG8_MMA(0, 0, At, B0); PG8_BAR; PG8_SCHED;
            PG8_LDB(B1, 1, 1); PG8_STAGE(PG8_SB(1, 0), b3, voffB);
            PG8_BAR; PG8_WAIT_L(0); PG8_MMA(0, 1, At, B1); PG8_BAR;
            PG8_LDA(At, 1, 1); PG8_STAGE(PG8_SA(1, 0), a3, voffA);
            PG8_BAR; PG8_WAIT_L(0); PG8_MMA(1, 0, At, B0); PG8_BAR; PG8_SCHED;
            PG8_STAGE(PG8_SB(1, 1), b3 + hstep, voffB);
            PG8_WAIT_V(6); PG8_BAR; PG8_MMA(1, 1, At, B1); PG8_BAR;
            }
        }
        if constexpr (ALIGN_EPI) { if (wr == 0) PG8_BAR; }
        E.template run<PERM>(acc, cur, S.kind(cur), wr, wc, fr, fq);
        if (!has_next) break;
        if (S.kind(cur) != K_BRA) {
#pragma unroll
        for (int a = 0; a < 2; ++a)
#pragma unroll
            for (int b = 0; b < 2; ++b)
#pragma unroll
                for (int m = 0; m < 4; ++m)
#pragma unroll
                    for (int n = 0; n < 2; ++n) acc[a][b][m][n] = (f32x4){0.f, 0.f, 0.f, 0.f};
        }
        cur = nxt; cA = nA; cB = nB; ++ui;
        if constexpr (ALIGN_EPI) { if (wr == 1) PG8_BAR; }
    }
    PG8_WAIT_V(0);
    if constexpr (!ALIGN_EPI) { if (wr == 0) PG8_BAR; }
    PG8_BAR;
#undef PG8_SA
#undef PG8_SB
#undef PG8_STAGE
#undef PG8_LDA
#undef PG8_LDB
#undef PG8_MMA
#undef PG8_WAIT_V
#undef PG8_WAIT_L
#undef PG8_BAR
#undef PG8_SCHED
}
}

namespace att {
using bf16 = __hip_bfloat16;
constexpr int D = 128, NW = 8, QBLK = 32, KVBLK = 64;
constexpr float SCALE = 0.088388347648318440f;
constexpr float THR = 8.f;
constexpr int LDQ = DM, LDK = 256, LDO = DM;
constexpr size_t SHM_V = KVBLK * D * 2, SHM_K = KVBLK * D * 2, SHM_ATTN = 2 * SHM_V + 2 * SHM_K + NW * 64 * 4;
#define KSWZ(row, colB) ((row) * 256 + ((colB) ^ (((row) & 7) << 4)))
#define SBAR() __builtin_amdgcn_sched_barrier(0)
__device__ __forceinline__ int crow(int r, int hi) { return (r & 3) + 8 * (r >> 2) + 4 * hi; }
__device__ __forceinline__ unsigned cvtpk(float lo, float hi) { unsigned r; asm volatile("v_cvt_pk_bf16_f32 %0, %1, %2" : "=v"(r) : "v"(lo), "v"(hi)); return r; }
__device__ __forceinline__ void partialSM(f32x16& p0, f32x16& p1, float& m_reg, float& mn, float& alpha) {
  constexpr float C = SCALE * 1.4426950408889634f;
  float pmax = p0[0];
  _Pragma("unroll") for (int r = 1; r < 16; ++r) pmax = fmaxf(pmax, p0[r]);
  _Pragma("unroll") for (int r = 0; r < 16; ++r) pmax = fmaxf(pmax, p1[r]);
  { auto rr = __builtin_amdgcn_permlane32_swap(__float_as_uint(pmax), __float_as_uint(pmax), false, false);
    pmax = fmaxf(__uint_as_float(rr[0]), __uint_as_float(rr[1])); }
  if (__builtin_expect(__all(pmax - m_reg <= THR / SCALE), 1)) { mn = m_reg; alpha = 1.f; }
  else { mn = fmaxf(m_reg, pmax); alpha = __builtin_amdgcn_exp2f((m_reg - mn) * C); m_reg = mn; }
  float mnC = -mn * C;
  _Pragma("unroll") for (int r = 0; r < 16; ++r) p0[r] = fmaf(p0[r], C, mnC);
  _Pragma("unroll") for (int r = 0; r < 16; ++r) p1[r] = fmaf(p1[r], C, mnC);
  _Pragma("unroll") for (int r = 0; r < 16; ++r) p0[r] = __builtin_amdgcn_exp2f(p0[r]);
}
__device__ __forceinline__ void finishSM(f32x16& p0, f32x16& p1, float alpha, float& l_reg, bf16x8& pa0, bf16x8& pa1, bf16x8& pa2, bf16x8& pa3) {
  _Pragma("unroll") for (int r = 0; r < 16; ++r) p1[r] = __builtin_amdgcn_exp2f(p1[r]);
  float ps = 0;
  _Pragma("unroll") for (int r = 0; r < 16; ++r) ps += p0[r];
  _Pragma("unroll") for (int r = 0; r < 16; ++r) ps += p1[r];
  { auto rr = __builtin_amdgcn_permlane32_swap(__float_as_uint(ps), __float_as_uint(ps), false, false);
    ps = __uint_as_float(rr[0]) + __uint_as_float(rr[1]); }
  l_reg = l_reg * alpha + ps;
#define PK4(P, BASE, OUT) do { unsigned a0 = cvtpk(P[BASE + 0], P[BASE + 1]), a1 = cvtpk(P[BASE + 2], P[BASE + 3]);   \
    unsigned b0 = cvtpk(P[BASE + 4], P[BASE + 5]), b1 = cvtpk(P[BASE + 6], P[BASE + 7]);                              \
    auto r0 = __builtin_amdgcn_permlane32_swap(a0, b0, false, false); auto r1 = __builtin_amdgcn_permlane32_swap(a1, b1, false, false); \
    u32x4 w = {r0[0], r1[0], r0[1], r1[1]}; OUT = *reinterpret_cast<bf16x8*>(&w); } while (0)
  PK4(p0, 0, pa0); PK4(p0, 8, pa1); PK4(p1, 0, pa2); PK4(p1, 8, pa3);
#undef PK4
}
__device__ __forceinline__ void qkt(f32x16& p0, f32x16& p1, const bf16* Ks, const bf16x8* qr, int r32, int hi) {
  p0 = f32x16{}; p1 = f32x16{};
  _Pragma("unroll") for (int d0 = 0; d0 < 8; ++d0) { int cb = (d0 * 16 + hi * 8) * 2;
    bf16x8 b0 = *reinterpret_cast<const bf16x8*>((const char*)Ks + KSWZ(r32, cb));
    bf16x8 b1 = *reinterpret_cast<const bf16x8*>((const char*)Ks + KSWZ(32 + r32, cb));
    p0 = __builtin_amdgcn_mfma_f32_32x32x16_bf16(b0, qr[d0], p0, 0, 0, 0);
    p1 = __builtin_amdgcn_mfma_f32_32x32x16_bf16(b1, qr[d0], p1, 0, 0, 0); }
}
__device__ __forceinline__ int v_st(int k, int c) { const int kk = (k & ~0xC) | ((k & 4) << 1) | ((k & 8) >> 1); return ((kk >> 3) * 4 + (c >> 5)) * 512 + ((kk & 7) * 32 + (c & 31)) * 2; }
__device__ __forceinline__ int v_rd_base(int lane) { return ((lane & 3) << 3) | (((lane >> 2) & 3) << 6) | (((lane >> 4) & 1) << 5) | (((lane >> 5) & 1) << 8); }
constexpr int v_rd_off(int d0, int ks, int half) { return d0 * 512 + ks * 4096 + half * 2048; }
template <int OFF> __device__ __forceinline__ s16x4 tr_read(int vb) {
  s16x4 r; asm volatile("ds_read_b64_tr_b16 %0, %1 offset:%2" : "=&v"(r) : "v"(vb), "i"(OFF) : "memory"); return r;
}
template <int D0> __device__ __forceinline__ void pv_one(f32x16& od, int vb, bf16x8 pa0, bf16x8 pa1, bf16x8 pa2, bf16x8 pa3) {
  const s16x4 l0 = tr_read<v_rd_off(D0, 0, 0)>(vb), h0 = tr_read<v_rd_off(D0, 0, 1)>(vb), l1 = tr_read<v_rd_off(D0, 1, 0)>(vb), h1 = tr_read<v_rd_off(D0, 1, 1)>(vb);
  const s16x4 l2 = tr_read<v_rd_off(D0, 2, 0)>(vb), h2 = tr_read<v_rd_off(D0, 2, 1)>(vb), l3 = tr_read<v_rd_off(D0, 3, 0)>(vb), h3 = tr_read<v_rd_off(D0, 3, 1)>(vb);
  asm volatile("s_waitcnt lgkmcnt(0)" ::: "memory"); SBAR();
#define PK(L, H) (bf16x8){L[0], L[1], L[2], L[3], H[0], H[1], H[2], H[3]}
  od = __builtin_amdgcn_mfma_f32_32x32x16_bf16(pa0, PK(l0, h0), od, 0, 0, 0);
  od = __builtin_amdgcn_mfma_f32_32x32x16_bf16(pa1, PK(l1, h1), od, 0, 0, 0);
  od = __builtin_amdgcn_mfma_f32_32x32x16_bf16(pa2, PK(l2, h2), od, 0, 0, 0);
  od = __builtin_amdgcn_mfma_f32_32x32x16_bf16(pa3, PK(l3, h3), od, 0, 0, 0);
#undef PK
}
__device__ __forceinline__ void pv_d0(f32x16* o, int vb, bf16x8 pa0, bf16x8 pa1, bf16x8 pa2, bf16x8 pa3) {
  pv_one<0>(o[0], vb, pa0, pa1, pa2, pa3); pv_one<1>(o[1], vb, pa0, pa1, pa2, pa3); pv_one<2>(o[2], vb, pa0, pa1, pa2, pa3); pv_one<3>(o[3], vb, pa0, pa1, pa2, pa3);
}
__device__ __forceinline__ void attn_unit(const bf16* Qb, const bf16* __restrict__ Kh, const bf16* __restrict__ Vh, bf16* Ob, int seq, char* lds, const int tid,
                                          const float* __restrict__ qg, const float* __restrict__ ropetab, int n0) {
  const int wid = __builtin_amdgcn_readfirstlane(tid >> 6), lane = tid & 63, r32 = lane & 31, hi = lane >> 5;
  bf16* V_lds = (bf16*)lds; bf16* K_lds = (bf16*)(lds + 2 * SHM_V);
  float* ws = (float*)(lds + 2 * SHM_V + 2 * SHM_K) + wid * 64; float* li_l = ws; float* al_l = ws + 32;
  bf16x8 qr[8];
  const bf16* Qw = Qb + (long)(wid * QBLK + r32) * LDQ + hi * 8;
#pragma unroll
  for (int d0 = 0; d0 < 8; ++d0) qr[d0] = *reinterpret_cast<const bf16x8*>(Qw + d0 * 16);
#ifndef NO_QFIX
  {
    float qf[8][8]; float ss = 0.f;
#pragma unroll
    for (int d0 = 0; d0 < 8; ++d0)
#pragma unroll
      for (int e = 0; e < 8; ++e) { const float v = __uint_as_float(((unsigned)(unsigned short)qr[d0][e]) << 16); qf[d0][e] = v; ss += v * v; }
    { auto rr = __builtin_amdgcn_permlane32_swap(__float_as_uint(ss), __float_as_uint(ss), false, false); ss = __uint_as_float(rr[0]) + __uint_as_float(rr[1]); }
    const float rstd = 1.0f / sqrtf(ss * (1.0f / 128.0f) + EPS);
    const int n = n0 + wid * QBLK + r32;
#pragma unroll
    for (int d0 = 0; d0 < 8; ++d0) { const f32x4 g0 = *(const f32x4*)(qg + d0 * 16 + hi * 8), g1 = *(const f32x4*)(qg + d0 * 16 + hi * 8 + 4);
#pragma unroll
      for (int e = 0; e < 4; ++e) { qf[d0][e] *= rstd * g0[e]; qf[d0][4 + e] *= rstd * g1[e]; } }
#pragma unroll
    for (int d0 = 0; d0 < 4; ++d0) { const int pos = d0 < 2 ? (n >> 6) : (n & 63); const float* rp = ropetab + 2 * (pos * 32 + (d0 & 1) * 16 + hi * 8);
#pragma unroll
      for (int e = 0; e < 8; e += 2) { const f32x4 cs = *(const f32x4*)(rp + 2 * e);
        { const float t1 = qf[d0][e], t2 = qf[d0 + 4][e]; qf[d0][e] = t1 * cs[0] - t2 * cs[1]; qf[d0 + 4][e] = t2 * cs[0] + t1 * cs[1]; }
        { const float t1 = qf[d0][e + 1], t2 = qf[d0 + 4][e + 1]; qf[d0][e + 1] = t1 * cs[2] - t2 * cs[3]; qf[d0 + 4][e + 1] = t2 * cs[2] + t1 * cs[3]; } } }
#pragma unroll
    for (int d0 = 0; d0 < 8; ++d0) { u32x4 w = {cvtpk(qf[d0][0], qf[d0][1]), cvtpk(qf[d0][2], qf[d0][3]), cvtpk(qf[d0][4], qf[d0][5]), cvtpk(qf[d0][6], qf[d0][7])}; qr[d0] = *reinterpret_cast<bf16x8*>(&w); }
  }
#endif
  float m_reg = -1e30f, l_reg = 0; f32x16 o[4] = {};
  const int sr = tid >> 4, sc = (tid & 15) * 8, vst0 = v_st(sr, sc), vst1 = v_st(32 + sr, sc);
  const int vb0 = (int)(uintptr_t)V_lds + v_rd_base(lane);
  bf16x8 sr_0vs0, sr_0vs1, sr_0ks0, sr_0ks1, sr_1vs0, sr_1vs1, sr_1ks0, sr_1ks1;
#define LD8(p) (*reinterpret_cast<const bf16x8*>(p))
#define SLOAD(i, k0) do { sr_##i##vs0 = LD8(&Vh[(long)((k0) + sr) * LDK + sc]); sr_##i##vs1 = LD8(&Vh[(long)((k0) + 32 + sr) * LDK + sc]); \
    sr_##i##ks0 = LD8(&Kh[(long)((k0) + sr) * LDK + sc]); sr_##i##ks1 = LD8(&Kh[(long)((k0) + 32 + sr) * LDK + sc]); } while (0)
#define SWRITE(b, i) do { *(bf16x8*)((char*)V_lds + (b) * SHM_V + vst0) = sr_##i##vs0;          \
    *(bf16x8*)((char*)V_lds + (b) * SHM_V + vst1) = sr_##i##vs1; int kc = sc * 2;               \
    *(bf16x8*)((char*)K_lds + (b) * SHM_K + KSWZ(sr, kc)) = sr_##i##ks0;                       \
    *(bf16x8*)((char*)K_lds + (b) * SHM_K + KSWZ(32 + sr, kc)) = sr_##i##ks1; } while (0)
#define SWAIT() asm volatile("s_waitcnt vmcnt(4)" ::: "memory")
#define RESC(a) do { if (__any((a) < 1.f)) { if (hi == 0) al_l[r32] = (a); asm volatile("s_waitcnt lgkmcnt(0)" ::: "memory"); \
    _Pragma("unroll") for (int d = 0; d < 4; ++d) _Pragma("unroll") for (int r = 0; r < 16; ++r) o[d][r] *= al_l[crow(r, hi)]; } } while (0)
  f32x16 pA0, pA1, pB0, pB1; float mnA, mnB, alA, alB; bf16x8 pa0, pa1, pa2, pa3; const int NT = seq / KVBLK;
  SLOAD(0, 0); asm volatile("s_waitcnt vmcnt(0)" ::: "memory"); SWRITE(0, 0); __syncthreads();
  qkt(pA0, pA1, K_lds, qr, r32, hi); partialSM(pA0, pA1, m_reg, mnA, alA);
  SLOAD(1, KVBLK); if (2 < NT) SLOAD(0, 2 * KVBLK);
  SWAIT(); SWRITE(1, 1); __syncthreads();
  for (int j = 1; j + 1 < NT; j += 2) {
    SBAR(); qkt(pB0, pB1, (bf16*)((char*)K_lds + SHM_K), qr, r32, hi);
    finishSM(pA0, pA1, alA, l_reg, pa0, pa1, pa2, pa3); SBAR();
    SLOAD(1, (j + 2) * KVBLK); SBAR();
    pv_d0(o, vb0, pa0, pa1, pa2, pa3); partialSM(pB0, pB1, m_reg, mnB, alB);
    __syncthreads(); SWAIT(); SWRITE(0, 0);
    RESC(alB); __syncthreads();
    SBAR(); qkt(pA0, pA1, K_lds, qr, r32, hi);
    finishSM(pB0, pB1, alB, l_reg, pa0, pa1, pa2, pa3); SBAR();
    if (j + 3 < NT) SLOAD(0, (j + 3) * KVBLK); SBAR();
    pv_d0(o, vb0 + (int)SHM_V, pa0, pa1, pa2, pa3); partialSM(pA0, pA1, m_reg, mnA, alA);
    __syncthreads(); SWAIT(); SWRITE(1, 1);
    RESC(alA); __syncthreads();
  }
  SBAR(); qkt(pB0, pB1, (bf16*)((char*)K_lds + SHM_K), qr, r32, hi);
  finishSM(pA0, pA1, alA, l_reg, pa0, pa1, pa2, pa3); SBAR();
  pv_d0(o, vb0, pa0, pa1, pa2, pa3); partialSM(pB0, pB1, m_reg, mnB, alB);
  __syncthreads(); RESC(alB);
  finishSM(pB0, pB1, alB, l_reg, pa0, pa1, pa2, pa3); SBAR();
  pv_d0(o, vb0 + (int)SHM_V, pa0, pa1, pa2, pa3);
  if (hi == 0) li_l[r32] = l_reg; asm volatile("s_waitcnt lgkmcnt(0)" ::: "memory");
  float rli[16];
#pragma unroll
  for (int r = 0; r < 16; ++r) rli[r] = __builtin_amdgcn_rcpf(li_l[crow(r, hi)]);
  int l2 = __builtin_amdgcn_mbcnt_hi(~0u, __builtin_amdgcn_mbcnt_lo(~0u, 0u)); asm volatile("" : "+v"(l2));
  const int r32b = l2 & 31, hib = l2 >> 5;
  bf16* Ow = Ob + (long)(wid * QBLK) * LDO;
#pragma unroll
  for (int r = 0; r < 16; ++r) { int orow = crow(r, hib);
    _Pragma("unroll") for (int d0 = 0; d0 < 4; ++d0) Ow[(long)orow * LDO + d0 * 32 + r32b] = __float2bfloat16(o[d0][r] * rli[r]); }
  __syncthreads();
#undef LD8
#undef SLOAD
#undef SWRITE
#undef SWAIT
#undef RESC
}
#undef SBAR
}

#define XB_TMO      128
#define XB_XCNT(j)  (256  + 64 * (j))
#define XB_XSUB(j)  (1280 + 64 * (j))
#define XB_XGEN(j)  (2304 + 64 * (j))
#define XB_TOP      3328
#define XB_TOPGEN   3392
#define XCD_BAR_WORDS 3456
#define XB_SPIN_CAP (1u << 18)
__device__ __forceinline__ unsigned xb_ld(unsigned* p)              { return __hip_atomic_load(p, __ATOMIC_RELAXED, __HIP_MEMORY_SCOPE_AGENT); }
__device__ __forceinline__ unsigned xb_add(unsigned* p, unsigned v) { return __hip_atomic_fetch_add(p, v, __ATOMIC_RELAXED, __HIP_MEMORY_SCOPE_AGENT); }
__device__ __forceinline__ unsigned xb_xcc_id() { return (unsigned)__builtin_amdgcn_s_getreg((3 << 11) | 20) & 0xFu; }
#define XB_SPIN(cond, bar) do { unsigned _sp = 0; while (cond) { __builtin_amdgcn_s_sleep(1); \
    if ((++_sp & 255u) == 0u) { if (xb_ld(&(bar)[XB_TMO])) break; if (_sp > XB_SPIN_CAP) { atomicAdd(&(bar)[XB_TMO], 1u); break; } } } } while (0)
struct XcdBarrier { unsigned* bar; unsigned x; volatile LAS unsigned* st; };
__device__ __forceinline__ XcdBarrier xcd_barrier_post(unsigned* bar, volatile LAS unsigned* st) {
    XcdBarrier b; b.bar = bar; b.x = xb_xcc_id(); b.st = st;
    if (threadIdx.x == 0) (void)xb_add(&bar[XB_XCNT(b.x)], 1u);
    return b;
}
__device__ __forceinline__ void xcd_barrier_complete(unsigned* bar, unsigned x, unsigned& nloc, unsigned& nx) {
    const unsigned G = gridDim.x * gridDim.y * gridDim.z;
    unsigned sum, cnt, mine, sp = 0u;
    for (;;) {
        sum = 0u; cnt = 0u; mine = 0u;
#pragma unroll
        for (unsigned j = 0; j < 16; ++j) { const unsigned c = xb_ld(&bar[XB_XCNT(j)]); sum += c; cnt += (c > 0u) ? 1u : 0u; mine = (j == x) ? c : mine; }
        if (sum == G) break;
        __builtin_amdgcn_s_sleep(1);
        if ((++sp & 255u) == 0u) { if (xb_ld(&bar[XB_TMO])) break; if (sp > XB_SPIN_CAP) { atomicAdd(&bar[XB_TMO], 1u); break; } }
    }
    nloc = mine > 0u ? mine : 1u; nx = cnt > 0u ? cnt : 1u;
}
__device__ __forceinline__ void xcd_barrier(const XcdBarrier& b) {
    asm volatile("s_waitcnt vmcnt(0)" ::: "memory");
    __syncthreads();
    if (threadIdx.x == 0) {
        unsigned* bar = b.bar;
        __builtin_amdgcn_s_waitcnt(0);
        unsigned nloc = b.st[0], nx = b.st[1];
        if (nloc == 0u) { xcd_barrier_complete(bar, b.x, nloc, nx); b.st[0] = nloc; b.st[1] = nx; }
        const unsigned old = xb_add(&bar[XB_XSUB(b.x)], 1u);
        const unsigned gen = old / nloc;
        if (old + 1u == (gen + 1u) * nloc) {
            __builtin_amdgcn_fence(__ATOMIC_RELEASE, "agent");
            asm volatile("s_waitcnt vmcnt(0)" ::: "memory");
            const unsigned og = xb_add(&bar[XB_TOP], 1u);
            const unsigned tg = og / nx;
            if (og + 1u == (tg + 1u) * nx) xb_add(&bar[XB_TOPGEN], 1u);
            else XB_SPIN(xb_ld(&bar[XB_TOPGEN]) == tg, bar);
            __builtin_amdgcn_fence(__ATOMIC_ACQUIRE, "agent");
            xb_add(&bar[XB_XGEN(b.x)], 1u);
            asm volatile("s_waitcnt vmcnt(0)" ::: "memory");
        } else {
            XB_SPIN(xb_ld(&bar[XB_XGEN(b.x)]) == gen, bar);
            __builtin_amdgcn_fence(__ATOMIC_ACQUIRE, "agent");
            asm volatile("s_waitcnt vmcnt(0)" ::: "memory");
        }
    }
    __syncthreads();
}

struct Params {
    const float *x, *c, *ctx, *c_ctx, *w_ada, *b_ada, *norm_ffn1, *w_ffn1_in, *w_ffn1_out, *norm_mix, *w_in, *q_norm, *k_norm, *w_ab, *w_fb, *w_out, *norm_ffn2, *w_ffn2_in, *w_ffn2_out;
    float* out; unsigned char* ws; int st_lo, st_hi;
};

__device__ __forceinline__ void transpose_item(const float* __restrict__ W, int K, int N, bf16_t* __restrict__ WT, int kb, int n0, int drow0, int lane, int ldd = 0) {
    if (ldd == 0) ldd = K;
    const int ng = lane & 15, kq = lane >> 4, k0 = 32 * kb + 8 * kq;
    const float* src = W + (size_t)k0 * N + n0 + 4 * ng;
    f32x4 v[8];
#pragma unroll
    for (int i = 0; i < 8; ++i) v[i] = __builtin_nontemporal_load((const f32x4*)(src + (size_t)i * N));
    bf16_t* dst = WT + (size_t)(drow0 + 4 * ng) * ldd + k0;
#pragma unroll
    for (int j = 0; j < 4; ++j) { u32x4 o; o.x = cvt_pk_bf16(v[0][j], v[1][j]); o.y = cvt_pk_bf16(v[2][j], v[3][j]); o.z = cvt_pk_bf16(v[4][j], v[5][j]); o.w = cvt_pk_bf16(v[6][j], v[7][j]);
        *(u32x4*)(dst + (size_t)j * ldd) = o; }
}

__device__ __forceinline__ void prep_phase(const Params& kp_, LAS unsigned char* lds, int tid, int lane, int wave, int G) {
    const Params* kp = &kp_; unsigned char* ws = kp->ws;
    LAS float* tab2048 = (LAS float*)(lds + LDS_MISC);
    LAS float* tab128 = (LAS float*)(lds + LDS_MISC + 8192);
    if (blockIdx.x < 144) {
        LAS float* s_l = (LAS float*)lds;
        LAS float* red = (LAS float*)(lds + 36864);
        for (int i = tid; i < 9216; i += 512) { const int r = i >> 10, k = i & 1023; const float v = (r < 8) ? kp->c[r * 1024 + k] : kp->c_ctx[k]; s_l[i] = v / (1.f + expf(-v)); }
        __syncthreads();
        const int c0 = blockIdx.x * 64, kr = lane >> 4, cgp = lane & 15;
        f32x4 a0 = {}, a1 = {}, a2 = {}, a3 = {}, a4 = {}, a5 = {}, a6 = {}, a7 = {}, a8 = {};
        const float* wp = kp->w_ada + (size_t)(wave * 128 + kr) * NMOD + c0 + 4 * cgp;
#pragma unroll 8
        for (int i = 0; i < 32; ++i) { const f32x4 w = __builtin_nontemporal_load((const f32x4*)(wp + (size_t)i * 4 * NMOD)); const int k = wave * 128 + 4 * i + kr;
            a0 += w * s_l[k]; a1 += w * s_l[1024 + k]; a2 += w * s_l[2048 + k]; a3 += w * s_l[3072 + k]; a4 += w * s_l[4096 + k];
            a5 += w * s_l[5120 + k]; a6 += w * s_l[6144 + k]; a7 += w * s_l[7168 + k]; a8 += w * s_l[8192 + k]; }
#define RED9(a, r) do { _Pragma("unroll") for (int e = 0; e < 4; ++e) { float v = a[e]; v += __shfl_xor(v, 16); v += __shfl_xor(v, 32); if (lane < 16) red[(wave * 9 + r) * 64 + 4 * cgp + e] = v; } } while (0)
        RED9(a0, 0); RED9(a1, 1); RED9(a2, 2); RED9(a3, 3); RED9(a4, 4); RED9(a5, 5); RED9(a6, 6); RED9(a7, 7); RED9(a8, 8);
#undef RED9
        __syncthreads();
        float* mod = (float*)(ws + WS_MOD);
        for (int i = tid; i < 576; i += 512) { const int r = i >> 6, col = i & 63; float s = 0.f;
#pragma unroll
            for (int w = 0; w < 8; ++w) s += red[(w * 9 + r) * 64 + col];
            mod[r * NMOD + c0 + col] = s + kp->b_ada[c0 + col]; }
    }
    __syncthreads();
    const int gw = blockIdx.x * 8 + wave, NGW = G * 8;
    if (blockIdx.x == G - 1) {
        float* rt = (float*)(ws + WS_ROPE);
        for (int i = tid; i < 2048; i += 512) { const int pos = i >> 5, j = i & 31; const float invf = powf(10000.0f, -(float)(2 * j) / 64.0f); const float ang = (float)pos * invf;
            rt[2 * i] = cosf(ang); rt[2 * i + 1] = sinf(ang); }
    }
    constexpr int I_1IN = 32 * 88;
    for (int r = (gw + 1152) % NGW; r < I_1IN; r += NGW) { const int kb = r / 88, n0 = (r % 88) * 64; const int isup = n0 >= DFF, j = isup ? n0 - DFF : n0;
        transpose_item(kp->w_ffn1_in, 1024, 2 * DFF, (bf16_t*)(ws + WS_W1IN), kb, n0, 256 * (j >> 7) + (j & 127) + 128 * isup, lane); }
}

__device__ __forceinline__ void late_weights(const Params& kp_, LAS unsigned char* lds, int tid, int lane, int widx, int nw) {
    const Params* kp = &kp_; unsigned char* ws = kp->ws;
    LAS float* tab2048 = (LAS float*)(lds + LDS_MISC);
    LAS float* tab128 = (LAS float*)(lds + LDS_MISC + 8192);
    for (int i = tid; i < 2048; i += 512) tab2048[i] = cospif((float)i * (1.0f / 1024.0f));
    if (tid < 128) tab128[tid] = cospif((float)tid * (1.0f / 64.0f));
    __syncthreads();
    constexpr int I_FOLD = 1024, I_IN = 32 * 64, I_AB = 32 * 16, I_FB = 16 * 16, I_O = 32 * 16, I_1OUT = 88 * 16;
    for (int r = widx; r < I_1OUT; r += nw) { const int kb = r >> 4, n0 = (r & 15) * 64; transpose_item(kp->w_ffn1_out, DFF, 1024, (bf16_t*)(ws + WS_W1OUT), kb, n0, n0, lane); }
    {
        bf16_t* dft = (bf16_t*)(ws + WS_DFT);
        for (int e8 = widx * 64 + lane; e8 < 2048 * 512; e8 += nw * 64) {
            const int k = e8 >> 9, kp0 = (e8 & 511) * 8, cs = kp0 >> 11, n0 = kp0 & 2047; float v[8];
#pragma unroll
            for (int e = 0; e < 8; ++e) { int idx = (k * (n0 + e)) & 2047; if (cs) idx = (idx + 512) & 2047; v[e] = tab2048[idx] * (1.0f / 512.0f); }
            u32x4 o; o.x = cvt_pk_bf16(v[0], v[1]); o.y = cvt_pk_bf16(v[2], v[3]); o.z = cvt_pk_bf16(v[4], v[5]); o.w = cvt_pk_bf16(v[6], v[7]);
            *(u32x4*)(dft + (size_t)e8 * 8) = o;
        }
    }
    for (int r = widx; r < I_FOLD; r += nw) {
        const int jt = r & 7, g = (r >> 3) & 3, kb = r >> 5, k0 = kb * 32;
        const int jj = jt * 32 + (lane & 31), cs = jj >> 7, m = jj & 127, hi = lane >> 5;
        const float* wrow = kp->w_in + (size_t)(k0 + (lane & 31)) * 4096 + 1536 + g * 128 + hi;
        f32x16 acc = {};
#pragma unroll 8
        for (int s2 = 0; s2 < 64; ++s2) { const int c = 2 * s2 + hi; const float a = wrow[2 * s2]; int idx = (c * m) & 127; if (cs) idx = (idx + 96) & 127;
            acc = __builtin_amdgcn_mfma_f32_32x32x2f32(a, tab128[idx], acc, 0, 0, 0); }
        bf16_t* WfT = (bf16_t*)(ws + WS_WF) + (size_t)(cs * 512 + g * 128 + m) * 1024 + k0 + 4 * hi;
#pragma unroll
        for (int q = 0; q < 4; ++q) { u32x2 o; o.x = cvt_pk_bf16(acc[4 * q], acc[4 * q + 1]); o.y = cvt_pk_bf16(acc[4 * q + 2], acc[4 * q + 3]); *(u32x2*)(WfT + 8 * q) = o; }
    }
    for (int r = widx; r < I_IN; r += nw) { const int kb = r >> 6, n0 = (r & 63) * 64; if (n0 < 1536 || n0 >= 2048) transpose_item(kp->w_in, 1024, 4096, (bf16_t*)(ws + WS_WIN), kb, n0, n0 < 1536 ? n0 : n0 - 512, lane); }
    for (int r = widx; r < I_AB; r += nw) { const int kb = r >> 4, n0 = (r & 15) * 64; transpose_item(kp->w_ab, 1024, 1024, (bf16_t*)(ws + WS_WAB), kb, n0, n0, lane); }
    for (int r = widx; r < I_O; r += nw) { const int kb = r >> 4, n0 = (r & 15) * 64; transpose_item(kp->w_out, 1024, 1024, (bf16_t*)(ws + WS_WO), kb, n0, n0, lane); }
}

template <bool LAT_BF> __device__ __forceinline__ void norm_phase(const float* lat, const float* ctxp, const float* ctxp2, int nrows, const float* gain, const float* mod, int sh_off, int sc_off, bf16_t* A, int gw, int NGW, int lane) {
    for (int r = gw; r < nrows; r += NGW) {
        const bool isctx = r >= NLAT; const float* src = isctx ? ctxp + (size_t)(r - NLAT) * DM : lat + (size_t)r * DM; const int mrow = isctx ? 8 : (r >> 11);
        f32x4 v[4]; float ss = 0.f;
#pragma unroll
        for (int j = 0; j < 4; ++j) { if (LAT_BF && !isctx) { const u32x2 w = __builtin_nontemporal_load((const u32x2*)((const bf16_t*)lat + (size_t)r * DM + 4 * lane + 256 * j)); v[j] = (f32x4){__uint_as_float(w.x << 16), __uint_as_float(w.x & 0xffff0000u), __uint_as_float(w.y << 16), __uint_as_float(w.y & 0xffff0000u)}; } else v[j] = __builtin_nontemporal_load((const f32x4*)(src + 4 * lane + 256 * j)); if (isctx && ctxp2) v[j] += *(const f32x4*)(ctxp2 + (size_t)(r - NLAT) * DM + 4 * lane + 256 * j); ss += (v[j][0] * v[j][0] + v[j][1] * v[j][1]) + (v[j][2] * v[j][2] + v[j][3] * v[j][3]); }
        const float rstd = 1.0f / sqrtf(wave_sum(ss) * (1.0f / DM) + EPS);
        const float* mp = mod + mrow * NMOD;
#pragma unroll
        for (int j = 0; j < 4; ++j) { const int c = 4 * lane + 256 * j; const f32x4 g = *(const f32x4*)(gain + c), sh = *(const f32x4*)(mp + sh_off + c), sc = *(const f32x4*)(mp + sc_off + c);
            const f32x4 o = (v[j] * rstd) * g * (sc + 1.0f) + sh; u32x2 w; w.x = cvt_pk_bf16(o[0], o[1]); w.y = cvt_pk_bf16(o[2], o[3]);
            *(u32x2*)(A + (size_t)r * DM + c) = w; }
    }
}

__device__ __forceinline__ void fix_head(bf16_t* hp, const float* g, const float* ropetab, int n, bool rope, int lane) {
    float t1 = bf2f(hp[lane]), t2 = bf2f(hp[lane + 64]);
    const float rstd = 1.0f / sqrtf(wave_sum(t1 * t1 + t2 * t2) * (1.0f / 128.0f) + EPS);
    t1 = t1 * rstd * g[lane]; t2 = t2 * rstd * g[lane + 64];
    float o1 = t1, o2 = t2;
    if (rope) { const int pos = lane < 32 ? (n >> 6) : (n & 63); const float c = ropetab[2 * (pos * 32 + (lane & 31))], s = ropetab[2 * (pos * 32 + (lane & 31)) + 1]; o1 = t1 * c - t2 * s; o2 = t2 * c + t1 * s; }
    hp[lane] = f2bf(o1); hp[lane + 64] = f2bf(o2);
}
__device__ __forceinline__ void fixup_phase(unsigned char* ws, const float* q_norm, const float* k_norm, int gw, int NGW, int lane) {
    bf16_t* Q = (bf16_t*)(ws + WS_Q); bf16_t* Kb = (bf16_t*)(ws + WS_K); const float* rt = (const float*)(ws + WS_ROPE);
    for (int r = gw; r < NTOK; r += NGW) {
        if (r < NLAT) { const int b = r >> 11, n = r & 2047;
            for (int h = 0; h < 8; ++h) fix_head(Q + (size_t)r * DM + h * 128, q_norm, rt, n, true, lane);
            for (int h = 0; h < 2; ++h) fix_head(Kb + (size_t)(b * SKV + CTXL + n) * 256 + h * 128, k_norm, rt, n, true, lane);
        } else { const int rc = r - NLAT, b = rc >> 8, n = rc & 255;
            for (int h = 0; h < 2; ++h) fix_head(Kb + (size_t)(b * SKV + n) * 256 + h * 128, k_norm, rt, 0, false, lane); }
    }
}

constexpr int NSTEPS = 15;
__host__ __device__ constexpr bool sync_after(int st) { return !(st == 7 || st == 9); }

__global__ void __launch_bounds__(512, 2) mk_fwd(Params p) {
    extern __shared__ __attribute__((aligned(16))) unsigned char lds_raw[];
    LAS unsigned char* lds = (LAS unsigned char*)lds_raw;
    const int G = gridDim.x, c = blockIdx.x, NGW = G * 8;
    const int lo = p.st_lo, hi = p.st_hi;
    unsigned char* const ws = p.ws;
    const float* const mod = (const float*)(ws + WS_MOD);
    bf16_t* const Abuf = (bf16_t*)(ws + WS_A);
#define IN(k) (lo <= (k) && (k) < hi)
    volatile LAS unsigned* bst = (volatile LAS unsigned*)(lds + LDS_MISC + 12288);
    if (threadIdx.x < 2) bst[threadIdx.x] = 0u;
    __syncthreads();
    XcdBarrier gbar; gbar.bar = (unsigned*)(ws + WS_BAR); gbar.x = 0; gbar.st = bst;
    if (hi - lo > 1) gbar = xcd_barrier_post((unsigned*)(ws + WS_BAR), bst);
    if (hi < 0) cg::this_grid().sync();
#define SEAM(k) do { if (IN(k) && IN((k) + 1)) { if (sync_after(k)) xcd_barrier(gbar); else { __syncthreads(); } } } while (0)
#define TIDS() int tid = threadIdx.x; asm volatile("" : "+v"(tid)); const int lane = tid & 63, wave = __builtin_amdgcn_readfirstlane(tid >> 6), gw = c * 8 + wave; (void)lane; (void)gw
#define GEMM1P(PRM, KK, a, b, nm, nn, kd, rm) do { const pg8::Sched S{(a), nullptr, nullptr, (b), nullptr, nullptr, (nm), 1, 1, (nn), 1, 1, (kd), (kd), (kd), (nm) * (nn), 0, 0, G, c, (KK), 0, (KK) / 64, (KK) / 64, (KK) / 64, 0, 0}; \
        const pg8::Epi E{ws, p.out, p.x, p.ctx, (rm), p.k_norm, p.norm_ffn2, (const LAS float*)(lds + LDS_MISC)}; pg8::gemm_phase<true, true, PRM>(lds, S, E, tid); } while (0)
#define GEMM1(KK, a, b, nm, nn, kd, rm) GEMM1P(true, KK, a, b, nm, nn, kd, rm)
    if (IN(0)) { TIDS(); prep_phase(p, lds, tid, lane, wave, G); }
    SEAM(0);
    if (IN(1)) { TIDS(); norm_phase<false>(p.x, p.ctx, nullptr, NTOK, p.norm_ffn1, mod, 0 * DM, 1 * DM, Abuf, gw, NGW, lane); }
    SEAM(1);
    if (IN(2)) { TIDS(); GEMM1(1024, Abuf, (const bf16_t*)(ws + WS_W1IN), NTOK / 256, 22, pg8::K_SWIGLU, 0);
        constexpr int NBUSY = (NTOK / 256) * 22 - 6 * 256;
        int t2 = threadIdx.x; asm volatile("" : "+v"(t2)); const int w2 = __builtin_amdgcn_readfirstlane(t2 >> 6);
        if (G == 256 && c >= NBUSY) late_weights(p, lds, t2, t2 & 63, (c - NBUSY) * 8 + w2, (256 - NBUSY) * 8);
        else if (G != 256) late_weights(p, lds, t2, t2 & 63, c * 8 + w2, NGW); }
    SEAM(2);
    if (IN(3)) { TIDS();
        const bf16_t* Hc = (const bf16_t*)(ws + WS_H) + (size_t)NLAT * DFF;
        const pg8::Sched S{(const bf16_t*)(ws + WS_H), Hc, Hc, (const bf16_t*)(ws + WS_W1OUT), (const bf16_t*)(ws + WS_W1OUT), (const bf16_t*)(ws + WS_W1OUT),
                           64, 8, 8, 4, 4, 4, pg8::K_RES, pg8::K_RESC0, pg8::K_RESC1, 256, 32, 32, G, c, DFF, 0, 44, 22, 22, 0, DFF / 2};
        const pg8::Epi E{ws, p.out, p.x, p.ctx, 0, p.k_norm, p.norm_ffn2, (const LAS float*)(lds + LDS_MISC)}; pg8::gemm_phase<true, true>(lds, S, E, tid); }
    SEAM(3);
    if (IN(4)) { TIDS(); norm_phase<true>(p.out, (const float*)(ws + WS_CTX1), (const float*)(ws + WS_CTX1B), NTOK, p.norm_mix, mod, 3 * DM, 4 * DM, Abuf, gw, NGW, lane); }
    SEAM(4);
    if (IN(5)) { TIDS();
        const pg8::Sched S{Abuf, (const bf16_t*)(ws + WS_WF), Abuf + (size_t)NLAT * DM, (const bf16_t*)(ws + WS_WIN), Abuf, (const bf16_t*)(ws + WS_WIN) + (size_t)1024 * DM,
                           64, 4, 8, 14, 64, 2, pg8::K_INPROJ, pg8::K_FTSWAP, pg8::K_CTXKV, 64 * 14, 256, 16, G, c, 1024, 0, 16, 16, 16, 0, 0};
        const pg8::Epi E{ws, p.out, p.x, p.ctx, 0, p.k_norm, p.norm_ffn2, (const LAS float*)(lds + LDS_MISC)}; pg8::gemm_phase<true, true>(lds, S, E, tid);
        if (G == 256 && c >= 144) {
            int t2 = threadIdx.x; asm volatile("" : "+v"(t2)); const int lane = t2 & 63;
            const int w2 = (c - 144) * 8 + __builtin_amdgcn_readfirstlane(t2 >> 6), nw2 = 112 * 8;
            for (int r = w2; r < 32 * 88; r += nw2) { const int kb = r / 88, n0 = (r % 88) * 64; const int isup = n0 >= DFF, j = isup ? n0 - DFF : n0;
                transpose_item(p.w_ffn2_in, 1024, 2 * DFF, (bf16_t*)(ws + WS_W2IN), kb, n0, 256 * (j >> 7) + (j & 127) + 128 * isup, lane); }
            for (int r = w2; r < 88 * 16; r += nw2) { const int kb = r >> 4, n0 = (r & 15) * 64; transpose_item(p.w_ffn2_out, DFF, 1024, (bf16_t*)(ws + WS_W2OUT), kb, n0, n0, lane); }
            for (int r = w2; r < 2 * 16 * 16; r += nw2) { const int hf = r >> 8, q = r & 255, kb = q >> 4, n0 = (q & 15) * 64;
                transpose_item(p.w_fb, 512, 1024, (bf16_t*)(ws + WS_WFB2) + hf * 512, kb, n0, n0, lane, 1024); }
        } }
    if (IN(5) && IN(7)) xcd_barrier(gbar);
    if (IN(7)) { TIDS();
        const pg8::Sched S{(const bf16_t*)(ws + WS_DFT), (const bf16_t*)(ws + WS_DFT), nullptr, (const bf16_t*)(ws + WS_FT), (const bf16_t*)(ws + WS_FT), nullptr, 8, 8, 1, 16, 16, 1, pg8::K_FOUR2, pg8::K_FOUR2, pg8::K_FOUR2, 128, 128, 0, G, c, 4096, 1, 32, 32, 32, 2048, 0};
        const pg8::Epi E{ws, p.out, p.x, p.ctx, 0, p.k_norm, p.norm_ffn2, (const LAS float*)(lds + LDS_MISC)}; pg8::gemm_phase<true, true>(lds, S, E, tid); }
    SEAM(7);
    if (IN(8)) { TIDS();
        const int x = c & 7, s = c >> 3; const int j0 = 2 * s; int nj = 2; asm volatile("" : "+s"(nj));
#pragma unroll 1
        for (int i = 0; i < nj; ++i) { const int j = j0 + i, kvh = j >> 5, h = kvh * 4 + ((j >> 3) & 3), qb = j & 7;
            att::bf16* Qb = (att::bf16*)(ws + WS_Q) + (size_t)(x * SEQ + qb * 256) * DM + h * 128;
            const att::bf16* Kh = (const att::bf16*)(ws + WS_K) + (size_t)x * SKV * 256 + kvh * 128;
            const att::bf16* Vh = (const att::bf16*)(ws + WS_V) + (size_t)x * SKV * 256 + kvh * 128;
            const int tu = tid;
            att::attn_unit(Qb, Kh, Vh, Qb, SKV, (char*)lds_raw, tu, p.q_norm, (const float*)(ws + WS_ROPE), qb * 256); }
        {
            int t2 = threadIdx.x; asm volatile("" : "+v"(t2)); const int ln = t2 & 63, wv = __builtin_amdgcn_readfirstlane(t2 >> 6);
            const bf16_t* W2 = (const bf16_t*)(ws + WS_W2IN); float* sw3 = (float*)(ws + WS_SW3);
            for (int n = c * 8 + wv; n < 2 * DFF; n += NGW) {
                const u32x4 w0 = *(const u32x4*)(W2 + (size_t)n * DM + 8 * ln), w1 = *(const u32x4*)(W2 + (size_t)n * DM + 512 + 8 * ln);
                f32x4 a0, a1, a2, a3; unpack8(w0, a0, a1); unpack8(w1, a2, a3);
#pragma unroll
                for (int b = 0; b < 8; ++b) { const float* sh = mod + b * NMOD + 6 * DM + 8 * ln;
                    const f32x4 s0 = *(const f32x4*)sh, s1 = *(const f32x4*)(sh + 4), s2 = *(const f32x4*)(sh + 512), s3 = *(const f32x4*)(sh + 516);
                    const f32x4 pr = a0 * s0 + a1 * s1 + a2 * s2 + a3 * s3; const float d = wave_sum((pr[0] + pr[1]) + (pr[2] + pr[3]));
                    if (ln == 0) sw3[b * (2 * DFF) + n] = d; }
            }
        }
    }
    SEAM(8);
    if (IN(9)) { TIDS();
        const pg8::Sched S{(const bf16_t*)(ws + WS_Q), (const bf16_t*)(ws + WS_YF), nullptr, (const bf16_t*)(ws + WS_WAB), (const bf16_t*)(ws + WS_WFB2), nullptr,
                           64, 64, 1, 4, 4, 1, pg8::K_BRA, pg8::K_BRB, pg8::K_BRB, 256, 256, 0, G, c, 1024, 2, 16, 8, 16, 0, 0};
        const pg8::Epi E{ws, p.out, p.x, p.ctx, 0, p.k_norm, p.norm_ffn2, (const LAS float*)(lds + LDS_MISC)}; pg8::gemm_phase<true, true>(lds, S, E, tid); }
    SEAM(9);
    SEAM(10);
    if (IN(11)) { TIDS(); GEMM1(1024, (const bf16_t*)(ws + WS_GA), (const bf16_t*)(ws + WS_WO), 64, 4, pg8::K_RES, 1); }
    if (IN(11) && IN(13)) xcd_barrier(gbar);
    if (IN(13)) { TIDS();
        {
            LAS float* rs = (LAS float*)(lds + LDS_MISC); const float* st3 = (const float*)(ws + WS_ST3) + (size_t)(c & 7) * 2048 * 16;
            for (int r = tid; r < 2048; r += 512) { const f32x4* sp = (const f32x4*)(st3 + (size_t)r * 16); const f32x4 q = (sp[0] + sp[1]) + (sp[2] + sp[3]);
                rs[r] = 1.0f / sqrtf(((q[0] + q[1]) + (q[2] + q[3])) * (1.0f / DM) + EPS); }
            __syncthreads();
        }
        GEMM1(1024, Abuf, (const bf16_t*)(ws + WS_W2IN), 64, 22, pg8::K_SWIGLU, 3); }
    SEAM(13);
    if (IN(14)) { TIDS(); GEMM1(DFF, (const bf16_t*)(ws + WS_H), (const bf16_t*)(ws + WS_W2OUT), 64, 4, pg8::K_RES, 2); }
#undef IN
#undef SEAM
#undef TIDS
#undef GEMM1
#undef GEMM1P
}

extern "C" void kernel_launch(void* const* d_in, const int* in_sizes, int n_in, void* d_out, int out_size, void* d_ws, size_t ws_size, hipStream_t stream) {
    static int grid = 0;
    if (grid == 0) {
        if (n_in != 19 || out_size != NLAT * DM || ws_size < WS_END) { fprintf(stderr, "kernel_launch: unexpected shapes (n_in %d out %d ws %zu)\n", n_in, out_size, ws_size); grid = -1; return; }
        int dev = 0, cus = 0, per_cu = 0;
        hipGetDevice(&dev); hipDeviceGetAttribute(&cus, hipDeviceAttributeMultiprocessorCount, dev);
        if (hipFuncSetAttribute((const void*)mk_fwd, hipFuncAttributeMaxDynamicSharedMemorySize, LDS_BYTES) != hipSuccess) { fprintf(stderr, "kernel_launch: hipFuncSetAttribute failed\n"); grid = -1; return; }
        hipOccupancyMaxActiveBlocksPerMultiprocessor(&per_cu, (const void*)mk_fwd, 512, LDS_BYTES);
        (void)hipGetLastError();
        if (cus != 256 || per_cu < 1) fprintf(stderr, "kernel_launch: note: cus %d per_cu %d (built for 256 x 1)\n", cus, per_cu);
        grid = 256;
    }
    if (grid < 0) return;
    Params p{};
    const float** pp = (const float**)&p;
    for (int i = 0; i < 19; ++i) pp[i] = (const float*)d_in[i];
    p.out = (float*)d_out; p.ws = (unsigned char*)d_ws;
    if (hipMemsetAsync((char*)d_ws + WS_BAR, 0, BAR_BYTES, stream) != hipSuccess) { fprintf(stderr, "kernel_launch: memset failed\n"); return; }
#if MK_MULTI
    int lo = 0;
    for (int st = 0; st < NSTEPS; ++st) {
        if (sync_after(st) || st == NSTEPS - 1) { p.st_lo = lo; p.st_hi = st + 1; hipLaunchKernelGGL(mk_fwd, dim3(grid), dim3(512), LDS_BYTES, stream, p); lo = st + 1; }
    }
#else
    p.st_lo = 0; p.st_hi = NSTEPS;
    void* args[] = {&p};
    hipError_t e = hipLaunchCooperativeKernel((const void*)mk_fwd, dim3(grid), dim3(512), args, LDS_BYTES, stream);
    if (e != hipSuccess) fprintf(stderr, "cooperative launch failed: %s\n", hipGetErrorString(e));
#endif
}
```

```cpp
#include <hip/hip_runtime.h>
#include <hip/hip_cooperative_groups.h>
#include <hip/hip_bf16.h>
#include <cstdio>
#include <cstdint>
namespace cg = cooperative_groups;

#ifndef MK_MULTI
#define MK_MULTI 0
#endif

#define LAS __attribute__((address_space(3)))
typedef unsigned short bf16_t;
typedef short bf16x8 __attribute__((ext_vector_type(8)));
typedef float f32x4 __attribute__((ext_vector_type(4)));
typedef float f32x16 __attribute__((ext_vector_type(16)));
typedef unsigned u32x4 __attribute__((ext_vector_type(4)));
typedef unsigned u32x2 __attribute__((ext_vector_type(2)));
typedef short s16x4 __attribute__((ext_vector_type(4)));

constexpr int DM = 1024, NB = 8, SEQ = 2048, CTXL = 256, NLAT = NB * SEQ, NCTX = NB * CTXL, NTOK = NLAT + NCTX;
constexpr int DFF = 2816, NMOD = 9 * DM, SKV = CTXL + SEQ;
constexpr float EPS = 1e-6f;

constexpr size_t MiB = 1u << 20;
constexpr size_t WS_MOD = 0, WS_ROPE = 384 * 1024, WS_BAR = 512 * 1024, WS_CNT = WS_BAR + 16384, BAR_BYTES = 16384 + 65536;
constexpr size_t WS_W1IN = 1 * MiB, WS_W1OUT = 12 * MiB, WS_WIN = 18 * MiB, WS_WF = 25 * MiB, WS_WAB = 27 * MiB, WS_WFB = 29 * MiB, WS_WO = 30 * MiB;
constexpr size_t WS_W2IN = 32 * MiB, WS_W2OUT = 43 * MiB, WS_DFT = 49 * MiB, WS_A = 65 * MiB, WS_CTX1 = 101 * MiB, WS_H = 109 * MiB;
constexpr size_t WS_Q = 109 * MiB, WS_K = 141 * MiB, WS_V = 150 * MiB, WS_GA = 159 * MiB, WS_GF = 191 * MiB, WS_FT = 223 * MiB, WS_YF = WS_A, WS_CTX1B = WS_FT, WS_X2 = WS_FT, WS_WFB2 = WS_W1IN, WS_ST3 = WS_CTX1, WS_SW3 = WS_CTX1 + 2 * MiB, WS_END = 255 * MiB;

constexpr int LDS_BYTES = 147456;
constexpr int LDS_MISC = 131072;

__device__ __forceinline__ unsigned cvt_pk_bf16(float lo, float hi) { unsigned r; asm volatile("v_cvt_pk_bf16_f32 %0, %1, %2" : "=v"(r) : "v"(lo), "v"(hi)); return r; }
__device__ __forceinline__ u32x4 pack8(f32x4 a, f32x4 b) { u32x4 w; w.x = cvt_pk_bf16(a[0], a[1]); w.y = cvt_pk_bf16(a[2], a[3]); w.z = cvt_pk_bf16(b[0], b[1]); w.w = cvt_pk_bf16(b[2], b[3]); return w; }
__device__ __forceinline__ void st16_wt(void* p, u32x4 v) {
    asm volatile("global_store_dwordx4 %0, %1, off sc1\n\ts_nop 1" :: "v"(p), "v"(v) : "memory");
}
__device__ __forceinline__ void unpack8(u32x4 w, f32x4& a, f32x4& b) {
    a[0] = __uint_as_float(w.x << 16); a[1] = __uint_as_float(w.x & 0xffff0000u); a[2] = __uint_as_float(w.y << 16); a[3] = __uint_as_float(w.y & 0xffff0000u);
    b[0] = __uint_as_float(w.z << 16); b[1] = __uint_as_float(w.z & 0xffff0000u); b[2] = __uint_as_float(w.w << 16); b[3] = __uint_as_float(w.w & 0xffff0000u); }
__device__ __forceinline__ float bf2f(bf16_t v) { return __uint_as_float((unsigned)v << 16); }
__device__ __forceinline__ bf16_t f2bf(float f) { unsigned u = __float_as_uint(f); return (bf16_t)((u + 0x7fffu + ((u >> 16) & 1u)) >> 16); }
__device__ __forceinline__ float sigmoidf_(float v) { return __builtin_amdgcn_rcpf(1.f + __builtin_amdgcn_exp2f(-1.4426950408889634f * v)); }
__device__ __forceinline__ float wave_sum(float v) {
#pragma unroll
    for (int o = 1; o < 64; o <<= 1) v += __shfl_xor(v, o);
    return v;
}

namespace pg8 {
constexpr int BM = 256, BK = 64, HALF = 128, HTB = HALF * BK * 2, STAGE_BYTES = 8 * HTB, NXCD = 8, WGM = 8;
__host__ __device__ __forceinline__ int lds_byte(int r, int c) { const int st = (r >> 4) * 2 + (c >> 5), rr = r & 15, cc = c & 31, ob = rr * 64 + cc * 2; return st * 1024 + (ob ^ (((ob >> 9) & 1) << 5)); }
__host__ __device__ __forceinline__ void stage_rc(int b, int& R, int& C) { const int st = b / 1024, sb = b % 1024, swz = sb ^ (((sb >> 9) & 1) << 5); R = (st >> 1) * 16 + swz / 64; C = (st & 1) * 32 + (swz % 64) / 2; }
__host__ __device__ __forceinline__ int perm32(int rho) { const int n = rho >> 4, i = rho & 15; return 8 * (i >> 2) + 4 * n + (i & 3); }

struct Unit { int pm, pn, sub, q; };
enum Kind { K_SWIGLU = 0, K_RES = 1, K_INPROJ = 2, K_FTSWAP = 3, K_CTXKV = 4, K_FOUR2 = 5, K_BRA = 6, K_BRB = 7, K_RESC0 = 8, K_RESC1 = 9 };

struct Sched {
    const bf16_t *A0, *A1, *A2, *B0, *B1, *B2; int nM0, nM1, nM2, nN0, nN1, nN2, k0, k1, k2; int n0, n1, n2; int G, c, K, direct; int kt0, kt1, kt2, ko1, ko2;
    static __device__ __forceinline__ int sel3(int sub, int v0, int v1, int v2) { const int m1 = -(int)(sub == 1), m2 = -(int)(sub == 2); return v0 ^ ((v0 ^ v1) & m1) ^ ((v0 ^ v2) & m2); }
    static __device__ __forceinline__ unsigned long long sel3p(int sub, const void* p0, const void* p1, const void* p2) {
        const unsigned long long v0 = (unsigned long long)p0, v1 = (unsigned long long)p1, v2 = (unsigned long long)p2, m1 = -(unsigned long long)(sub == 1), m2 = -(unsigned long long)(sub == 2);
        return v0 ^ ((v0 ^ v1) & m1) ^ ((v0 ^ v2) & m2); }
    __device__ __forceinline__ bool next(int i, Unit& u) const {
        u.q = 0;
        if (direct == 1) { if (i > 0) return false; const int x = c & 7, s = c >> 3, r = s & 7; u.sub = 0; u.q = s >> 3; u.pm = r & 3; u.pn = 2 * x + (r >> 2); return true; }
        if (direct == 2) {
            if (i > 1 || c >= n0) return false; u.sub = i;
            const int nwg = nM0 * nN0; int wgid; { const int q = nwg / NXCD, r = nwg % NXCD, xcd = c % NXCD, off = c / NXCD; wgid = (xcd < r ? xcd * (q + 1) : r * (q + 1) + (xcd - r) * q) + off; }
            const int nig = WGM * nN0, gid = wgid / nig, fm = gid * WGM, gsz = (nM0 - fm) < WGM ? (nM0 - fm) : WGM;
            u.pm = fm + ((wgid % nig) % gsz); u.pn = (wgid % nig) / gsz; return true; }
        const long L = (long)i * G + c;
        if (L >= n0 + n1 + n2) return false;
        const int sub = (L >= n0) + (L >= n0 + n1); u.sub = sub;
        const int l = (int)L - sel3(sub, 0, n0, n0 + n1), nM = sel3(sub, nM0, nM1, nM2), nN = sel3(sub, nN0, nN1, nN2);
        const int nwg = nM * nN; int wgid; { const int q = nwg / NXCD, r = nwg % NXCD, xcd = l % NXCD, off = l / NXCD; wgid = (xcd < r ? xcd * (q + 1) : r * (q + 1) + (xcd - r) * q) + off; }
        const int nig = WGM * nN, gid = wgid / nig, fm = gid * WGM, gsz = (nM - fm) < WGM ? (nM - fm) : WGM;
        u.pm = fm + ((wgid % nig) % gsz); u.pn = (wgid % nig) / gsz; return true;
    }
    __device__ __forceinline__ const char* aptr(const Unit& u) const { return (const char*)sel3p(u.sub, A0, A1, A2) + (size_t)u.pm * (size_t)(512 * K) + 2 * sel3(u.sub, 0, ko1, ko2) + (direct == 1 ? 2048 * u.q : 0); }
    __device__ __forceinline__ const char* bptr(const Unit& u) const { return (const char*)sel3p(u.sub, B0, B1, B2) + (size_t)u.pn * (size_t)(512 * K) + 2 * sel3(u.sub, 0, ko1, ko2) + (direct == 1 ? 2048 * u.q : 0); }
    __device__ __forceinline__ int ktiles(const Unit& u) const { return sel3(u.sub, kt0, kt1, kt2); }
    __device__ __forceinline__ int kind(const Unit& u) const { return sel3(u.sub, k0, k1, k2); }
};

struct Epi {
    unsigned char* ws; float* out; const float* x; const float* ctx; int res_mode; const float* kg; const float* ng; const LAS float* rs;
    template <bool PERM> __device__ __forceinline__ void run(f32x4 (&acc)[2][2][4][2], const Unit& u, int kind, int wr, int wc, int fr_in, int fq_in) const {
        int fr = fr_in, fq = fq_in; asm volatile("" : "+v"(fr), "+v"(fq));
        const int rowt = u.pm * 256 + wr * 64 + fr;
        const int cw = wc * 32 + 8 * fq;
        if (kind == K_SWIGLU) {
            bf16_t* H = (bf16_t*)(ws + WS_H);
            const bool fn = (res_mode == 3);
            f32x4 sg[2], su[2];
            if (fn) { const float* sw = (const float*)(ws + WS_SW3) + (u.pm >> 3) * (2 * DFF) + u.pn * 256 + cw;
#pragma unroll
                for (int n = 0; n < 2; ++n) { sg[n] = *(const f32x4*)(sw + 4 * n); su[n] = *(const f32x4*)(sw + 128 + 4 * n); } }
#pragma unroll
            for (int ai = 0; ai < 2; ++ai)
#pragma unroll
                for (int m = 0; m < 4; ++m) {
                    const int row = rowt + ai * 128 + m * 16; f32x4 h[2];
                    const float rstd = fn ? rs[row & 2047] : 1.f;
#pragma unroll
                    for (int n = 0; n < 2; ++n) { f32x4 g = acc[ai][0][m][n], up = acc[ai][1][m][n]; if (fn) { g = g * rstd + sg[n]; up = up * rstd + su[n]; }
#pragma unroll
                        for (int e = 0; e < 4; ++e) h[n][e] = g[e] * sigmoidf_(g[e]) * up[e]; }
                    *(u32x4*)(H + (size_t)row * DFF + u.pn * 128 + cw) = pack8(h[0], h[1]);
                }
        } else if (kind == K_RES || kind == K_RESC0 || kind == K_RESC1) {
            const float* mod = (const float*)(ws + WS_MOD);
            const bool isctx = kind != K_RES, nobase = kind == K_RESC1;
            const bool in_bf = (res_mode != 0), out_bf = (res_mode == 1) || (res_mode == 0 && !isctx);
            const float* basef = isctx ? ctx : x; float* dstf = isctx ? (float*)(ws + (nobase ? WS_CTX1B : WS_CTX1)) : out;
            const bf16_t* baseb = res_mode == 1 ? (const bf16_t*)out : (const bf16_t*)(ws + WS_X2); bf16_t* dstb = res_mode == 0 ? (bf16_t*)out : (bf16_t*)(ws + WS_X2);
            const int gate_off = res_mode == 0 ? 2 * DM : (res_mode == 1 ? 5 * DM : 8 * DM); const float coef = res_mode == 1 ? 1.f : 0.5f;
            const int mrow = isctx ? 8 : (u.pm >> 3);
            const float* gp = mod + mrow * NMOD + gate_off + u.pn * 256 + cw;
            f32x4 gv[2][2], gg[2][2];
#pragma unroll
            for (int bj = 0; bj < 2; ++bj)
#pragma unroll
                for (int n = 0; n < 2; ++n) { gv[bj][n] = *(const f32x4*)(gp + bj * 128 + 4 * n) * coef; gg[bj][n] = gv[bj][n];
                    if (res_mode == 1) gg[bj][n] = *(const f32x4*)(ng + u.pn * 256 + cw + bj * 128 + 4 * n) * (*(const f32x4*)(mod + mrow * NMOD + 7 * DM + u.pn * 256 + cw + bj * 128 + 4 * n) + 1.0f); }
#pragma unroll
            for (int ai = 0; ai < 2; ++ai) {
                f32x4 bv[4][2][2];
#pragma unroll
                for (int m = 0; m < 4; ++m) { const size_t off = (size_t)(rowt + ai * 128 + m * 16) * DM + u.pn * 256 + cw;
#pragma unroll
                    for (int bj = 0; bj < 2; ++bj) {
                        if (in_bf) unpack8(__builtin_nontemporal_load((const u32x4*)(baseb + off + bj * 128)), bv[m][bj][0], bv[m][bj][1]);
                        else if (nobase) { bv[m][bj][0] = (f32x4){0.f, 0.f, 0.f, 0.f}; bv[m][bj][1] = bv[m][bj][0]; }
                        else { bv[m][bj][0] = __builtin_nontemporal_load((const f32x4*)(basef + off + bj * 128)); bv[m][bj][1] = __builtin_nontemporal_load((const f32x4*)(basef + off + bj * 128 + 4)); } } }
#pragma unroll
                for (int m = 0; m < 4; ++m) { const size_t off = (size_t)(rowt + ai * 128 + m * 16) * DM + u.pn * 256 + cw; float ss = 0.f;
#pragma unroll
                    for (int bj = 0; bj < 2; ++bj) { const f32x4 v0 = bv[m][bj][0] + gv[bj][0] * acc[ai][bj][m][0], v1 = bv[m][bj][1] + gv[bj][1] * acc[ai][bj][m][1];
                        if (out_bf) *(u32x4*)(dstb + off + bj * 128) = pack8(v0, v1);
                        else { *(f32x4*)(dstf + off + bj * 128) = v0; *(f32x4*)(dstf + off + bj * 128 + 4) = v1; }
                        if (res_mode == 1) {
                            *(u32x4*)((bf16_t*)(ws + WS_A) + off + bj * 128) = pack8(v0 * gg[bj][0], v1 * gg[bj][1]);
                            ss += (v0[0] * v0[0] + v0[1] * v0[1]) + (v0[2] * v0[2] + v0[3] * v0[3]) + (v1[0] * v1[0] + v1[1] * v1[1]) + (v1[2] * v1[2] + v1[3] * v1[3]); } }
                    if (res_mode == 1) { ss += __shfl_xor(ss, 16); ss += __shfl_xor(ss, 32);
                        if (fq == 0) ((float*)(ws + WS_ST3))[(size_t)(rowt + ai * 128 + m * 16) * 16 + u.pn * 4 + wc] = ss; } }
            }
        } else if (kind == K_INPROJ || kind == K_CTXKV) {
            bf16_t* dstb; int ld, rowadd, colb; bool sig = false;
            if (kind == K_INPROJ) {
                const int pn = u.pn;
                if (pn < 4) { dstb = (bf16_t*)(ws + WS_Q); ld = DM; rowadd = 0; colb = pn * 256; }
                else if (pn < 6) { dstb = (bf16_t*)(ws + (pn == 4 ? WS_K : WS_V)); ld = 256; rowadd = 256 * ((u.pm >> 3) + 1); colb = 0; }
                else if (pn < 10) { dstb = (bf16_t*)(ws + WS_GA); ld = DM; rowadd = 0; colb = (pn - 6) * 256; sig = true; }
                else { dstb = (bf16_t*)(ws + WS_GF); ld = DM; rowadd = 0; colb = (pn - 10) * 256; sig = true; }
            } else { dstb = (bf16_t*)(ws + (u.pn == 0 ? WS_K : WS_V)); ld = 256; rowadd = u.pm * (SKV - CTXL); colb = 0; }
#pragma unroll
            for (int ai = 0; ai < 2; ++ai)
#pragma unroll
                for (int m = 0; m < 4; ++m) {
                    const int row = rowt + ai * 128 + m * 16 + rowadd;
#pragma unroll
                    for (int bj = 0; bj < 2; ++bj) { f32x4 a = acc[ai][bj][m][0], b = acc[ai][bj][m][1];
                        if (sig) {
#pragma unroll
                            for (int e = 0; e < 4; ++e) { a[e] = sigmoidf_(a[e]); b[e] = sigmoidf_(b[e]); } }
                        *(u32x4*)(dstb + (size_t)row * ld + colb + bj * 128 + cw) = pack8(a, b); }
                }
            const bool isk = (kind == K_INPROJ) ? (u.pn == 4) : (u.pn == 0);
            if (isk) {
                asm volatile("s_waitcnt vmcnt(0)" ::: "memory"); __builtin_amdgcn_s_barrier(); asm volatile("" ::: "memory");
                const float* rt = (const float*)(ws + WS_ROPE); const bool rope = (kind == K_INPROJ);
                const int lane = fq * 16 + fr, wid = wr * 4 + wc, l16 = lane & 15;
                const f32x4 g1 = *(const f32x4*)(kg + 4 * l16), g2 = *(const f32x4*)(kg + 64 + 4 * l16);
#pragma unroll 4
                for (int it = 0; it < 16; ++it) { const int item = it * 32 + wid * 4 + (lane >> 4), r = item >> 1, hd = item & 1;
                    bf16_t* hp = dstb + (size_t)(u.pm * 256 + r + rowadd) * 256 + hd * 128 + 4 * l16;
                    const u32x2 w1 = *(const u32x2*)hp, w2 = *(const u32x2*)(hp + 64);
                    f32x4 t1 = {__uint_as_float(w1.x << 16), __uint_as_float(w1.x & 0xffff0000u), __uint_as_float(w1.y << 16), __uint_as_float(w1.y & 0xffff0000u)};
                    f32x4 t2 = {__uint_as_float(w2.x << 16), __uint_as_float(w2.x & 0xffff0000u), __uint_as_float(w2.y << 16), __uint_as_float(w2.y & 0xffff0000u)};
                    float ss = (t1[0] * t1[0] + t1[1] * t1[1]) + (t1[2] * t1[2] + t1[3] * t1[3]) + (t2[0] * t2[0] + t2[1] * t2[1]) + (t2[2] * t2[2] + t2[3] * t2[3]);
                    ss += __shfl_xor(ss, 1); ss += __shfl_xor(ss, 2); ss += __shfl_xor(ss, 4); ss += __shfl_xor(ss, 8);
                    const float rstd = 1.0f / sqrtf(ss * (1.0f / 128.0f) + EPS);
                    t1 = t1 * rstd * g1; t2 = t2 * rstd * g2;
                    if (rope) { const int n = ((u.pm & 7) * 256 + r); const int pos = l16 < 8 ? (n >> 6) : (n & 63); const float* rp = rt + 2 * (pos * 32 + ((4 * l16) & 31));
                        const f32x4 c0 = *(const f32x4*)rp, c1 = *(const f32x4*)(rp + 4); f32x4 o1, o2;
                        o1[0] = t1[0] * c0[0] - t2[0] * c0[1]; o2[0] = t2[0] * c0[0] + t1[0] * c0[1]; o1[1] = t1[1] * c0[2] - t2[1] * c0[3]; o2[1] = t2[1] * c0[2] + t1[1] * c0[3];
                        o1[2] = t1[2] * c1[0] - t2[2] * c1[1]; o2[2] = t2[2] * c1[0] + t1[2] * c1[1]; o1[3] = t1[3] * c1[2] - t2[3] * c1[3]; o2[3] = t2[3] * c1[2] + t1[3] * c1[3];
                        t1 = o1; t2 = o2; }
                    u32x2 q1, q2; q1.x = cvt_pk_bf16(t1[0], t1[1]); q1.y = cvt_pk_bf16(t1[2], t1[3]); q2.x = cvt_pk_bf16(t2[0], t2[1]); q2.y = cvt_pk_bf16(t2[2], t2[3]);
                    *(u32x2*)hp = q1; *(u32x2*)(hp + 64) = q2; }
            }
        } else if (kind == K_FTSWAP) {
            bf16_t* FT = (bf16_t*)(ws + WS_FT);
#pragma unroll
            for (int ai = 0; ai < 2; ++ai)
#pragma unroll
                for (int m = 0; m < 4; ++m) {
                    const int j = rowt + ai * 128 + m * 16; const int cs = j >> 9, g = (j >> 7) & 3, mm = j & 127;
#pragma unroll
                    for (int bj = 0; bj < 2; ++bj) { const int t0 = u.pn * 256 + bj * 128 + cw; const int b = t0 >> 11, n = t0 & 2047;
                        *(u32x4*)(FT + ((size_t)((b * 4 + g) * 128 + mm)) * 4096 + cs * 2048 + n) = pack8(acc[ai][bj][m][0], acc[ai][bj][m][1]); }
                }
        } else if (kind == K_FOUR2) {
            bf16_t* YF = (bf16_t*)(ws + WS_YF);
            unsigned* flag = (unsigned*)(ws + WS_CNT) + (size_t)((u.pm * 16 + u.pn) * 4) * 64;
            const int lane = fq * 16 + fr, wid = wr * 4 + wc, role = u.q;
#define F2_WAIT(w) do { if (wid == 0) { unsigned sp_ = 0; while ((unsigned)__builtin_amdgcn_readfirstlane(__hip_atomic_load((w), __ATOMIC_RELAXED, __HIP_MEMORY_SCOPE_AGENT)) < 8u) { __builtin_amdgcn_s_sleep(2); if (++sp_ > (1u << 13)) break; } } } while (0)
            if (role == 1 || role == 3) {
                F2_WAIT(flag + (role == 1 ? 0 : 64)); if (role == 3) F2_WAIT(flag + 128);
                if (wid == 0) { __builtin_amdgcn_fence(__ATOMIC_ACQUIRE, "agent"); asm volatile("s_waitcnt vmcnt(0)" ::: "memory"); }
                asm volatile("" ::: "memory"); __builtin_amdgcn_s_barrier(); asm volatile("" ::: "memory");
            }
#pragma unroll
            for (int ai = 0; ai < 2; ++ai) {
                u32x4 t01[4][2], t2[4][2];
                if (role == 1 || role == 3) {
#pragma unroll
                    for (int m = 0; m < 4; ++m) { const int k = rowt + ai * 128 + m * 16;
#pragma unroll
                        for (int bj = 0; bj < 2; ++bj) { const int c = u.pn * 256 + bj * 128 + cw; const int b = c >> 9, cc = c & 511;
                            t01[m][bj] = __builtin_nontemporal_load((const u32x4*)(YF + (size_t)(b * SEQ + k) * 1024 + 512 + cc));
                            if (role == 3) t2[m][bj] = __builtin_nontemporal_load((const u32x4*)(YF + (size_t)(b * SEQ + 1024 + k) * 1024 + 512 + cc)); else t2[m][bj] = t01[m][bj]; } }
                }
#pragma unroll
                for (int m = 0; m < 4; ++m) { const int k = rowt + ai * 128 + m * 16;
#pragma unroll
                    for (int bj = 0; bj < 2; ++bj) { const int c = u.pn * 256 + bj * 128 + cw; const int b = c >> 9, cc = c & 511;
                        bf16_t* t01p = YF + (size_t)(b * SEQ + k) * 1024 + 512 + cc; bf16_t* t2p = YF + (size_t)(b * SEQ + 1024 + k) * 1024 + 512 + cc;
                        if (role == 0) st16_wt(t01p, pack8(acc[ai][bj][m][0], acc[ai][bj][m][1]));
                        else if (role == 2) st16_wt(t2p, pack8(acc[ai][bj][m][0], acc[ai][bj][m][1]));
                        else if (role == 1) { f32x4 p0, p1; unpack8(t01[m][bj], p0, p1); st16_wt(t01p, pack8(p0 + acc[ai][bj][m][0], p1 + acc[ai][bj][m][1])); }
                        else { f32x4 c0, c1, s0, s1; unpack8(t01[m][bj], c0, c1); unpack8(t2[m][bj], s0, s1); s0 = s0 + acc[ai][bj][m][0]; s1 = s1 + acc[ai][bj][m][1];
                            *(u32x4*)(YF + (size_t)(b * SEQ + k) * 1024 + cc) = pack8(c0 + s0, c1 + s1);
                            if (k != 0) *(u32x4*)(YF + (size_t)(b * SEQ + SEQ - k) * 1024 + cc) = pack8(c0 - s0, c1 - s1); } } }
            }
            if (role != 3) { asm volatile("s_waitcnt vmcnt(0)" ::: "memory"); if (lane == 0) __hip_atomic_fetch_add(flag + (role == 0 ? 0 : (role == 1 ? 64 : 128)), 1u, __ATOMIC_RELAXED, __HIP_MEMORY_SCOPE_AGENT); }
#undef F2_WAIT
        } else {
            bf16_t* GA = (bf16_t*)(ws + WS_GA); const bf16_t* GF = (const bf16_t*)(ws + WS_GF);
#pragma unroll
            for (int ai = 0; ai < 2; ++ai) {
                u32x4 ra[4][2], rf[4][2];
#pragma unroll
                for (int m = 0; m < 4; ++m) { const size_t off = (size_t)(rowt + ai * 128 + m * 16) * DM + u.pn * 256 + cw;
#pragma unroll
                    for (int bj = 0; bj < 2; ++bj) { if (kind == K_BRA) { rf[m][bj] = *(const u32x4*)(GF + off + bj * 128); ra[m][bj] = __builtin_nontemporal_load((const u32x4*)(GA + off + bj * 128)); } else { rf[m][bj] = __builtin_nontemporal_load((const u32x4*)(GF + off + bj * 128)); ra[m][bj] = rf[m][bj]; } } }
#pragma unroll
                for (int m = 0; m < 4; ++m) { const size_t off = (size_t)(rowt + ai * 128 + m * 16) * DM + u.pn * 256 + cw;
#pragma unroll
                    for (int bj = 0; bj < 2; ++bj) { f32x4 g0, g1; unpack8(rf[m][bj], g0, g1);
                        if (kind == K_BRA) { f32x4 a0, a1; unpack8(ra[m][bj], a0, a1);
#pragma unroll
                            for (int e = 0; e < 4; ++e) { acc[ai][bj][m][0][e] *= a0[e] * __builtin_amdgcn_rcpf(g0[e]); acc[ai][bj][m][1][e] *= a1[e] * __builtin_amdgcn_rcpf(g1[e]); } }
                        else *(u32x4*)(GA + off + bj * 128) = pack8(g0 * acc[ai][bj][m][0], g1 * acc[ai][bj][m][1]); } }
            }
        }
    }
};

template <bool ALIGN_EPI, bool SP2, bool PERM = true>
__device__ __forceinline__ void gemm_phase(LAS unsigned char* lds, const Sched& S, const Epi& E, const int tid) {
    const int wid = __builtin_amdgcn_readfirstlane(tid >> 6), lane = tid & 63, wr = wid >> 2, wc = wid & 3, fr = lane & 15, fq = lane >> 4;
    const int K = S.K;
    unsigned voffA[2], voffB[2];
#pragma unroll
    for (int i = 0; i < 2; ++i) { int R, C; stage_rc(tid * 16 + i * 8192, R, C); const int Rb = PERM ? ((R & ~31) + perm32(R & 31)) : R;
        voffA[i] = (unsigned)(R * K + C) * 2u; voffB[i] = (unsigned)(Rb * K + C) * 2u; }
    const size_t kstep = (size_t)(BK * 2);
    const size_t hstep = (size_t)HALF * K * 2;
    const unsigned ldsw = (unsigned)wid * 1024u;
    const int aoff = lds_byte(wr * 64 + fr, fq * 8), boff = lds_byte(wc * 32 + fr, fq * 8);
#define PG8_SA(b, h) (((b) * 2 + (h)) * HTB)
#define PG8_SB(b, h) ((4 + (b) * 2 + (h)) * HTB)
#define PG8_STAGE(bufoff, gbase, voff) do { _Pragma("unroll") for (int _i = 0; _i < 2; ++_i) \
        __builtin_amdgcn_global_load_lds((const unsigned*)((const char*)(gbase) + (voff)[_i]), (LAS unsigned*)(lds + (bufoff) + ldsw + _i * 8192), 16, 0, 0); } while (0)
#define PG8_LDA(dst, b, h) do { _Pragma("unroll") for (int m = 0; m < 4; ++m) _Pragma("unroll") for (int k = 0; k < 2; ++k) dst[m][k] = *(const LAS bf16x8*)(lds + PG8_SA(b, h) + aoff + m * 2048 + k * 1024); } while (0)
#define PG8_LDB(dst, b, h) do { _Pragma("unroll") for (int n = 0; n < 2; ++n) _Pragma("unroll") for (int k = 0; k < 2; ++k) dst[n][k] = *(const LAS bf16x8*)(lds + PG8_SB(b, h) + boff + n * 2048 + k * 1024); } while (0)
#define PG8_MMA(ai, bj, At, Bt) do { __builtin_amdgcn_s_setprio(1); _Pragma("unroll") for (int m = 0; m < 4; ++m) _Pragma("unroll") for (int n = 0; n < 2; ++n) _Pragma("unroll") for (int k = 0; k < 2; ++k) \
        acc[ai][bj][m][n] = __builtin_amdgcn_mfma_f32_16x16x32_bf16(Bt[n][k], At[m][k], acc[ai][bj][m][n], 0, 0, 0); __builtin_amdgcn_s_setprio(0); } while (0)
#define PG8_WAIT_V(n) asm volatile("s_waitcnt vmcnt(" #n ")" ::: "memory")
#define PG8_WAIT_L(n) asm volatile("s_waitcnt lgkmcnt(" #n ")" ::: "memory")
#define PG8_BAR __builtin_amdgcn_s_barrier()
#define PG8_SCHED __builtin_amdgcn_sched_barrier(0)
    Unit cur, nxt; int ui = 0;
    if (!S.next(0, cur)) return;
    f32x4 acc[2][2][4][2];
#pragma unroll
    for (int a = 0; a < 2; ++a)
#pragma unroll
        for (int b = 0; b < 2; ++b)
#pragma unroll
            for (int m = 0; m < 4; ++m)
#pragma unroll
                for (int n = 0; n < 2; ++n) acc[a][b][m][n] = (f32x4){0.f, 0.f, 0.f, 0.f};
    bf16x8 At[4][2], B0[2][2], B1[2][2];
    const char* cA = S.aptr(cur); const char* cB = S.bptr(cur);
    if constexpr (SP2) {
        PG8_STAGE(PG8_SB(0, 0), cB, voffB); PG8_STAGE(PG8_SB(0, 1), cB + hstep, voffB); PG8_STAGE(PG8_SA(0, 0), cA, voffA); PG8_STAGE(PG8_SA(0, 1), cA + hstep, voffA);
        if (wr == 1) PG8_BAR;
        PG8_WAIT_V(2); PG8_BAR;
        PG8_STAGE(PG8_SB(1, 0), cB + kstep, voffB); PG8_STAGE(PG8_SA(1, 0), cA + kstep, voffA); PG8_STAGE(PG8_SB(1, 1), cB + hstep + kstep, voffB);
        PG8_WAIT_V(6); PG8_BAR;
    } else {
        PG8_STAGE(PG8_SB(0, 0), cB, voffB); PG8_STAGE(PG8_SA(0, 0), cA, voffA); PG8_STAGE(PG8_SB(0, 1), cB + hstep, voffB); PG8_STAGE(PG8_SA(0, 1), cA + hstep, voffA);
        if (wr == 1) PG8_BAR;
        PG8_WAIT_V(4); PG8_BAR;
        PG8_STAGE(PG8_SB(1, 0), cB + kstep, voffB); PG8_STAGE(PG8_SA(1, 0), cA + kstep, voffA); PG8_STAGE(PG8_SB(1, 1), cB + hstep + kstep, voffB);
        PG8_WAIT_V(6); PG8_BAR;
    }
    for (;;) {
        const bool has_next = S.next(ui + 1, nxt); const int nt = S.ktiles(cur);
        const char* nA = has_next ? S.aptr(nxt) : cA; const char* nB = has_next ? S.bptr(nxt) : cB;
        for (int t = 0; t < nt; t += 2) {
            const bool last = (t == nt - 2);
            const char* a1 = cA + (size_t)(t + 1) * kstep;
            const char* a2 = last ? nA : cA + (size_t)(t + 2) * kstep; const char* b2 = last ? nB : cB + (size_t)(t + 2) * kstep;
            const char* a3 = a2 + kstep; const char* b3 = b2 + kstep;
            if constexpr (SP2) {
            PG8_LDB(B0, 0, 0); PG8_LDB(B1, 0, 1); PG8_SCHED; PG8_LDA(At, 0, 0); PG8_STAGE(PG8_SA(1, 1), a1 + hstep, voffA);
            PG8_WAIT_V(8); PG8_WAIT_L(0); PG8_BAR; PG8_MMA(0, 0, At, B0); PG8_MMA(0, 1, At, B1); PG8_BAR; PG8_SCHED;
            PG8_LDA(At, 0, 1); PG8_STAGE(PG8_SB(0, 0), b2, voffB); PG8_STAGE(PG8_SB(0, 1), b2 + hstep, voffB); PG8_STAGE(PG8_SA(0, 0), a2, voffA);
            PG8_WAIT_V(8); PG8_WAIT_L(0); PG8_BAR; PG8_MMA(1, 0, At, B0); PG8_MMA(1, 1, At, B1); PG8_BAR; PG8_SCHED;
            PG8_LDB(B0, 1, 0); PG8_LDB(B1, 1, 1); PG8_SCHED; PG8_LDA(At, 1, 0); PG8_STAGE(PG8_SA(0, 1), a2 + hstep, voffA);
            PG8_WAIT_V(8); PG8_WAIT_L(0); PG8_BAR; PG8_MMA(0, 0, At, B0); PG8_MMA(0, 1, At, B1); PG8_BAR; PG8_SCHED;
            PG8_LDA(At, 1, 1); PG8_STAGE(PG8_SB(1, 0), b3, voffB); PG8_STAGE(PG8_SB(1, 1), b3 + hstep, voffB); PG8_STAGE(PG8_SA(1, 0), a3, voffA);
            PG8_WAIT_V(8); PG8_WAIT_L(0); PG8_BAR; PG8_MMA(1, 0, At, B0); PG8_MMA(1, 1, At, B1); PG8_BAR; PG8_SCHED;
            } else {
            PG8_LDB(B0, 0, 0); PG8_SCHED; PG8_LDA(At, 0, 0); PG8_STAGE(PG8_SA(1, 1), a1 + hstep, voffA);
            PG8_WAIT_L(8); PG8_BAR; PG8_WAIT_L(0); PG8_MMA(0, 0, At, B0); PG8_BAR; PG8_SCHED;
            PG8_LDB(B1, 0, 1); PG8_STAGE(PG8_SB(0, 0), b2, voffB);
            PG8_BAR; PG8_WAIT_L(0); PG8_MMA(0, 1, At, B1); PG8_BAR;
            PG8_LDA(At, 0, 1); PG8_STAGE(PG8_SA(0, 0), a2, voffA);
            PG8_BAR; PG8_WAIT_L(0); PG8_MMA(1, 0, At, B0); PG8_BAR; PG8_SCHED;
            PG8_STAGE(PG8_SB(0, 1), b2 + hstep, voffB);
            PG8_WAIT_V(6); PG8_BAR; PG8_MMA(1, 1, At, B1); PG8_BAR;
            PG8_LDB(B0, 1, 0); PG8_SCHED; PG8_LDA(At, 1, 0); PG8_STAGE(PG8_SA(0, 1), a2 + hstep, voffA);
            PG8_WAIT_L(8); PG8_BAR; PG8_WAIT_L(0); PG8_MMA(0, 0, At, B0); PG8_BAR; PG8_SCHED;
            PG8_LDB(B1, 1, 1); PG8_STAGE(PG8_SB(1, 0), b3, voffB);
            PG8_BAR; PG8_WAIT_L(0); PG8_MMA(0, 1, At, B1); PG8_BAR;
            PG8_LDA(At, 1, 1); PG8_STAGE(PG8_SA(1, 0), a3, voffA);
            PG8_BAR; PG8_WAIT_L(0); PG8_MMA(1, 0, At, B0); PG8_BAR; PG8_SCHED;
            PG8_STAGE(PG8_SB(1, 1), b3 + hstep, voffB);
            PG8_WAIT_V(6); PG8_BAR; PG8_MMA(1, 1, At, B1); PG8_BAR;
            }
        }
        if constexpr (ALIGN_EPI) { if (wr == 0) PG8_BAR; }
        E.template run<PERM>(acc, cur, S.kind(cur), wr, wc, fr, fq);
        if (!has_next) break;
        if (S.kind(cur) != K_BRA) {
#pragma unroll
        for (int a = 0; a < 2; ++a)
#pragma unroll
            for (int b = 0; b < 2; ++b)
#pragma unroll
                for (int m = 0; m < 4; ++m)
#pragma unroll
                    for (int n = 0; n < 2; ++n) acc[a][b][m][n] = (f32x4){0.f, 0.f, 0.f, 0.f};
        }
        cur = nxt; cA = nA; cB = nB; ++ui;
        if constexpr (ALIGN_EPI) { if (wr == 1) PG8_BAR; }
    }
    PG8_WAIT_V(0);
    if constexpr (!ALIGN_EPI) { if (wr == 0) PG8_BAR; }
    PG8_BAR;
#undef PG8_SA
#undef PG8_SB
#undef PG8_STAGE
#undef PG8_LDA
#undef PG8_LDB
#undef PG8_MMA
#undef PG8_WAIT_V
#undef PG8_WAIT_L
#undef PG8_BAR
#undef PG8_SCHED
}
}

namespace att {
using bf16 = __hip_bfloat16;
constexpr int D = 128, NW = 8, QBLK = 32, KVBLK = 64;
constexpr float SCALE = 0.088388347648318440f;
constexpr float THR = 8.f;
constexpr int LDQ = DM, LDK = 256, LDO = DM;
constexpr size_t SHM_V = KVBLK * D * 2, SHM_K = KVBLK * D * 2, SHM_ATTN = 2 * SHM_V + 2 * SHM_K + NW * 64 * 4;
#define KSWZ(row, colB) ((row) * 256 + ((colB) ^ (((row) & 7) << 4)))
#define SBAR() __builtin_amdgcn_sched_barrier(0)
__device__ __forceinline__ int crow(int r, int hi) { return (r & 3) + 8 * (r >> 2) + 4 * hi; }
__device__ __forceinline__ unsigned cvtpk(float lo, float hi) { unsigned r; asm volatile("v_cvt_pk_bf16_f32 %0, %1, %2" : "=v"(r) : "v"(lo), "v"(hi)); return r; }
__device__ __forceinline__ void partialSM(f32x16& p0, f32x16& p1, float& m_reg, float& mn, float& alpha) {
  constexpr float C = SCALE * 1.4426950408889634f;
  float pmax = p0[0];
  _Pragma("unroll") for (int r = 1; r < 16; ++r) pmax = fmaxf(pmax, p0[r]);
  _Pragma("unroll") for (int r = 0; r < 16; ++r) pmax = fmaxf(pmax, p1[r]);
  { auto rr = __builtin_amdgcn_permlane32_swap(__float_as_uint(pmax), __float_as_uint(pmax), false, false);
    pmax = fmaxf(__uint_as_float(rr[0]), __uint_as_float(rr[1])); }
  if (__builtin_expect(__all(pmax - m_reg <= THR / SCALE), 1)) { mn = m_reg; alpha = 1.f; }
  else { mn = fmaxf(m_reg, pmax); alpha = __builtin_amdgcn_exp2f((m_reg - mn) * C); m_reg = mn; }
  float mnC = -mn * C;
  _Pragma("unroll") for (int r = 0; r < 16; ++r) p0[r] = fmaf(p0[r], C, mnC);
  _Pragma("unroll") for (int r = 0; r < 16; ++r) p1[r] = fmaf(p1[r], C, mnC);
  _Pragma("unroll") for (int r = 0; r < 16; ++r) p0[r] = __builtin_amdgcn_exp2f(p0[r]);
}
__device__ __forceinline__ void finishSM(f32x16& p0, f32x16& p1, float alpha, float& l_reg, bf16x8& pa0, bf16x8& pa1, bf16x8& pa2, bf16x8& pa3) {
  _Pragma("unroll") for (int r = 0; r < 16; ++r) p1[r] = __builtin_amdgcn_exp2f(p1[r]);
  float ps = 0;
  _Pragma("unroll") for (int r = 0; r < 16; ++r) ps += p0[r];
  _Pragma("unroll") for (int r = 0; r < 16; ++r) ps += p1[r];
  { auto rr = __builtin_amdgcn_permlane32_swap(__float_as_uint(ps), __float_as_uint(ps), false, false);
    ps = __uint_as_float(rr[0]) + __uint_as_float(rr[1]); }
  l_reg = l_reg * alpha + ps;
#define PK4(P, BASE, OUT) do { unsigned a0 = cvtpk(P[BASE + 0], P[BASE + 1]), a1 = cvtpk(P[BASE + 2], P[BASE + 3]);   \
    unsigned b0 = cvtpk(P[BASE + 4], P[BASE + 5]), b1 = cvtpk(P[BASE + 6], P[BASE + 7]);                              \
    auto r0 = __builtin_amdgcn_permlane32_swap(a0, b0, false, false); auto r1 = __builtin_amdgcn_permlane32_swap(a1, b1, false, false); \
    u32x4 w = {r0[0], r1[0], r0[1], r1[1]}; OUT = *reinterpret_cast<bf16x8*>(&w); } while (0)
  PK4(p0, 0, pa0); PK4(p0, 8, pa1); PK4(p1, 0, pa2); PK4(p1, 8, pa3);
#undef PK4
}
__device__ __forceinline__ void qkt(f32x16& p0, f32x16& p1, const bf16* Ks, const bf16x8* qr, int r32, int hi) {
  p0 = f32x16{}; p1 = f32x16{};
  _Pragma("unroll") for (int d0 = 0; d0 < 8; ++d0) { int cb = (d0 * 16 + hi * 8) * 2;
    bf16x8 b0 = *reinterpret_cast<const bf16x8*>((const char*)Ks + KSWZ(r32, cb));
    bf16x8 b1 = *reinterpret_cast<const bf16x8*>((const char*)Ks + KSWZ(32 + r32, cb));
    p0 = __builtin_amdgcn_mfma_f32_32x32x16_bf16(b0, qr[d0], p0, 0, 0, 0);
    p1 = __builtin_amdgcn_mfma_f32_32x32x16_bf16(b1, qr[d0], p1, 0, 0, 0); }
}
__device__ __forceinline__ int v_st(int k, int c) { const int kk = (k & ~0xC) | ((k & 4) << 1) | ((k & 8) >> 1); return ((kk >> 3) * 4 + (c >> 5)) * 512 + ((kk & 7) * 32 + (c & 31)) * 2; }
__device__ __forceinline__ int v_rd_base(int lane) { return ((lane & 3) << 3) | (((lane >> 2) & 3) << 6) | (((lane >> 4) & 1) << 5) | (((lane >> 5) & 1) << 8); }
constexpr int v_rd_off(int d0, int ks, int half) { return d0 * 512 + ks * 4096 + half * 2048; }
template <int OFF> __device__ __forceinline__ s16x4 tr_read(int vb) {
  s16x4 r; asm volatile("ds_read_b64_tr_b16 %0, %1 offset:%2" : "=&v"(r) : "v"(vb), "i"(OFF) : "memory"); return r;
}
template <int D0> __device__ __forceinline__ void pv_one(f32x16& od, int vb, bf16x8 pa0, bf16x8 pa1, bf16x8 pa2, bf16x8 pa3) {
  const s16x4 l0 = tr_read<v_rd_off(D0, 0, 0)>(vb), h0 = tr_read<v_rd_off(D0, 0, 1)>(vb), l1 = tr_read<v_rd_off(D0, 1, 0)>(vb), h1 = tr_read<v_rd_off(D0, 1, 1)>(vb);
  const s16x4 l2 = tr_read<v_rd_off(D0, 2, 0)>(vb), h2 = tr_read<v_rd_off(D0, 2, 1)>(vb), l3 = tr_read<v_rd_off(D0, 3, 0)>(vb), h3 = tr_read<v_rd_off(D0, 3, 1)>(vb);
  asm volatile("s_waitcnt lgkmcnt(0)" ::: "memory"); SBAR();
#define PK(L, H) (bf16x8){L[0], L[1], L[2], L[3], H[0], H[1], H[2], H[3]}
  od = __builtin_amdgcn_mfma_f32_32x32x16_bf16(pa0, PK(l0, h0), od, 0, 0, 0);
  od = __builtin_amdgcn_mfma_f32_32x32x16_bf16(pa1, PK(l1, h1), od, 0, 0, 0);
  od = __builtin_amdgcn_mfma_f32_32x32x16_bf16(pa2, PK(l2, h2), od, 0, 0, 0);
  od = __builtin_amdgcn_mfma_f32_32x32x16_bf16(pa3, PK(l3, h3), od, 0, 0, 0);
#undef PK
}
__device__ __forceinline__ void pv_d0(f32x16* o, int vb, bf16x8 pa0, bf16x8 pa1, bf16x8 pa2, bf16x8 pa3) {
  pv_one<0>(o[0], vb, pa0, pa1, pa2, pa3); pv_one<1>(o[1], vb, pa0, pa1, pa2, pa3); pv_one<2>(o[2], vb, pa0, pa1, pa2, pa3); pv_one<3>(o[3], vb, pa0, pa1, pa2, pa3);
}
__device__ __forceinline__ void attn_unit(const bf16* Qb, const bf16* __restrict__ Kh, const bf16* __restrict__ Vh, bf16* Ob, int seq, char* lds, const int tid,
                                          const float* __restrict__ qg, const float* __restrict__ ropetab, int n0) {
  const int wid = __builtin_amdgcn_readfirstlane(tid >> 6), lane = tid & 63, r32 = lane & 31, hi = lane >> 5;
  bf16* V_lds = (bf16*)lds; bf16* K_lds = (bf16*)(lds + 2 * SHM_V);
  float* ws = (float*)(lds + 2 * SHM_V + 2 * SHM_K) + wid * 64; float* li_l = ws; float* al_l = ws + 32;
  bf16x8 qr[8];
  const bf16* Qw = Qb + (long)(wid * QBLK + r32) * LDQ + hi * 8;
#pragma unroll
  for (int d0 = 0; d0 < 8; ++d0) qr[d0] = *reinterpret_cast<const bf16x8*>(Qw + d0 * 16);
#ifndef NO_QFIX
  {
    float qf[8][8]; float ss = 0.f;
#pragma unroll
    for (int d0 = 0; d0 < 8; ++d0)
#pragma unroll
      for (int e = 0; e < 8; ++e) { const float v = __uint_as_float(((unsigned)(unsigned short)qr[d0][e]) << 16); qf[d0][e] = v; ss += v * v; }
    { auto rr = __builtin_amdgcn_permlane32_swap(__float_as_uint(ss), __float_as_uint(ss), false, false); ss = __uint_as_float(rr[0]) + __uint_as_float(rr[1]); }
    const float rstd = 1.0f / sqrtf(ss * (1.0f / 128.0f) + EPS);
    const int n = n0 + wid * QBLK + r32;
#pragma unroll
    for (int d0 = 0; d0 < 8; ++d0) { const f32x4 g0 = *(const f32x4*)(qg + d0 * 16 + hi * 8), g1 = *(const f32x4*)(qg + d0 * 16 + hi * 8 + 4);
#pragma unroll
      for (int e = 0; e < 4; ++e) { qf[d0][e] *= rstd * g0[e]; qf[d0][4 + e] *= rstd * g1[e]; } }
#pragma unroll
    for (int d0 = 0; d0 < 4; ++d0) { const int pos = d0 < 2 ? (n >> 6) : (n & 63); const float* rp = ropetab + 2 * (pos * 32 + (d0 & 1) * 16 + hi * 8);
#pragma unroll
      for (int e = 0; e < 8; e += 2) { const f32x4 cs = *(const f32x4*)(rp + 2 * e);
        { const float t1 = qf[d0][e], t2 = qf[d0 + 4][e]; qf[d0][e] = t1 * cs[0] - t2 * cs[1]; qf[d0 + 4][e] = t2 * cs[0] + t1 * cs[1]; }
        { const float t1 = qf[d0][e + 1], t2 = qf[d0 + 4][e + 1]; qf[d0][e + 1] = t1 * cs[2] - t2 * cs[3]; qf[d0 + 4][e + 1] = t2 * cs[2] + t1 * cs[3]; } } }
#pragma unroll
    for (int d0 = 0; d0 < 8; ++d0) { u32x4 w = {cvtpk(qf[d0][0], qf[d0][1]), cvtpk(qf[d0][2], qf[d0][3]), cvtpk(qf[d0][4], qf[d0][5]), cvtpk(qf[d0][6], qf[d0][7])}; qr[d0] = *reinterpret_cast<bf16x8*>(&w); }
  }
#endif
  float m_reg = -1e30f, l_reg = 0; f32x16 o[4] = {};
  const int sr = tid >> 4, sc = (tid & 15) * 8, vst0 = v_st(sr, sc), vst1 = v_st(32 + sr, sc);
  const int vb0 = (int)(uintptr_t)V_lds + v_rd_base(lane);
  bf16x8 sr_0vs0, sr_0vs1, sr_0ks0, sr_0ks1, sr_1vs0, sr_1vs1, sr_1ks0, sr_1ks1;
#define LD8(p) (*reinterpret_cast<const bf16x8*>(p))
#define SLOAD(i, k0) do { sr_##i##vs0 = LD8(&Vh[(long)((k0) + sr) * LDK + sc]); sr_##i##vs1 = LD8(&Vh[(long)((k0) + 32 + sr) * LDK + sc]); \
    sr_##i##ks0 = LD8(&Kh[(long)((k0) + sr) * LDK + sc]); sr_##i##ks1 = LD8(&Kh[(long)((k0) + 32 + sr) * LDK + sc]); } while (0)
#define SWRITE(b, i) do { *(bf16x8*)((char*)V_lds + (b) * SHM_V + vst0) = sr_##i##vs0;          \
    *(bf16x8*)((char*)V_lds + (b) * SHM_V + vst1) = sr_##i##vs1; int kc = sc * 2;               \
    *(bf16x8*)((char*)K_lds + (b) * SHM_K + KSWZ(sr, kc)) = sr_##i##ks0;                       \
    *(bf16x8*)((char*)K_lds + (b) * SHM_K + KSWZ(32 + sr, kc)) = sr_##i##ks1; } while (0)
#define SWAIT() asm volatile("s_waitcnt vmcnt(4)" ::: "memory")
#define RESC(a) do { if (__any((a) < 1.f)) { if (hi == 0) al_l[r32] = (a); asm volatile("s_waitcnt lgkmcnt(0)" ::: "memory"); \
    _Pragma("unroll") for (int d = 0; d < 4; ++d) _Pragma("unroll") for (int r = 0; r < 16; ++r) o[d][r] *= al_l[crow(r, hi)]; } } while (0)
  f32x16 pA0, pA1, pB0, pB1; float mnA, mnB, alA, alB; bf16x8 pa0, pa1, pa2, pa3; const int NT = seq / KVBLK;
  SLOAD(0, 0); asm volatile("s_waitcnt vmcnt(0)" ::: "memory"); SWRITE(0, 0); __syncthreads();
  qkt(pA0, pA1, K_lds, qr, r32, hi); partialSM(pA0, pA1, m_reg, mnA, alA);
  SLOAD(1, KVBLK); if (2 < NT) SLOAD(0, 2 * KVBLK);
  SWAIT(); SWRITE(1, 1); __syncthreads();
  for (int j = 1; j + 1 < NT; j += 2) {
    SBAR(); qkt(pB0, pB1, (bf16*)((char*)K_lds + SHM_K), qr, r32, hi);
    finishSM(pA0, pA1, alA, l_reg, pa0, pa1, pa2, pa3); SBAR();
    SLOAD(1, (j + 2) * KVBLK); SBAR();
    pv_d0(o, vb0, pa0, pa1, pa2, pa3); partialSM(pB0, pB1, m_reg, mnB, alB);
    __syncthreads(); SWAIT(); SWRITE(0, 0);
    RESC(alB); __syncthreads();
    SBAR(); qkt(pA0, pA1, K_lds, qr, r32, hi);
    finishSM(pB0, pB1, alB, l_reg, pa0, pa1, pa2, pa3); SBAR();
    if (j + 3 < NT) SLOAD(0, (j + 3) * KVBLK); SBAR();
    pv_d0(o, vb0 + (int)SHM_V, pa0, pa1, pa2, pa3); partialSM(pA0, pA1, m_reg, mnA, alA);
    __syncthreads(); SWAIT(); SWRITE(1, 1);
    RESC(alA); __syncthreads();
  }
  SBAR(); qkt(pB0, pB1, (bf16*)((char*)K_lds + SHM_K), qr, r32, hi);
  finishSM(pA0, pA1, alA, l_reg, pa0, pa1, pa2, pa3); SBAR();
  pv_d0(o, vb0, pa0, pa1, pa2, pa3); partialSM(pB0, pB1, m_reg, mnB, alB);
  __syncthreads(); RESC(alB);
  finishSM(pB0, pB1, alB, l_reg, pa0, pa1, pa2, pa3); SBAR();
  pv_d0(o, vb0 + (int)SHM_V, pa0, pa1, pa2, pa3);
  if (hi == 0) li_l[r32] = l_reg; asm volatile("s_waitcnt lgkmcnt(0)" ::: "memory");
  float rli[16];
#pragma unroll
  for (int r = 0; r < 16; ++r) rli[r] = __builtin_amdgcn_rcpf(li_l[crow(r, hi)]);
  int l2 = __builtin_amdgcn_mbcnt_hi(~0u, __builtin_amdgcn_mbcnt_lo(~0u, 0u)); asm volatile("" : "+v"(l2));
  const int r32b = l2 & 31, hib = l2 >> 5;
  bf16* Ow = Ob + (long)(wid * QBLK) * LDO;
#pragma unroll
  for (int r = 0; r < 16; ++r) { int orow = crow(r, hib);
    _Pragma("unroll") for (int d0 = 0; d0 < 4; ++d0) Ow[(long)orow * LDO + d0 * 32 + r32b] = __float2bfloat16(o[d0][r] * rli[r]); }
  __syncthreads();
#undef LD8
#undef SLOAD
#undef SWRITE
#undef SWAIT
#undef RESC
}
#undef SBAR
}

#define XB_TMO      128
#define XB_XCNT(j)  (256  + 64 * (j))
#define XB_XSUB(j)  (1280 + 64 * (j))
#define XB_XGEN(j)  (2304 + 64 * (j))
#define XB_TOP      3328
#define XB_TOPGEN   3392
#define XCD_BAR_WORDS 3456
#define XB_SPIN_CAP (1u << 18)
__device__ __forceinline__ unsigned xb_ld(unsigned* p)              { return __hip_atomic_load(p, __ATOMIC_RELAXED, __HIP_MEMORY_SCOPE_AGENT); }
__device__ __forceinline__ unsigned xb_add(unsigned* p, unsigned v) { return __hip_atomic_fetch_add(p, v, __ATOMIC_RELAXED, __HIP_MEMORY_SCOPE_AGENT); }
__device__ __forceinline__ unsigned xb_xcc_id() { return (unsigned)__builtin_amdgcn_s_getreg((3 << 11) | 20) & 0xFu; }
#define XB_SPIN(cond, bar) do { unsigned _sp = 0; while (cond) { __builtin_amdgcn_s_sleep(1); \
    if ((++_sp & 255u) == 0u) { if (xb_ld(&(bar)[XB_TMO])) break; if (_sp > XB_SPIN_CAP) { atomicAdd(&(bar)[XB_TMO], 1u); break; } } } } while (0)
struct XcdBarrier { unsigned* bar; unsigned x; volatile LAS unsigned* st; };
__device__ __forceinline__ XcdBarrier xcd_barrier_post(unsigned* bar, volatile LAS unsigned* st) {
    XcdBarrier b; b.bar = bar; b.x = xb_xcc_id(); b.st = st;
    if (threadIdx.x == 0) (void)xb_add(&bar[XB_XCNT(b.x)], 1u);
    return b;
}
__device__ __forceinline__ void xcd_barrier_complete(unsigned* bar, unsigned x, unsigned& nloc, unsigned& nx) {
    const unsigned G = gridDim.x * gridDim.y * gridDim.z;
    unsigned sum, cnt, mine, sp = 0u;
    for (;;) {
        sum = 0u; cnt = 0u; mine = 0u;
#pragma unroll
        for (unsigned j = 0; j < 16; ++j) { const unsigned c = xb_ld(&bar[XB_XCNT(j)]); sum += c; cnt += (c > 0u) ? 1u : 0u; mine = (j == x) ? c : mine; }
        if (sum == G) break;
        __builtin_amdgcn_s_sleep(1);
        if ((++sp & 255u) == 0u) { if (xb_ld(&bar[XB_TMO])) break; if (sp > XB_SPIN_CAP) { atomicAdd(&bar[XB_TMO], 1u); break; } }
    }
    nloc = mine > 0u ? mine : 1u; nx = cnt > 0u ? cnt : 1u;
}
__device__ __forceinline__ void xcd_barrier(const XcdBarrier& b) {
    asm volatile("s_waitcnt vmcnt(0)" ::: "memory");
    __syncthreads();
    if (threadIdx.x == 0) {
        unsigned* bar = b.bar;
        __builtin_amdgcn_s_waitcnt(0);
        unsigned nloc = b.st[0], nx = b.st[1];
        if (nloc == 0u) { xcd_barrier_complete(bar, b.x, nloc, nx); b.st[0] = nloc; b.st[1] = nx; }
        const unsigned old = xb_add(&bar[XB_XSUB(b.x)], 1u);
        const unsigned gen = old / nloc;
        if (old + 1u == (gen + 1u) * nloc) {
            __builtin_amdgcn_fence(__ATOMIC_RELEASE, "agent");
            asm volatile("s_waitcnt vmcnt(0)" ::: "memory");
            const unsigned og = xb_add(&bar[XB_TOP], 1u);
            const unsigned tg = og / nx;
            if (og + 1u == (tg + 1u) * nx) xb_add(&bar[XB_TOPGEN], 1u);
            else XB_SPIN(xb_ld(&bar[XB_TOPGEN]) == tg, bar);
            __builtin_amdgcn_fence(__ATOMIC_ACQUIRE, "agent");
            xb_add(&bar[XB_XGEN(b.x)], 1u);
            asm volatile("s_waitcnt vmcnt(0)" ::: "memory");
        } else {
            XB_SPIN(xb_ld(&bar[XB_XGEN(b.x)]) == gen, bar);
            __builtin_amdgcn_fence(__ATOMIC_ACQUIRE, "agent");
            asm volatile("s_waitcnt vmcnt(0)" ::: "memory");
        }
    }
    __syncthreads();
}

struct Params {
    const float *x, *c, *ctx, *c_ctx, *w_ada, *b_ada, *norm_ffn1, *w_ffn1_in, *w_ffn1_out, *norm_mix, *w_in, *q_norm, *k_norm, *w_ab, *w_fb, *w_out, *norm_ffn2, *w_ffn2_in, *w_ffn2_out;
    float* out; unsigned char* ws; int st_lo, st_hi;
};

__device__ __forceinline__ void transpose_item(const float* __restrict__ W, int K, int N, bf16_t* __restrict__ WT, int kb, int n0, int drow0, int lane, int ldd = 0) {
    if (ldd == 0) ldd = K;
    const int ng = lane & 15, kq = lane >> 4, k0 = 32 * kb + 8 * kq;
    const float* src = W + (size_t)k0 * N + n0 + 4 * ng;
    f32x4 v[8];
#pragma unroll
    for (int i = 0; i < 8; ++i) v[i] = __builtin_nontemporal_load((const f32x4*)(src + (size_t)i * N));
    bf16_t* dst = WT + (size_t)(drow0 + 4 * ng) * ldd + k0;
#pragma unroll
    for (int j = 0; j < 4; ++j) { u32x4 o; o.x = cvt_pk_bf16(v[0][j], v[1][j]); o.y = cvt_pk_bf16(v[2][j], v[3][j]); o.z = cvt_pk_bf16(v[4][j], v[5][j]); o.w = cvt_pk_bf16(v[6][j], v[7][j]);
        *(u32x4*)(dst + (size_t)j * ldd) = o; }
}

__device__ __forceinline__ void prep_phase(const Params& kp_, LAS unsigned char* lds, int tid, int lane, int wave, int G) {
    const Params* kp = &kp_; unsigned char* ws = kp->ws;
    LAS float* tab2048 = (LAS float*)(lds + LDS_MISC);
    LAS float* tab128 = (LAS float*)(lds + LDS_MISC + 8192);
    if (blockIdx.x < 144) {
        LAS float* s_l = (LAS float*)lds;
        LAS float* red = (LAS float*)(lds + 36864);
        for (int i = tid; i < 9216; i += 512) { const int r = i >> 10, k = i & 1023; const float v = (r < 8) ? kp->c[r * 1024 + k] : kp->c_ctx[k]; s_l[i] = v / (1.f + expf(-v)); }
        __syncthreads();
        const int c0 = blockIdx.x * 64, kr = lane >> 4, cgp = lane & 15;
        f32x4 a0 = {}, a1 = {}, a2 = {}, a3 = {}, a4 = {}, a5 = {}, a6 = {}, a7 = {}, a8 = {};
        const float* wp = kp->w_ada + (size_t)(wave * 128 + kr) * NMOD + c0 + 4 * cgp;
#pragma unroll 8
        for (int i = 0; i < 32; ++i) { const f32x4 w = __builtin_nontemporal_load((const f32x4*)(wp + (size_t)i * 4 * NMOD)); const int k = wave * 128 + 4 * i + kr;
            a0 += w * s_l[k]; a1 += w * s_l[1024 + k]; a2 += w * s_l[2048 + k]; a3 += w * s_l[3072 + k]; a4 += w * s_l[4096 + k];
            a5 += w * s_l[5120 + k]; a6 += w * s_l[6144 + k]; a7 += w * s_l[7168 + k]; a8 += w * s_l[8192 + k]; }
#define RED9(a, r) do { _Pragma("unroll") for (int e = 0; e < 4; ++e) { float v = a[e]; v += __shfl_xor(v, 16); v += __shfl_xor(v, 32); if (lane < 16) red[(wave * 9 + r) * 64 + 4 * cgp + e] = v; } } while (0)
        RED9(a0, 0); RED9(a1, 1); RED9(a2, 2); RED9(a3, 3); RED9(a4, 4); RED9(a5, 5); RED9(a6, 6); RED9(a7, 7); RED9(a8, 8);
#undef RED9
        __syncthreads();
        float* mod = (float*)(ws + WS_MOD);
        for (int i = tid; i < 576; i += 512) { const int r = i >> 6, col = i & 63; float s = 0.f;
#pragma unroll
            for (int w = 0; w < 8; ++w) s += red[(w * 9 + r) * 64 + col];
            mod[r * NMOD + c0 + col] = s + kp->b_ada[c0 + col]; }
    }
    __syncthreads();
    const int gw = blockIdx.x * 8 + wave, NGW = G * 8;
    if (blockIdx.x == G - 1) {
        float* rt = (float*)(ws + WS_ROPE);
        for (int i = tid; i < 2048; i += 512) { const int pos = i >> 5, j = i & 31; const float invf = powf(10000.0f, -(float)(2 * j) / 64.0f); const float ang = (float)pos * invf;
            rt[2 * i] = cosf(ang); rt[2 * i + 1] = sinf(ang); }
    }
    constexpr int I_1IN = 32 * 88;
    for (int r = (gw + 1152) % NGW; r < I_1IN; r += NGW) { const int kb = r / 88, n0 = (r % 88) * 64; const int isup = n0 >= DFF, j = isup ? n0 - DFF : n0;
        transpose_item(kp->w_ffn1_in, 1024, 2 * DFF, (bf16_t*)(ws + WS_W1IN), kb, n0, 256 * (j >> 7) + (j & 127) + 128 * isup, lane); }
}

__device__ __forceinline__ void late_weights(const Params& kp_, LAS unsigned char* lds, int tid, int lane, int widx, int nw) {
    const Params* kp = &kp_; unsigned char* ws = kp->ws;
    LAS float* tab2048 = (LAS float*)(lds + LDS_MISC);
    LAS float* tab128 = (LAS float*)(lds + LDS_MISC + 8192);
    for (int i = tid; i < 2048; i += 512) tab2048[i] = cospif((float)i * (1.0f / 1024.0f));
    if (tid < 128) tab128[tid] = cospif((float)tid * (1.0f / 64.0f));
    __syncthreads();
    constexpr int I_FOLD = 1024, I_IN = 32 * 64, I_AB = 32 * 16, I_FB = 16 * 16, I_O = 32 * 16, I_1OUT = 88 * 16;
    for (int r = widx; r < I_1OUT; r += nw) { const int kb = r >> 4, n0 = (r & 15) * 64; transpose_item(kp->w_ffn1_out, DFF, 1024, (bf16_t*)(ws + WS_W1OUT), kb, n0, n0, lane); }
    {
        bf16_t* dft = (bf16_t*)(ws + WS_DFT);
        for (int e8 = widx * 64 + lane; e8 < 2048 * 512; e8 += nw * 64) {
            const int k = e8 >> 9, kp0 = (e8 & 511) * 8, cs = kp0 >> 11, n0 = kp0 & 2047; float v[8];
#pragma unroll
            for (int e = 0; e < 8; ++e) { int idx = (k * (n0 + e)) & 2047; if (cs) idx = (idx + 512) & 2047; v[e] = tab2048[idx] * (1.0f / 512.0f); }
            u32x4 o; o.x = cvt_pk_bf16(v[0], v[1]); o.y = cvt_pk_bf16(v[2], v[3]); o.z = cvt_pk_bf16(v[4], v[5]); o.w = cvt_pk_bf16(v[6], v[7]);
            *(u32x4*)(dft + (size_t)e8 * 8) = o;
        }
    }
    for (int r = widx; r < I_FOLD; r += nw) {
        const int jt = r & 7, g = (r >> 3) & 3, kb = r >> 5, k0 = kb * 32;
        const int jj = jt * 32 + (lane & 31), cs = jj >> 7, m = jj & 127, hi = lane >> 5;
        const float* wrow = kp->w_in + (size_t)(k0 + (lane & 31)) * 4096 + 1536 + g * 128 + hi;
        f32x16 acc = {};
#pragma unroll 8
        for (int s2 = 0; s2 < 64; ++s2) { const int c = 2 * s2 + hi; const float a = wrow[2 * s2]; int idx = (c * m) & 127; if (cs) idx = (idx + 96) & 127;
            acc = __builtin_amdgcn_mfma_f32_32x32x2f32(a, tab128[idx], acc, 0, 0, 0); }
        bf16_t* WfT = (bf16_t*)(ws + WS_WF) + (size_t)(cs * 512 + g * 128 + m) * 1024 + k0 + 4 * hi;
#pragma unroll
        for (int q = 0; q < 4; ++q) { u32x2 o; o.x = cvt_pk_bf16(acc[4 * q], acc[4 * q + 1]); o.y = cvt_pk_bf16(acc[4 * q + 2], acc[4 * q + 3]); *(u32x2*)(WfT + 8 * q) = o; }
    }
    for (int r = widx; r < I_IN; r += nw) { const int kb = r >> 6, n0 = (r & 63) * 64; if (n0 < 1536 || n0 >= 2048) transpose_item(kp->w_in, 1024, 4096, (bf16_t*)(ws + WS_WIN), kb, n0, n0 < 1536 ? n0 : n0 - 512, lane); }
    for (int r = widx; r < I_AB; r += nw) { const int kb = r >> 4, n0 = (r & 15) * 64; transpose_item(kp->w_ab, 1024, 1024, (bf16_t*)(ws + WS_WAB), kb, n0, n0, lane); }
    for (int r = widx; r < I_O; r += nw) { const int kb = r >> 4, n0 = (r & 15) * 64; transpose_item(kp->w_out, 1024, 1024, (bf16_t*)(ws + WS_WO), kb, n0, n0, lane); }
}

template <bool LAT_BF> __device__ __forceinline__ void norm_phase(const float* lat, const float* ctxp, const float* ctxp2, int nrows, const float* gain, const float* mod, int sh_off, int sc_off, bf16_t* A, int gw, int NGW, int lane) {
    for (int r = gw; r < nrows; r += NGW) {
        const bool isctx = r >= NLAT; const float* src = isctx ? ctxp + (size_t)(r - NLAT) * DM : lat + (size_t)r * DM; const int mrow = isctx ? 8 : (r >> 11);
        f32x4 v[4]; float ss = 0.f;
#pragma unroll
        for (int j = 0; j < 4; ++j) { if (LAT_BF && !isctx) { const u32x2 w = __builtin_nontemporal_load((const u32x2*)((const bf16_t*)lat + (size_t)r * DM + 4 * lane + 256 * j)); v[j] = (f32x4){__uint_as_float(w.x << 16), __uint_as_float(w.x & 0xffff0000u), __uint_as_float(w.y << 16), __uint_as_float(w.y & 0xffff0000u)}; } else v[j] = __builtin_nontemporal_load((const f32x4*)(src + 4 * lane + 256 * j)); if (isctx && ctxp2) v[j] += *(const f32x4*)(ctxp2 + (size_t)(r - NLAT) * DM + 4 * lane + 256 * j); ss += (v[j][0] * v[j][0] + v[j][1] * v[j][1]) + (v[j][2] * v[j][2] + v[j][3] * v[j][3]); }
        const float rstd = 1.0f / sqrtf(wave_sum(ss) * (1.0f / DM) + EPS);
        const float* mp = mod + mrow * NMOD;
#pragma unroll
        for (int j = 0; j < 4; ++j) { const int c = 4 * lane + 256 * j; const f32x4 g = *(const f32x4*)(gain + c), sh = *(const f32x4*)(mp + sh_off + c), sc = *(const f32x4*)(mp + sc_off + c);
            const f32x4 o = (v[j] * rstd) * g * (sc + 1.0f) + sh; u32x2 w; w.x = cvt_pk_bf16(o[0], o[1]); w.y = cvt_pk_bf16(o[2], o[3]);
            *(u32x2*)(A + (size_t)r * DM + c) = w; }
    }
}

__device__ __forceinline__ void fix_head(bf16_t* hp, const float* g, const float* ropetab, int n, bool rope, int lane) {
    float t1 = bf2f(hp[lane]), t2 = bf2f(hp[lane + 64]);
    const float rstd = 1.0f / sqrtf(wave_sum(t1 * t1 + t2 * t2) * (1.0f / 128.0f) + EPS);
    t1 = t1 * rstd * g[lane]; t2 = t2 * rstd * g[lane + 64];
    float o1 = t1, o2 = t2;
    if (rope) { const int pos = lane < 32 ? (n >> 6) : (n & 63); const float c = ropetab[2 * (pos * 32 + (lane & 31))], s = ropetab[2 * (pos * 32 + (lane & 31)) + 1]; o1 = t1 * c - t2 * s; o2 = t2 * c + t1 * s; }
    hp[lane] = f2bf(o1); hp[lane + 64] = f2bf(o2);
}
__device__ __forceinline__ void fixup_phase(unsigned char* ws, const float* q_norm, const float* k_norm, int gw, int NGW, int lane) {
    bf16_t* Q = (bf16_t*)(ws + WS_Q); bf16_t* Kb = (bf16_t*)(ws + WS_K); const float* rt = (const float*)(ws + WS_ROPE);
    for (int r = gw; r < NTOK; r += NGW) {
        if (r < NLAT) { const int b = r >> 11, n = r & 2047;
            for (int h = 0; h < 8; ++h) fix_head(Q + (size_t)r * DM + h * 128, q_norm, rt, n, true, lane);
            for (int h = 0; h < 2; ++h) fix_head(Kb + (size_t)(b * SKV + CTXL + n) * 256 + h * 128, k_norm, rt, n, true, lane);
        } else { const int rc = r - NLAT, b = rc >> 8, n = rc & 255;
            for (int h = 0; h < 2; ++h) fix_head(Kb + (size_t)(b * SKV + n) * 256 + h * 128, k_norm, rt, 0, false, lane); }
    }
}

constexpr int NSTEPS = 15;
__host__ __device__ constexpr bool sync_after(int st) { return !(st == 7 || st == 9); }

__global__ void __launch_bounds__(512, 2) mk_fwd(Params p) {
    extern __shared__ __attribute__((aligned(16))) unsigned char lds_raw[];
    LAS unsigned char* lds = (LAS unsigned char*)lds_raw;
    const int G = gridDim.x, c = blockIdx.x, NGW = G * 8;
    const int lo = p.st_lo, hi = p.st_hi;
    unsigned char* const ws = p.ws;
    const float* const mod = (const float*)(ws + WS_MOD);
    bf16_t* const Abuf = (bf16_t*)(ws + WS_A);
#define IN(k) (lo <= (k) && (k) < hi)
    volatile LAS unsigned* bst = (volatile LAS unsigned*)(lds + LDS_MISC + 12288);
    if (threadIdx.x < 2) bst[threadIdx.x] = 0u;
    __syncthreads();
    XcdBarrier gbar; gbar.bar = (unsigned*)(ws + WS_BAR); gbar.x = 0; gbar.st = bst;
    if (hi - lo > 1) gbar = xcd_barrier_post((unsigned*)(ws + WS_BAR), bst);
    if (hi < 0) cg::this_grid().sync();
#define SEAM(k) do { if (IN(k) && IN((k) + 1)) { if (sync_after(k)) xcd_barrier(gbar); else { __syncthreads(); } } } while (0)
#define TIDS() int tid = threadIdx.x; asm volatile("" : "+v"(tid)); const int lane = tid & 63, wave = __builtin_amdgcn_readfirstlane(tid >> 6), gw = c * 8 + wave; (void)lane; (void)gw
#define GEMM1P(PRM, KK, a, b, nm, nn, kd, rm) do { const pg8::Sched S{(a), nullptr, nullptr, (b), nullptr, nullptr, (nm), 1, 1, (nn), 1, 1, (kd), (kd), (kd), (nm) * (nn), 0, 0, G, c, (KK), 0, (KK) / 64, (KK) / 64, (KK) / 64, 0, 0}; \
        const pg8::Epi E{ws, p.out, p.x, p.ctx, (rm), p.k_norm, p.norm_ffn2, (const LAS float*)(lds + LDS_MISC)}; pg8::gemm_phase<true, true, PRM>(lds, S, E, tid); } while (0)
#define GEMM1(KK, a, b, nm, nn, kd, rm) GEMM1P(true, KK, a, b, nm, nn, kd, rm)
    if (IN(0)) { TIDS(); prep_phase(p, lds, tid, lane, wave, G); }
    SEAM(0);
    if (IN(1)) { TIDS(); norm_phase<false>(p.x, p.ctx, nullptr, NTOK, p.norm_ffn1, mod, 0 * DM, 1 * DM, Abuf, gw, NGW, lane); }
    SEAM(1);
    if (IN(2)) { TIDS(); GEMM1(1024, Abuf, (const bf16_t*)(ws + WS_W1IN), NTOK / 256, 22, pg8::K_SWIGLU, 0);
        constexpr int NBUSY = (NTOK / 256) * 22 - 6 * 256;
        int t2 = threadIdx.x; asm volatile("" : "+v"(t2)); const int w2 = __builtin_amdgcn_readfirstlane(t2 >> 6);
        if (G == 256 && c >= NBUSY) late_weights(p, lds, t2, t2 & 63, (c - NBUSY) * 8 + w2, (256 - NBUSY) * 8);
        else if (G != 256) late_weights(p, lds, t2, t2 & 63, c * 8 + w2, NGW); }
    SEAM(2);
    if (IN(3)) { TIDS();
        const bf16_t* Hc = (const bf16_t*)(ws + WS_H) + (size_t)NLAT * DFF;
        const pg8::Sched S{(const bf16_t*)(ws + WS_H), Hc, Hc, (const bf16_t*)(ws + WS_W1OUT), (const bf16_t*)(ws + WS_W1OUT), (const bf16_t*)(ws + WS_W1OUT),
                           64, 8, 8, 4, 4, 4, pg8::K_RES, pg8::K_RESC0, pg8::K_RESC1, 256, 32, 32, G, c, DFF, 0, 44, 22, 22, 0, DFF / 2};
        const pg8::Epi E{ws, p.out, p.x, p.ctx, 0, p.k_norm, p.norm_ffn2, (const LAS float*)(lds + LDS_MISC)}; pg8::gemm_phase<true, true>(lds, S, E, tid); }
    SEAM(3);
    if (IN(4)) { TIDS(); norm_phase<true>(p.out, (const float*)(ws + WS_CTX1), (const float*)(ws + WS_CTX1B), NTOK, p.norm_mix, mod, 3 * DM, 4 * DM, Abuf, gw, NGW, lane); }
    SEAM(4);
    if (IN(5)) { TIDS();
        const pg8::Sched S{Abuf, (const bf16_t*)(ws + WS_WF), Abuf + (size_t)NLAT * DM, (const bf16_t*)(ws + WS_WIN), Abuf, (const bf16_t*)(ws + WS_WIN) + (size_t)1024 * DM,
                           64, 4, 8, 14, 64, 2, pg8::K_INPROJ, pg8::K_FTSWAP, pg8::K_CTXKV, 64 * 14, 256, 16, G, c, 1024, 0, 16, 16, 16, 0, 0};
        const pg8::Epi E{ws, p.out, p.x, p.ctx, 0, p.k_norm, p.norm_ffn2, (const LAS float*)(lds + LDS_MISC)}; pg8::gemm_phase<true, true>(lds, S, E, tid);
        if (G == 256 && c >= 144) {
            int t2 = threadIdx.x; asm volatile("" : "+v"(t2)); const int lane = t2 & 63;
            const int w2 = (c - 144) * 8 + __builtin_amdgcn_readfirstlane(t2 >> 6), nw2 = 112 * 8;
            for (int r = w2; r < 32 * 88; r += nw2) { const int kb = r / 88, n0 = (r % 88) * 64; const int isup = n0 >= DFF, j = isup ? n0 - DFF : n0;
                transpose_item(p.w_ffn2_in, 1024, 2 * DFF, (bf16_t*)(ws + WS_W2IN), kb, n0, 256 * (j >> 7) + (j & 127) + 128 * isup, lane); }
            for (int r = w2; r < 88 * 16; r += nw2) { const int kb = r >> 4, n0 = (r & 15) * 64; transpose_item(p.w_ffn2_out, DFF, 1024, (bf16_t*)(ws + WS_W2OUT), kb, n0, n0, lane); }
            for (int r = w2; r < 2 * 16 * 16; r += nw2) { const int hf = r >> 8, q = r & 255, kb = q >> 4, n0 = (q & 15) * 64;
                transpose_item(p.w_fb, 512, 1024, (bf16_t*)(ws + WS_WFB2) + hf * 512, kb, n0, n0, lane, 1024); }
        } }
    if (IN(5) && IN(7)) xcd_barrier(gbar);
    if (IN(7)) { TIDS();
        {
            const bf16_t* FTp = (const bf16_t*)(ws + WS_FT); bf16_t* YFp = (bf16_t*)(ws + WS_YF);
            for (int j = gw; j < 4096; j += NGW) { const bf16_t* src = FTp + (size_t)j * 4096 + 32 * lane; float acc_ = 0.f;
#pragma unroll
                for (int q4 = 0; q4 < 4; ++q4) { f32x4 a0, a1; unpack8(*(const u32x4*)(src + 8 * q4), a0, a1); acc_ += (a0[0] - a0[1]) + (a0[2] - a0[3]) + (a1[0] - a1[1]) + (a1[2] - a1[3]); }
                const float tot = wave_sum(acc_) * (1.0f / 512.0f);
                if (lane == 0) YFp[(size_t)((j >> 9) * SEQ + 1024) * 1024 + (j & 511)] = f2bf(tot); }
        }
        const pg8::Sched S{(const bf16_t*)(ws + WS_DFT), nullptr, nullptr, (const bf16_t*)(ws + WS_FT), nullptr, nullptr, 4, 1, 1, 16, 1, 1, pg8::K_FOUR2, pg8::K_FOUR2, pg8::K_FOUR2, 256, 0, 0, G, c, 4096, 1, 16, 16, 16, 0, 0};
        const pg8::Epi E{ws, p.out, p.x, p.ctx, 0, p.k_norm, p.norm_ffn2, (const LAS float*)(lds + LDS_MISC)}; pg8::gemm_phase<true, true>(lds, S, E, tid); }
    SEAM(7);
    if (IN(8)) { TIDS();
        const int x = c & 7, s = c >> 3; const int j0 = 2 * s; int nj = 2; asm volatile("" : "+s"(nj));
#pragma unroll 1
        for (int i = 0; i < nj; ++i) { const int j = j0 + i, kvh = j >> 5, h = kvh * 4 + ((j >> 3) & 3), qb = j & 7;
            att::bf16* Qb = (att::bf16*)(ws + WS_Q) + (size_t)(x * SEQ + qb * 256) * DM + h * 128;
            const att::bf16* Kh = (const att::bf16*)(ws + WS_K) + (size_t)x * SKV * 256 + kvh * 128;
            const att::bf16* Vh = (const att::bf16*)(ws + WS_V) + (size_t)x * SKV * 256 + kvh * 128;
            const int tu = tid;
            att::attn_unit(Qb, Kh, Vh, Qb, SKV, (char*)lds_raw, tu, p.q_norm, (const float*)(ws + WS_ROPE), qb * 256); }
        {
            int t2 = threadIdx.x; asm volatile("" : "+v"(t2)); const int ln = t2 & 63, wv = __builtin_amdgcn_readfirstlane(t2 >> 6);
            const bf16_t* W2 = (const bf16_t*)(ws + WS_W2IN); float* sw3 = (float*)(ws + WS_SW3);
            for (int n = c * 8 + wv; n < 2 * DFF; n += NGW) {
                const u32x4 w0 = *(const u32x4*)(W2 + (size_t)n * DM + 8 * ln), w1 = *(const u32x4*)(W2 + (size_t)n * DM + 512 + 8 * ln);
                f32x4 a0, a1, a2, a3; unpack8(w0, a0, a1); unpack8(w1, a2, a3);
#pragma unroll
                for (int b = 0; b < 8; ++b) { const float* sh = mod + b * NMOD + 6 * DM + 8 * ln;
                    const f32x4 s0 = *(const f32x4*)sh, s1 = *(const f32x4*)(sh + 4), s2 = *(const f32x4*)(sh + 512), s3 = *(const f32x4*)(sh + 516);
                    const f32x4 pr = a0 * s0 + a1 * s1 + a2 * s2 + a3 * s3; const float d = wave_sum((pr[0] + pr[1]) + (pr[2] + pr[3]));
                    if (ln == 0) sw3[b * (2 * DFF) + n] = d; }
            }
        }
    }
    SEAM(8);
    if (IN(9)) { TIDS();
        const pg8::Sched S{(const bf16_t*)(ws + WS_Q), (const bf16_t*)(ws + WS_YF), nullptr, (const bf16_t*)(ws + WS_WAB), (const bf16_t*)(ws + WS_WFB2), nullptr,
                           64, 64, 1, 4, 4, 1, pg8::K_BRA, pg8::K_BRB, pg8::K_BRB, 256, 256, 0, G, c, 1024, 2, 16, 8, 16, 0, 0};
        const pg8::Epi E{ws, p.out, p.x, p.ctx, 0, p.k_norm, p.norm_ffn2, (const LAS float*)(lds + LDS_MISC)}; pg8::gemm_phase<true, true>(lds, S, E, tid); }
    SEAM(9);
    SEAM(10);
    if (IN(11)) { TIDS(); GEMM1(1024, (const bf16_t*)(ws + WS_GA), (const bf16_t*)(ws + WS_WO), 64, 4, pg8::K_RES, 1); }
    if (IN(11) && IN(13)) xcd_barrier(gbar);
    if (IN(13)) { TIDS();
        {
            LAS float* rs = (LAS float*)(lds + LDS_MISC); const float* st3 = (const float*)(ws + WS_ST3) + (size_t)(c & 7) * 2048 * 16;
            for (int r = tid; r < 2048; r += 512) { const f32x4* sp = (const f32x4*)(st3 + (size_t)r * 16); const f32x4 q = (sp[0] + sp[1]) + (sp[2] + sp[3]);
                rs[r] = 1.0f / sqrtf(((q[0] + q[1]) + (q[2] + q[3])) * (1.0f / DM) + EPS); }
            __syncthreads();
        }
        GEMM1(1024, Abuf, (const bf16_t*)(ws + WS_W2IN), 64, 22, pg8::K_SWIGLU, 3); }
    SEAM(13);
    if (IN(14)) { TIDS(); GEMM1(DFF, (const bf16_t*)(ws + WS_H), (const bf16_t*)(ws + WS_W2OUT), 64, 4, pg8::K_RES, 2); }
#undef IN
#undef SEAM
#undef TIDS
#undef GEMM1
#undef GEMM1P
}

extern "C" void kernel_launch(void* const* d_in, const int* in_sizes, int n_in, void* d_out, int out_size, void* d_ws, size_t ws_size, hipStream_t stream) {
    static int grid = 0;
    if (grid == 0) {
        if (n_in != 19 || out_size != NLAT * DM || ws_size < WS_END) { fprintf(stderr, "kernel_launch: unexpected shapes (n_in %d out %d ws %zu)\n", n_in, out_size, ws_size); grid = -1; return; }
        int dev = 0, cus = 0, per_cu = 0;
        hipGetDevice(&dev); hipDeviceGetAttribute(&cus, hipDeviceAttributeMultiprocessorCount, dev);
        if (hipFuncSetAttribute((const void*)mk_fwd, hipFuncAttributeMaxDynamicSharedMemorySize, LDS_BYTES) != hipSuccess) { fprintf(stderr, "kernel_launch: hipFuncSetAttribute failed\n"); grid = -1; return; }
        hipOccupancyMaxActiveBlocksPerMultiprocessor(&per_cu, (const void*)mk_fwd, 512, LDS_BYTES);
        (void)hipGetLastError();
        if (cus != 256 || per_cu < 1) fprintf(stderr, "kernel_launch: note: cus %d per_cu %d (built for 256 x 1)\n", cus, per_cu);
        grid = 256;
    }
    if (grid < 0) return;
    Params p{};
    const float** pp = (const float**)&p;
    for (int i = 0; i < 19; ++i) pp[i] = (const float*)d_in[i];
    p.out = (float*)d_out; p.ws = (unsigned char*)d_ws;
    if (hipMemsetAsync((char*)d_ws + WS_BAR, 0, BAR_BYTES, stream) != hipSuccess) { fprintf(stderr, "kernel_launch: memset failed\n"); return; }
#if MK_MULTI
    int lo = 0;
    for (int st = 0; st < NSTEPS; ++st) {
        if (sync_after(st) || st == NSTEPS - 1) { p.st_lo = lo; p.st_hi = st + 1; hipLaunchKernelGGL(mk_fwd, dim3(grid), dim3(512), LDS_BYTES, stream, p); lo = st + 1; }
    }
#else
    p.st_lo = 0; p.st_hi = NSTEPS;
    void* args[] = {&p};
    hipError_t e = hipLaunchCooperativeKernel((const void*)mk_fwd, dim3(grid), dim3(512), args, LDS_BYTES, stream);
    if (e != hipSuccess) fprintf(stderr, "cooperative launch failed: %s\n", hipGetErrorString(e));
#endif
}
```

```cpp
#include <hip/hip_runtime.h>
#include <hip/hip_cooperative_groups.h>
#include <hip/hip_bf16.h>
#include <cstdio>
#include <cstdint>
namespace cg = cooperative_groups;

#ifndef MK_MULTI
#define MK_MULTI 0
#endif

#define LAS __attribute__((address_space(3)))
typedef unsigned short bf16_t;
typedef short bf16x8 __attribute__((ext_vector_type(8)));
typedef float f32x4 __attribute__((ext_vector_type(4)));
typedef float f32x16 __attribute__((ext_vector_type(16)));
typedef unsigned u32x4 __attribute__((ext_vector_type(4)));
typedef unsigned u32x2 __attribute__((ext_vector_type(2)));
typedef short s16x4 __attribute__((ext_vector_type(4)));

constexpr int DM = 1024, NB = 8, SEQ = 2048, CTXL = 256, NLAT = NB * SEQ, NCTX = NB * CTXL, NTOK = NLAT + NCTX;
constexpr int DFF = 2816, NMOD = 9 * DM, SKV = CTXL + SEQ;
constexpr float EPS = 1e-6f;

constexpr size_t MiB = 1u << 20;
constexpr size_t WS_MOD = 0, WS_ROPE = 384 * 1024, WS_BAR = 512 * 1024, WS_CNT = WS_BAR + 16384, BAR_BYTES = 16384 + 65536;
constexpr size_t WS_W1IN = 1 * MiB, WS_W1OUT = 12 * MiB, WS_WIN = 18 * MiB, WS_WF = 25 * MiB, WS_WAB = 27 * MiB, WS_WFB = 29 * MiB, WS_WO = 30 * MiB;
constexpr size_t WS_W2IN = 32 * MiB, WS_W2OUT = 43 * MiB, WS_DFT = 49 * MiB, WS_A = 65 * MiB, WS_CTX1 = 101 * MiB, WS_H = 109 * MiB;
constexpr size_t WS_Q = 109 * MiB, WS_K = 141 * MiB, WS_V = 150 * MiB, WS_GA = 159 * MiB, WS_GF = 191 * MiB, WS_FT = 223 * MiB, WS_YF = WS_A, WS_CTX1B = WS_FT, WS_X2 = WS_FT, WS_WFB2 = WS_W1IN, WS_ST3 = WS_CTX1, WS_SW3 = WS_CTX1 + 2 * MiB, WS_END = 255 * MiB;

constexpr int LDS_BYTES = 147456;
constexpr int LDS_MISC = 131072;

__device__ __forceinline__ unsigned cvt_pk_bf16(float lo, float hi) { unsigned r; asm volatile("v_cvt_pk_bf16_f32 %0, %1, %2" : "=v"(r) : "v"(lo), "v"(hi)); return r; }
__device__ __forceinline__ u32x4 pack8(f32x4 a, f32x4 b) { u32x4 w; w.x = cvt_pk_bf16(a[0], a[1]); w.y = cvt_pk_bf16(a[2], a[3]); w.z = cvt_pk_bf16(b[0], b[1]); w.w = cvt_pk_bf16(b[2], b[3]); return w; }
__device__ __forceinline__ void st16_wt(void* p, u32x4 v) {
    asm volatile("global_store_dwordx4 %0, %1, off sc1\n\ts_nop 1" :: "v"(p), "v"(v) : "memory");
}
__device__ __forceinline__ void unpack8(u32x4 w, f32x4& a, f32x4& b) {
    a[0] = __uint_as_float(w.x << 16); a[1] = __uint_as_float(w.x & 0xffff0000u); a[2] = __uint_as_float(w.y << 16); a[3] = __uint_as_float(w.y & 0xffff0000u);
    b[0] = __uint_as_float(w.z << 16); b[1] = __uint_as_float(w.z & 0xffff0000u); b[2] = __uint_as_float(w.w << 16); b[3] = __uint_as_float(w.w & 0xffff0000u); }
__device__ __forceinline__ float bf2f(bf16_t v) { return __uint_as_float((unsigned)v << 16); }
__device__ __forceinline__ bf16_t f2bf(float f) { unsigned u = __float_as_uint(f); return (bf16_t)((u + 0x7fffu + ((u >> 16) & 1u)) >> 16); }
__device__ __forceinline__ float sigmoidf_(float v) { return __builtin_amdgcn_rcpf(1.f + __builtin_amdgcn_exp2f(-1.4426950408889634f * v)); }
__device__ __forceinline__ float wave_sum(float v) {
#pragma unroll
    for (int o = 1; o < 64; o <<= 1) v += __shfl_xor(v, o);
    return v;
}

namespace pg8 {
constexpr int BM = 256, BK = 64, HALF = 128, HTB = HALF * BK * 2, STAGE_BYTES = 8 * HTB, NXCD = 8, WGM = 8;
__host__ __device__ __forceinline__ int lds_byte(int r, int c) { const int st = (r >> 4) * 2 + (c >> 5), rr = r & 15, cc = c & 31, ob = rr * 64 + cc * 2; return st * 1024 + (ob ^ (((ob >> 9) & 1) << 5)); }
__host__ __device__ __forceinline__ void stage_rc(int b, int& R, int& C) { const int st = b / 1024, sb = b % 1024, swz = sb ^ (((sb >> 9) & 1) << 5); R = (st >> 1) * 16 + swz / 64; C = (st & 1) * 32 + (swz % 64) / 2; }
__host__ __device__ __forceinline__ int perm32(int rho) { const int n = rho >> 4, i = rho & 15; return 8 * (i >> 2) + 4 * n + (i & 3); }

struct Unit { int pm, pn, sub, q; };
enum Kind { K_SWIGLU = 0, K_RES = 1, K_INPROJ = 2, K_FTSWAP = 3, K_CTXKV = 4, K_FOUR2 = 5, K_BRA = 6, K_BRB = 7, K_RESC0 = 8, K_RESC1 = 9 };

struct Sched {
    const bf16_t *A0, *A1, *A2, *B0, *B1, *B2; int nM0, nM1, nM2, nN0, nN1, nN2, k0, k1, k2; int n0, n1, n2; int G, c, K, direct; int kt0, kt1, kt2, ko1, ko2;
    static __device__ __forceinline__ int sel3(int sub, int v0, int v1, int v2) { const int m1 = -(int)(sub == 1), m2 = -(int)(sub == 2); return v0 ^ ((v0 ^ v1) & m1) ^ ((v0 ^ v2) & m2); }
    static __device__ __forceinline__ unsigned long long sel3p(int sub, const void* p0, const void* p1, const void* p2) {
        const unsigned long long v0 = (unsigned long long)p0, v1 = (unsigned long long)p1, v2 = (unsigned long long)p2, m1 = -(unsigned long long)(sub == 1), m2 = -(unsigned long long)(sub == 2);
        return v0 ^ ((v0 ^ v1) & m1) ^ ((v0 ^ v2) & m2); }
    __device__ __forceinline__ bool next(int i, Unit& u) const {
        u.q = 0;
        if (direct == 1) { if (i > 0) return false; const int x = c & 7, s = c >> 3, r = s & 7; u.sub = 0; u.q = s >> 3; u.pm = r & 3; u.pn = 2 * x + (r >> 2); return true; }
        if (direct == 2) {
            if (i > 1 || c >= n0) return false; u.sub = i;
            const int nwg = nM0 * nN0; int wgid; { const int q = nwg / NXCD, r = nwg % NXCD, xcd = c % NXCD, off = c / NXCD; wgid = (xcd < r ? xcd * (q + 1) : r * (q + 1) + (xcd - r) * q) + off; }
            const int nig = WGM * nN0, gid = wgid / nig, fm = gid * WGM, gsz = (nM0 - fm) < WGM ? (nM0 - fm) : WGM;
            u.pm = fm + ((wgid % nig) % gsz); u.pn = (wgid % nig) / gsz; return true; }
        const long L = (long)i * G + c;
        if (L >= n0 + n1 + n2) return false;
        const int sub = (L >= n0) + (L >= n0 + n1); u.sub = sub;
        const int l = (int)L - sel3(sub, 0, n0, n0 + n1), nM = sel3(sub, nM0, nM1, nM2), nN = sel3(sub, nN0, nN1, nN2);
        const int nwg = nM * nN; int wgid; { const int q = nwg / NXCD, r = nwg % NXCD, xcd = l % NXCD, off = l / NXCD; wgid = (xcd < r ? xcd * (q + 1) : r * (q + 1) + (xcd - r) * q) + off; }
        const int nig = WGM * nN, gid = wgid / nig, fm = gid * WGM, gsz = (nM - fm) < WGM ? (nM - fm) : WGM;
        u.pm = fm + ((wgid % nig) % gsz); u.pn = (wgid % nig) / gsz; return true;
    }
    __device__ __forceinline__ const char* aptr(const Unit& u) const { return (const char*)sel3p(u.sub, A0, A1, A2) + (size_t)u.pm * (size_t)(512 * K) + 2 * sel3(u.sub, 0, ko1, ko2) + (direct == 1 ? 2048 * u.q : 0); }
    __device__ __forceinline__ const char* bptr(const Unit& u) const { return (const char*)sel3p(u.sub, B0, B1, B2) + (size_t)u.pn * (size_t)(512 * K) + 2 * sel3(u.sub, 0, ko1, ko2) + (direct == 1 ? 2048 * u.q : 0); }
    __device__ __forceinline__ int ktiles(const Unit& u) const { return sel3(u.sub, kt0, kt1, kt2); }
    __device__ __forceinline__ int kind(const Unit& u) const { return sel3(u.sub, k0, k1, k2); }
};

struct Epi {
    unsigned char* ws; float* out; const float* x; const float* ctx; int res_mode; const float* kg; const float* ng; const LAS float* rs;
    template <bool PERM> __device__ __forceinline__ void run(f32x4 (&acc)[2][2][4][2], const Unit& u, int kind, int wr, int wc, int fr_in, int fq_in) const {
        int fr = fr_in, fq = fq_in; asm volatile("" : "+v"(fr), "+v"(fq));
        const int rowt = u.pm * 256 + wr * 64 + fr;
        const int cw = wc * 32 + 8 * fq;
        if (kind == K_SWIGLU) {
            bf16_t* H = (bf16_t*)(ws + WS_H);
            const bool fn = (res_mode == 3);
            f32x4 sg[2], su[2];
            if (fn) { const float* sw = (const float*)(ws + WS_SW3) + (u.pm >> 3) * (2 * DFF) + u.pn * 256 + cw;
#pragma unroll
                for (int n = 0; n < 2; ++n) { sg[n] = *(const f32x4*)(sw + 4 * n); su[n] = *(const f32x4*)(sw + 128 + 4 * n); } }
#pragma unroll
            for (int ai = 0; ai < 2; ++ai)
#pragma unroll
                for (int m = 0; m < 4; ++m) {
                    const int row = rowt + ai * 128 + m * 16; f32x4 h[2];
                    const float rstd = fn ? rs[row & 2047] : 1.f;
#pragma unroll
                    for (int n = 0; n < 2; ++n) { f32x4 g = acc[ai][0][m][n], up = acc[ai][1][m][n]; if (fn) { g = g * rstd + sg[n]; up = up * rstd + su[n]; }
#pragma unroll
                        for (int e = 0; e < 4; ++e) h[n][e] = g[e] * sigmoidf_(g[e]) * up[e]; }
                    *(u32x4*)(H + (size_t)row * DFF + u.pn * 128 + cw) = pack8(h[0], h[1]);
                }
        } else if (kind == K_RES || kind == K_RESC0 || kind == K_RESC1) {
            const float* mod = (const float*)(ws + WS_MOD);
            const bool isctx = kind != K_RES, nobase = kind == K_RESC1;
            const bool in_bf = (res_mode != 0), out_bf = (res_mode == 1) || (res_mode == 0 && !isctx);
            const float* basef = isctx ? ctx : x; float* dstf = isctx ? (float*)(ws + (nobase ? WS_CTX1B : WS_CTX1)) : out;
            const bf16_t* baseb = res_mode == 1 ? (const bf16_t*)out : (const bf16_t*)(ws + WS_X2); bf16_t* dstb = res_mode == 0 ? (bf16_t*)out : (bf16_t*)(ws + WS_X2);
            const int gate_off = res_mode == 0 ? 2 * DM : (res_mode == 1 ? 5 * DM : 8 * DM); const float coef = res_mode == 1 ? 1.f : 0.5f;
            const int mrow = isctx ? 8 : (u.pm >> 3);
            const float* gp = mod + mrow * NMOD + gate_off + u.pn * 256 + cw;
            f32x4 gv[2][2], gg[2][2];
#pragma unroll
            for (int bj = 0; bj < 2; ++bj)
#pragma unroll
                for (int n = 0; n < 2; ++n) { gv[bj][n] = *(const f32x4*)(gp + bj * 128 + 4 * n) * coef; gg[bj][n] = gv[bj][n];
                    if (res_mode == 1) gg[bj][n] = *(const f32x4*)(ng + u.pn * 256 + cw + bj * 128 + 4 * n) * (*(const f32x4*)(mod + mrow * NMOD + 7 * DM + u.pn * 256 + cw + bj * 128 + 4 * n) + 1.0f); }
#pragma unroll
            for (int ai = 0; ai < 2; ++ai) {
                f32x4 bv[4][2][2];
#pragma unroll
                for (int m = 0; m < 4; ++m) { const size_t off = (size_t)(rowt + ai * 128 + m * 16) * DM + u.pn * 256 + cw;
#pragma unroll
                    for (int bj = 0; bj < 2; ++bj) {
                        if (in_bf) unpack8(__builtin_nontemporal_load((const u32x4*)(baseb + off + bj * 128)), bv[m][bj][0], bv[m][bj][1]);
                        else if (nobase) { bv[m][bj][0] = (f32x4){0.f, 0.f, 0.f, 0.f}; bv[m][bj][1] = bv[m][bj][0]; }
                        else { bv[m][bj][0] = __builtin_nontemporal_load((const f32x4*)(basef + off + bj * 128)); bv[m][bj][1] = __builtin_nontemporal_load((const f32x4*)(basef + off + bj * 128 + 4)); } } }
#pragma unroll
                for (int m = 0; m < 4; ++m) { const size_t off = (size_t)(rowt + ai * 128 + m * 16) * DM + u.pn * 256 + cw; float ss = 0.f;
#pragma unroll
                    for (int bj = 0; bj < 2; ++bj) { const f32x4 v0 = bv[m][bj][0] + gv[bj][0] * acc[ai][bj][m][0], v1 = bv[m][bj][1] + gv[bj][1] * acc[ai][bj][m][1];
                        if (out_bf) *(u32x4*)(dstb + off + bj * 128) = pack8(v0, v1);
                        else { *(f32x4*)(dstf + off + bj * 128) = v0; *(f32x4*)(dstf + off + bj * 128 + 4) = v1; }
                        if (res_mode == 1) {
                            *(u32x4*)((bf16_t*)(ws + WS_A) + off + bj * 128) = pack8(v0 * gg[bj][0], v1 * gg[bj][1]);
                            ss += (v0[0] * v0[0] + v0[1] * v0[1]) + (v0[2] * v0[2] + v0[3] * v0[3]) + (v1[0] * v1[0] + v1[1] * v1[1]) + (v1[2] * v1[2] + v1[3] * v1[3]); } }
                    if (res_mode == 1) { ss += __shfl_xor(ss, 16); ss += __shfl_xor(ss, 32);
                        if (fq == 0) ((float*)(ws + WS_ST3))[(size_t)(rowt + ai * 128 + m * 16) * 16 + u.pn * 4 + wc] = ss; } }
            }
        } else if (kind == K_INPROJ || kind == K_CTXKV) {
            bf16_t* dstb; int ld, rowadd, colb; bool sig = false;
            if (kind == K_INPROJ) {
                const int pn = u.pn;
                if (pn < 4) { dstb = (bf16_t*)(ws + WS_Q); ld = DM; rowadd = 0; colb = pn * 256; }
                else if (pn < 6) { dstb = (bf16_t*)(ws + (pn == 4 ? WS_K : WS_V)); ld = 256; rowadd = 256 * ((u.pm >> 3) + 1); colb = 0; }
                else if (pn < 10) { dstb = (bf16_t*)(ws + WS_GA); ld = DM; rowadd = 0; colb = (pn - 6) * 256; sig = true; }
                else { dstb = (bf16_t*)(ws + WS_GF); ld = DM; rowadd = 0; colb = (pn - 10) * 256; sig = true; }
            } else { dstb = (bf16_t*)(ws + (u.pn == 0 ? WS_K : WS_V)); ld = 256; rowadd = u.pm * (SKV - CTXL); colb = 0; }
#pragma unroll
            for (int ai = 0; ai < 2; ++ai)
#pragma unroll
                for (int m = 0; m < 4; ++m) {
                    const int row = rowt + ai * 128 + m * 16 + rowadd;
#pragma unroll
                    for (int bj = 0; bj < 2; ++bj) { f32x4 a = acc[ai][bj][m][0], b = acc[ai][bj][m][1];
                        if (sig) {
#pragma unroll
                            for (int e = 0; e < 4; ++e) { a[e] = sigmoidf_(a[e]); b[e] = sigmoidf_(b[e]); } }
                        *(u32x4*)(dstb + (size_t)row * ld + colb + bj * 128 + cw) = pack8(a, b); }
                }
            const bool isk = (kind == K_INPROJ) ? (u.pn == 4) : (u.pn == 0);
            if (isk) {
                asm volatile("s_waitcnt vmcnt(0)" ::: "memory"); __builtin_amdgcn_s_barrier(); asm volatile("" ::: "memory");
                const float* rt = (const float*)(ws + WS_ROPE); const bool rope = (kind == K_INPROJ);
                const int lane = fq * 16 + fr, wid = wr * 4 + wc, l16 = lane & 15;
                const f32x4 g1 = *(const f32x4*)(kg + 4 * l16), g2 = *(const f32x4*)(kg + 64 + 4 * l16);
#pragma unroll 4
                for (int it = 0; it < 16; ++it) { const int item = it * 32 + wid * 4 + (lane >> 4), r = item >> 1, hd = item & 1;
                    bf16_t* hp = dstb + (size_t)(u.pm * 256 + r + rowadd) * 256 + hd * 128 + 4 * l16;
                    const u32x2 w1 = *(const u32x2*)hp, w2 = *(const u32x2*)(hp + 64);
                    f32x4 t1 = {__uint_as_float(w1.x << 16), __uint_as_float(w1.x & 0xffff0000u), __uint_as_float(w1.y << 16), __uint_as_float(w1.y & 0xffff0000u)};
                    f32x4 t2 = {__uint_as_float(w2.x << 16), __uint_as_float(w2.x & 0xffff0000u), __uint_as_float(w2.y << 16), __uint_as_float(w2.y & 0xffff0000u)};
                    float ss = (t1[0] * t1[0] + t1[1] * t1[1]) + (t1[2] * t1[2] + t1[3] * t1[3]) + (t2[0] * t2[0] + t2[1] * t2[1]) + (t2[2] * t2[2] + t2[3] * t2[3]);
                    ss += __shfl_xor(ss, 1); ss += __shfl_xor(ss, 2); ss += __shfl_xor(ss, 4); ss += __shfl_xor(ss, 8);
                    const float rstd = 1.0f / sqrtf(ss * (1.0f / 128.0f) + EPS);
                    t1 = t1 * rstd * g1; t2 = t2 * rstd * g2;
                    if (rope) { const int n = ((u.pm & 7) * 256 + r); const int pos = l16 < 8 ? (n >> 6) : (n & 63); const float* rp = rt + 2 * (pos * 32 + ((4 * l16) & 31));
                        const f32x4 c0 = *(const f32x4*)rp, c1 = *(const f32x4*)(rp + 4); f32x4 o1, o2;
                        o1[0] = t1[0] * c0[0] - t2[0] * c0[1]; o2[0] = t2[0] * c0[0] + t1[0] * c0[1]; o1[1] = t1[1] * c0[2] - t2[1] * c0[3]; o2[1] = t2[1] * c0[2] + t1[1] * c0[3];
                        o1[2] = t1[2] * c1[0] - t2[2] * c1[1]; o2[2] = t2[2] * c1[0] + t1[2] * c1[1]; o1[3] = t1[3] * c1[2] - t2[3] * c1[3]; o2[3] = t2[3] * c1[2] + t1[3] * c1[3];
                        t1 = o1; t2 = o2; }
                    u32x2 q1, q2; q1.x = cvt_pk_bf16(t1[0], t1[1]); q1.y = cvt_pk_bf16(t1[2], t1[3]); q2.x = cvt_pk_bf16(t2[0], t2[1]); q2.y = cvt_pk_bf16(t2[2], t2[3]);
                    *(u32x2*)hp = q1; *(u32x2*)(hp + 64) = q2; }
            }
        } else if (kind == K_FTSWAP) {
            bf16_t* FT = (bf16_t*)(ws + WS_FT);
#pragma unroll
            for (int ai = 0; ai < 2; ++ai)
#pragma unroll
                for (int m = 0; m < 4; ++m) {
                    const int j = rowt + ai * 128 + m * 16; const int cs = j >> 9, g = (j >> 7) & 3, mm = j & 127;
#pragma unroll
                    for (int bj = 0; bj < 2; ++bj) { const int t0 = u.pn * 256 + bj * 128 + cw; const int b = t0 >> 11, n = t0 & 2047;
                        *(u32x4*)(FT + ((size_t)((b * 4 + g) * 128 + mm)) * 4096 + cs * 2048 + n) = pack8(acc[ai][bj][m][0], acc[ai][bj][m][1]); }
                }
        } else if (kind == K_FOUR2) {
            bf16_t* YF = (bf16_t*)(ws + WS_YF);
            unsigned* flag = (unsigned*)(ws + WS_CNT) + (size_t)((u.pm * 16 + u.pn) * 4) * 64;
            const int lane = fq * 16 + fr, wid = wr * 4 + wc, role = u.q;
            if (role != 3) {
#pragma unroll
                for (int ai = 0; ai < 2; ++ai)
#pragma unroll
                    for (int m = 0; m < 4; ++m) { const int k = rowt + ai * 128 + m * 16;
#pragma unroll
                        for (int bj = 0; bj < 2; ++bj) { const int c = u.pn * 256 + bj * 128 + cw; const int b = c >> 9, cc = c & 511;
                            bf16_t* dstp = role == 0 ? YF + (size_t)(b * SEQ + k) * 1024 + 512 + cc : (role == 1 ? YF + (size_t)(b * SEQ + 1024 + k) * 1024 + 512 + cc : YF + (size_t)(b * SEQ + k) * 1024 + cc);
                            st16_wt(dstp, pack8(acc[ai][bj][m][0], acc[ai][bj][m][1])); } }
                asm volatile("s_waitcnt vmcnt(0)" ::: "memory");
                if (lane == 0) __hip_atomic_fetch_add(flag + 64 * role, 1u, __ATOMIC_RELAXED, __HIP_MEMORY_SCOPE_AGENT);
            } else {
                if (wid == 0) {
#pragma unroll
                    for (int f = 0; f < 3; ++f) { unsigned sp_ = 0; while ((unsigned)__builtin_amdgcn_readfirstlane(__hip_atomic_load(flag + 64 * f, __ATOMIC_RELAXED, __HIP_MEMORY_SCOPE_AGENT)) < 8u) { __builtin_amdgcn_s_sleep(2); if (++sp_ > (1u << 13)) break; } }
                    __builtin_amdgcn_fence(__ATOMIC_ACQUIRE, "agent"); asm volatile("s_waitcnt vmcnt(0)" ::: "memory"); }
                asm volatile("" ::: "memory"); __builtin_amdgcn_s_barrier(); asm volatile("" ::: "memory");
#pragma unroll
                for (int ai2 = 0; ai2 < 4; ++ai2) { const int ai = ai2 >> 1, mb = (ai2 & 1) * 2;
                    u32x4 t0[4][2], t1[4][2], t2[4][2];
#pragma unroll
                    for (int m = mb; m < mb + 2; ++m) { const int k = rowt + ai * 128 + m * 16;
#pragma unroll
                        for (int bj = 0; bj < 2; ++bj) { const int c = u.pn * 256 + bj * 128 + cw; const int b = c >> 9, cc = c & 511;
                            t0[m][bj] = __builtin_nontemporal_load((const u32x4*)(YF + (size_t)(b * SEQ + k) * 1024 + 512 + cc));
                            t1[m][bj] = __builtin_nontemporal_load((const u32x4*)(YF + (size_t)(b * SEQ + 1024 + k) * 1024 + 512 + cc));
                            t2[m][bj] = __builtin_nontemporal_load((const u32x4*)(YF + (size_t)(b * SEQ + k) * 1024 + cc)); } }
#pragma unroll
                    for (int m = mb; m < mb + 2; ++m) { const int k = rowt + ai * 128 + m * 16;
#pragma unroll
                        for (int bj = 0; bj < 2; ++bj) { const int c = u.pn * 256 + bj * 128 + cw; const int b = c >> 9, cc = c & 511;
                            f32x4 a0, a1, b0, b1, s0, s1; unpack8(t0[m][bj], a0, a1); unpack8(t1[m][bj], b0, b1); unpack8(t2[m][bj], s0, s1);
                            const f32x4 c0 = a0 + b0, c1 = a1 + b1; s0 = s0 + acc[ai][bj][m][0]; s1 = s1 + acc[ai][bj][m][1];
                            *(u32x4*)(YF + (size_t)(b * SEQ + k) * 1024 + cc) = pack8(c0 + s0, c1 + s1);
                            if (k != 0) *(u32x4*)(YF + (size_t)(b * SEQ + SEQ - k) * 1024 + cc) = pack8(c0 - s0, c1 - s1); } }
                }
            }
        } else {
            bf16_t* GA = (bf16_t*)(ws + WS_GA); const bf16_t* GF = (const bf16_t*)(ws + WS_GF);
#pragma unroll
            for (int ai = 0; ai < 2; ++ai) {
                u32x4 ra[4][2], rf[4][2];
#pragma unroll
                for (int m = 0; m < 4; ++m) { const size_t off = (size_t)(rowt + ai * 128 + m * 16) * DM + u.pn * 256 + cw;
#pragma unroll
                    for (int bj = 0; bj < 2; ++bj) { if (kind == K_BRA) { rf[m][bj] = *(const u32x4*)(GF + off + bj * 128); ra[m][bj] = __builtin_nontemporal_load((const u32x4*)(GA + off + bj * 128)); } else { rf[m][bj] = __builtin_nontemporal_load((const u32x4*)(GF + off + bj * 128)); ra[m][bj] = rf[m][bj]; } } }
#pragma unroll
                for (int m = 0; m < 4; ++m) { const size_t off = (size_t)(rowt + ai * 128 + m * 16) * DM + u.pn * 256 + cw;
#pragma unroll
                    for (int bj = 0; bj < 2; ++bj) { f32x4 g0, g1; unpack8(rf[m][bj], g0, g1);
                        if (kind == K_BRA) { f32x4 a0, a1; unpack8(ra[m][bj], a0, a1);
#pragma unroll
                            for (int e = 0; e < 4; ++e) { acc[ai][bj][m][0][e] *= a0[e] * __builtin_amdgcn_rcpf(g0[e]); acc[ai][bj][m][1][e] *= a1[e] * __builtin_amdgcn_rcpf(g1[e]); } }
                        else *(u32x4*)(GA + off + bj * 128) = pack8(g0 * acc[ai][bj][m][0], g1 * acc[ai][bj][m][1]); } }
            }
        }
    }
};

template <bool ALIGN_EPI, bool SP2, bool PERM = true>
__device__ __forceinline__ void gemm_phase(LAS unsigned char* lds, const Sched& S, const Epi& E, const int tid) {
    const int wid = __builtin_amdgcn_readfirstlane(tid >> 6), lane = tid & 63, wr = wid >> 2, wc = wid & 3, fr = lane & 15, fq = lane >> 4;
    const int K = S.K;
    unsigned voffA[2], voffB[2];
#pragma unroll
    for (int i = 0; i < 2; ++i) { int R, C; stage_rc(tid * 16 + i * 8192, R, C); const int Rb = PERM ? ((R & ~31) + perm32(R & 31)) : R;
        voffA[i] = (unsigned)(R * K + C) * 2u; voffB[i] = (unsigned)(Rb * K + C) * 2u; }
    const size_t kstep = (size_t)(BK * 2);
    const size_t hstep = (size_t)HALF * K * 2;
    const unsigned ldsw = (unsigned)wid * 1024u;
    const int aoff = lds_byte(wr * 64 + fr, fq * 8), boff = lds_byte(wc * 32 + fr, fq * 8);
#define PG8_SA(b, h) (((b) * 2 + (h)) * HTB)
#define PG8_SB(b, h) ((4 + (b) * 2 + (h)) * HTB)
#define PG8_STAGE(bufoff, gbase, voff) do { _Pragma("unroll") for (int _i = 0; _i < 2; ++_i) \
        __builtin_amdgcn_global_load_lds((const unsigned*)((const char*)(gbase) + (voff)[_i]), (LAS unsigned*)(lds + (bufoff) + ldsw + _i * 8192), 16, 0, 0); } while (0)
#define PG8_LDA(dst, b, h) do { _Pragma("unroll") for (int m = 0; m < 4; ++m) _Pragma("unroll") for (int k = 0; k < 2; ++k) dst[m][k] = *(const LAS bf16x8*)(lds + PG8_SA(b, h) + aoff + m * 2048 + k * 1024); } while (0)
#define PG8_LDB(dst, b, h) do { _Pragma("unroll") for (int n = 0; n < 2; ++n) _Pragma("unroll") for (int k = 0; k < 2; ++k) dst[n][k] = *(const LAS bf16x8*)(lds + PG8_SB(b, h) + boff + n * 2048 + k * 1024); } while (0)
#define PG8_MMA(ai, bj, At, Bt) do { __builtin_amdgcn_s_setprio(1); _Pragma("unroll") for (int m = 0; m < 4; ++m) _Pragma("unroll") for (int n = 0; n < 2; ++n) _Pragma("unroll") for (int k = 0; k < 2; ++k) \
        acc[ai][bj][m][n] = __builtin_amdgcn_mfma_f32_16x16x32_bf16(Bt[n][k], At[m][k], acc[ai][bj][m][n], 0, 0, 0); __builtin_amdgcn_s_setprio(0); } while (0)
#define PG8_WAIT_V(n) asm volatile("s_waitcnt vmcnt(" #n ")" ::: "memory")
#define PG8_WAIT_L(n) asm volatile("s_waitcnt lgkmcnt(" #n ")" ::: "memory")
#define PG8_BAR __builtin_amdgcn_s_barrier()
#define PG8_SCHED __builtin_amdgcn_sched_barrier(0)
    Unit cur, nxt; int ui = 0;
    if (!S.next(0, cur)) return;
    f32x4 acc[2][2][4][2];
#pragma unroll
    for (int a = 0; a < 2; ++a)
#pragma unroll
        for (int b = 0; b < 2; ++b)
#pragma unroll
            for (int m = 0; m < 4; ++m)
#pragma unroll
                for (int n = 0; n < 2; ++n) acc[a][b][m][n] = (f32x4){0.f, 0.f, 0.f, 0.f};
    bf16x8 At[4][2], B0[2][2], B1[2][2];
    const char* cA = S.aptr(cur); const char* cB = S.bptr(cur);
    if constexpr (SP2) {
        PG8_STAGE(PG8_SB(0, 0), cB, voffB); PG8_STAGE(PG8_SB(0, 1), cB + hstep, voffB); PG8_STAGE(PG8_SA(0, 0), cA, voffA); PG8_STAGE(PG8_SA(0, 1), cA + hstep, voffA);
        if (wr == 1) PG8_BAR;
        PG8_WAIT_V(2); PG8_BAR;
        PG8_STAGE(PG8_SB(1, 0), cB + kstep, voffB); PG8_STAGE(PG8_SA(1, 0), cA + kstep, voffA); PG8_STAGE(PG8_SB(1, 1), cB + hstep + kstep, voffB);
        PG8_WAIT_V(6); PG8_BAR;
    } else {
        PG8_STAGE(PG8_SB(0, 0), cB, voffB); PG8_STAGE(PG8_SA(0, 0), cA, voffA); PG8_STAGE(PG8_SB(0, 1), cB + hstep, voffB); PG8_STAGE(PG8_SA(0, 1), cA + hstep, voffA);
        if (wr == 1) PG8_BAR;
        PG8_WAIT_V(4); PG8_BAR;
        PG8_STAGE(PG8_SB(1, 0), cB + kstep, voffB); PG8_STAGE(PG8_SA(1, 0), cA + kstep, voffA); PG8_STAGE(PG8_SB(1, 1), cB + hstep + kstep, voffB);
        PG8_WAIT_V(6); PG8_BAR;
    }
    for (;;) {
        const bool has_next = S.next(ui + 1, nxt); const int nt = S.ktiles(cur);
        const char* nA = has_next ? S.aptr(nxt) : cA; const char* nB = has_next ? S.bptr(nxt) : cB;
        for (int t = 0; t < nt; t += 2) {
            const bool last = (t == nt - 2);
            const char* a1 = cA + (size_t)(t + 1) * kstep;
            const char* a2 = last ? nA : cA + (size_t)(t + 2) * kstep; const char* b2 = last ? nB : cB + (size_t)(t + 2) * kstep;
            const char* a3 = a2 + kstep; const char* b3 = b2 + kstep;
            if constexpr (SP2) {
            PG8_LDB(B0, 0, 0); PG8_LDB(B1, 0, 1); PG8_SCHED; PG8_LDA(At, 0, 0); PG8_STAGE(PG8_SA(1, 1), a1 + hstep, voffA);
            PG8_WAIT_V(8); PG8_WAIT_L(0); PG8_BAR; PG8_MMA(0, 0, At, B0); PG8_MMA(0, 1, At, B1); PG8_BAR; PG8_SCHED;
            PG8_LDA(At, 0, 1); PG8_STAGE(PG8_SB(0, 0), b2, voffB); PG8_STAGE(PG8_SB(0, 1), b2 + hstep, voffB); PG8_STAGE(PG8_SA(0, 0), a2, voffA);
            PG8_WAIT_V(8); PG8_WAIT_L(0); PG8_BAR; PG8_MMA(1, 0, At, B0); PG8_MMA(1, 1, At, B1); PG8_BAR; PG8_SCHED;
            PG8_LDB(B0, 1, 0); PG8_LDB(B1, 1, 1); PG8_SCHED; PG8_LDA(At, 1, 0); PG8_STAGE(PG8_SA(0, 1), a2 + hstep, voffA);
            PG8_WAIT_V(8); PG8_WAIT_L(0); PG8_BAR; PG8_MMA(0, 0, At, B0); PG8_MMA(0, 1, At, B1); PG8_BAR; PG8_SCHED;
            PG8_LDA(At, 1, 1); PG8_STAGE(PG8_SB(1, 0), b3, voffB); PG8_STAGE(PG8_SB(1, 1), b3 + hstep, voffB); PG8_STAGE(PG8_SA(1, 0), a3, voffA);
            PG8_WAIT_V(8); PG8_WAIT_L(0); PG8_BAR; PG8_MMA(1, 0, At, B0); PG8_MMA(1, 1, At, B1); PG8_BAR; PG8_SCHED;
            } else {
            PG8_LDB(B0, 0, 0); PG8_SCHED; PG8_LDA(At, 0, 0); PG8_STAGE(PG8_SA(1, 1), a1 + hstep, voffA);
            PG8_WAIT_L(8); PG8_BAR; PG8_WAIT_L(0); PG8_MMA(0, 0, At, B0); PG8_BAR; PG8_SCHED;
            PG8_LDB(B1, 0, 1); PG8_STAGE(PG8_SB(0, 0), b2, voffB);
            PG8_BAR; PG8_WAIT_L(0); PG8_MMA(0, 1, At, B1); PG8_BAR;
            PG8_LDA(At, 0, 1); PG8_STAGE(PG8_SA(0, 0), a2, voffA);
            PG8_BAR; PG8_WAIT_L(0); PG8_MMA(1, 0, At, B0); PG8_BAR; PG8_SCHED;
            PG8_STAGE(PG8_SB(0, 1), b2 + hstep, voffB);
            PG8_WAIT_V(6); PG8_BAR; PG8_MMA(1, 1, At, B1); PG8_BAR;
            PG8_LDB(B0, 1, 0); PG8_SCHED; PG8_LDA(At, 1, 0); PG8_STAGE(PG8_SA(0, 1), a2 + hstep, voffA);
            PG8_WAIT_L(8); PG8_BAR; PG8_WAIT_L(0); PG8_MMA(0, 0, At, B0); PG8_BAR; PG8_SCHED;
            PG8_LDB(B1, 1, 1); PG8_STAGE(PG8_SB(1, 0), b3, voffB);
            PG8_BAR; PG8_WAIT_L(0); PG8_MMA(0, 1, At, B1); PG8_BAR;
            PG8_LDA(At, 1, 1); PG8_STAGE(PG8_SA(1, 0), a3, voffA);
            PG8_BAR; PG8_WAIT_L(0); PG8_MMA(1, 0, At, B0); PG8_BAR; PG8_SCHED;
            PG8_STAGE(PG8_SB(1, 1), b3 + hstep, voffB);
            PG8_WAIT_V(6); PG8_BAR; PG8_MMA(1, 1, At, B1); PG8_BAR;
            }
        }
        if constexpr (ALIGN_EPI) { if (wr == 0) PG8_BAR; }
        E.template run<PERM>(acc, cur, S.kind(cur), wr, wc, fr, fq);
        if (!has_next) break;
        if (S.kind(cur) != K_BRA) {
#pragma unroll
        for (int a = 0; a < 2; ++a)
#pragma unroll
            for (int b = 0; b < 2; ++b)
#pragma unroll
                for (int m = 0; m < 4; ++m)
#pragma unroll
                    for (int n = 0; n < 2; ++n) acc[a][b][m][n] = (f32x4){0.f, 0.f, 0.f, 0.f};
        }
        cur = nxt; cA = nA; cB = nB; ++ui;
        if constexpr (ALIGN_EPI) { if (wr == 1) PG8_BAR; }
    }
    PG8_WAIT_V(0);
    if constexpr (!ALIGN_EPI) { if (wr == 0) PG8_BAR; }
    PG8_BAR;
#undef PG8_SA
#undef PG8_SB
#undef PG8_STAGE
#undef PG8_LDA
#undef PG8_LDB
#undef PG8_MMA
#undef PG8_WAIT_V
#undef PG8_WAIT_L
#undef PG8_BAR
#undef PG8_SCHED
}
}

namespace att {
using bf16 = __hip_bfloat16;
constexpr int D = 128, NW = 8, QBLK = 32, KVBLK = 64;
constexpr float SCALE = 0.088388347648318440f;
constexpr float THR = 8.f;
constexpr int LDQ = DM, LDK = 256, LDO = DM;
constexpr size_t SHM_V = KVBLK * D * 2, SHM_K = KVBLK * D * 2, SHM_ATTN = 2 * SHM_V + 2 * SHM_K + NW * 64 * 4;
#define KSWZ(row, colB) ((row) * 256 + ((colB) ^ (((row) & 7) << 4)))
#define SBAR() __builtin_amdgcn_sched_barrier(0)
__device__ __forceinline__ int crow(int r, int hi) { return (r & 3) + 8 * (r >> 2) + 4 * hi; }
__device__ __forceinline__ unsigned cvtpk(float lo, float hi) { unsigned r; asm volatile("v_cvt_pk_bf16_f32 %0, %1, %2" : "=v"(r) : "v"(lo), "v"(hi)); return r; }
__device__ __forceinline__ void partialSM(f32x16& p0, f32x16& p1, float& m_reg, float& mn, float& alpha) {
  constexpr float C = SCALE * 1.4426950408889634f;
  float pmax = p0[0];
  _Pragma("unroll") for (int r = 1; r < 16; ++r) pmax = fmaxf(pmax, p0[r]);
  _Pragma("unroll") for (int r = 0; r < 16; ++r) pmax = fmaxf(pmax, p1[r]);
  { auto rr = __builtin_amdgcn_permlane32_swap(__float_as_uint(pmax), __float_as_uint(pmax), false, false);
    pmax = fmaxf(__uint_as_float(rr[0]), __uint_as_float(rr[1])); }
  if (__builtin_expect(__all(pmax - m_reg <= THR / SCALE), 1)) { mn = m_reg; alpha = 1.f; }
  else { mn = fmaxf(m_reg, pmax); alpha = __builtin_amdgcn_exp2f((m_reg - mn) * C); m_reg = mn; }
  float mnC = -mn * C;
  _Pragma("unroll") for (int r = 0; r < 16; ++r) p0[r] = fmaf(p0[r], C, mnC);
  _Pragma("unroll") for (int r = 0; r < 16; ++r) p1[r] = fmaf(p1[r], C, mnC);
  _Pragma("unroll") for (int r = 0; r < 16; ++r) p0[r] = __builtin_amdgcn_exp2f(p0[r]);
}
__device__ __forceinline__ void finishSM(f32x16& p0, f32x16& p1, float alpha, float& l_reg, bf16x8& pa0, bf16x8& pa1, bf16x8& pa2, bf16x8& pa3) {
  _Pragma("unroll") for (int r = 0; r < 16; ++r) p1[r] = __builtin_amdgcn_exp2f(p1[r]);
  float ps = 0;
  _Pragma("unroll") for (int r = 0; r < 16; ++r) ps += p0[r];
  _Pragma("unroll") for (int r = 0; r < 16; ++r) ps += p1[r];
  { auto rr = __builtin_amdgcn_permlane32_swap(__float_as_uint(ps), __float_as_uint(ps), false, false);
    ps = __uint_as_float(rr[0]) + __uint_as_float(rr[1]); }
  l_reg = l_reg * alpha + ps;
#define PK4(P, BASE, OUT) do { unsigned a0 = cvtpk(P[BASE + 0], P[BASE + 1]), a1 = cvtpk(P[BASE + 2], P[BASE + 3]);   \
    unsigned b0 = cvtpk(P[BASE + 4], P[BASE + 5]), b1 = cvtpk(P[BASE + 6], P[BASE + 7]);                              \
    auto r0 = __builtin_amdgcn_permlane32_swap(a0, b0, false, false); auto r1 = __builtin_amdgcn_permlane32_swap(a1, b1, false, false); \
    u32x4 w = {r0[0], r1[0], r0[1], r1[1]}; OUT = *reinterpret_cast<bf16x8*>(&w); } while (0)
  PK4(p0, 0, pa0); PK4(p0, 8, pa1); PK4(p1, 0, pa2); PK4(p1, 8, pa3);
#undef PK4
}
__device__ __forceinline__ void qkt(f32x16& p0, f32x16& p1, const bf16* Ks, const bf16x8* qr, int r32, int hi) {
  p0 = f32x16{}; p1 = f32x16{};
  _Pragma("unroll") for (int d0 = 0; d0 < 8; ++d0) { int cb = (d0 * 16 + hi * 8) * 2;
    bf16x8 b0 = *reinterpret_cast<const bf16x8*>((const char*)Ks + KSWZ(r32, cb));
    bf16x8 b1 = *reinterpret_cast<const bf16x8*>((const char*)Ks + KSWZ(32 + r32, cb));
    p0 = __builtin_amdgcn_mfma_f32_32x32x16_bf16(b0, qr[d0], p0, 0, 0, 0);
    p1 = __builtin_amdgcn_mfma_f32_32x32x16_bf16(b1, qr[d0], p1, 0, 0, 0); }
}
__device__ __forceinline__ int v_st(int k, int c) { const int kk = (k & ~0xC) | ((k & 4) << 1) | ((k & 8) >> 1); return ((kk >> 3) * 4 + (c >> 5)) * 512 + ((kk & 7) * 32 + (c & 31)) * 2; }
__device__ __forceinline__ int v_rd_base(int lane) { return ((lane & 3) << 3) | (((lane >> 2) & 3) << 6) | (((lane >> 4) & 1) << 5) | (((lane >> 5) & 1) << 8); }
constexpr int v_rd_off(int d0, int ks, int half) { return d0 * 512 + ks * 4096 + half * 2048; }
template <int OFF> __device__ __forceinline__ s16x4 tr_read(int vb) {
  s16x4 r; asm volatile("ds_read_b64_tr_b16 %0, %1 offset:%2" : "=&v"(r) : "v"(vb), "i"(OFF) : "memory"); return r;
}
template <int D0> __device__ __forceinline__ void pv_one(f32x16& od, int vb, bf16x8 pa0, bf16x8 pa1, bf16x8 pa2, bf16x8 pa3) {
  const s16x4 l0 = tr_read<v_rd_off(D0, 0, 0)>(vb), h0 = tr_read<v_rd_off(D0, 0, 1)>(vb), l1 = tr_read<v_rd_off(D0, 1, 0)>(vb), h1 = tr_read<v_rd_off(D0, 1, 1)>(vb);
  const s16x4 l2 = tr_read<v_rd_off(D0, 2, 0)>(vb), h2 = tr_read<v_rd_off(D0, 2, 1)>(vb), l3 = tr_read<v_rd_off(D0, 3, 0)>(vb), h3 = tr_read<v_rd_off(D0, 3, 1)>(vb);
  asm volatile("s_waitcnt lgkmcnt(0)" ::: "memory"); SBAR();
#define PK(L, H) (bf16x8){L[0], L[1], L[2], L[3], H[0], H[1], H[2], H[3]}
  od = __builtin_amdgcn_mfma_f32_32x32x16_bf16(pa0, PK(l0, h0), od, 0, 0, 0);
  od = __builtin_amdgcn_mfma_f32_32x32x16_bf16(pa1, PK(l1, h1), od, 0, 0, 0);
  od = __builtin_amdgcn_mfma_f32_32x32x16_bf16(pa2, PK(l2, h2), od, 0, 0, 0);
  od = __builtin_amdgcn_mfma_f32_32x32x16_bf16(pa3, PK(l3, h3), od, 0, 0, 0);
#undef PK
}
__device__ __forceinline__ void pv_d0(f32x16* o, int vb, bf16x8 pa0, bf16x8 pa1, bf16x8 pa2, bf16x8 pa3) {
  pv_one<0>(o[0], vb, pa0, pa1, pa2, pa3); pv_one<1>(o[1], vb, pa0, pa1, pa2, pa3); pv_one<2>(o[2], vb, pa0, pa1, pa2, pa3); pv_one<3>(o[3], vb, pa0, pa1, pa2, pa3);
}
__device__ __forceinline__ void attn_unit(const bf16* Qb, const bf16* __restrict__ Kh, const bf16* __restrict__ Vh, bf16* Ob, int seq, char* lds, const int tid,
                                          const float* __restrict__ qg, const float* __restrict__ ropetab, int n0) {
  const int wid = __builtin_amdgcn_readfirstlane(tid >> 6), lane = tid & 63, r32 = lane & 31, hi = lane >> 5;
  bf16* V_lds = (bf16*)lds; bf16* K_lds = (bf16*)(lds + 2 * SHM_V);
  float* ws = (float*)(lds + 2 * SHM_V + 2 * SHM_K) + wid * 64; float* li_l = ws; float* al_l = ws + 32;
  bf16x8 qr[8];
  const bf16* Qw = Qb + (long)(wid * QBLK + r32) * LDQ + hi * 8;
#pragma unroll
  for (int d0 = 0; d0 < 8; ++d0) qr[d0] = *reinterpret_cast<const bf16x8*>(Qw + d0 * 16);
#ifndef NO_QFIX
  {
    float qf[8][8]; float ss = 0.f;
#pragma unroll
    for (int d0 = 0; d0 < 8; ++d0)
#pragma unroll
      for (int e = 0; e < 8; ++e) { const float v = __uint_as_float(((unsigned)(unsigned short)qr[d0][e]) << 16); qf[d0][e] = v; ss += v * v; }
    { auto rr = __builtin_amdgcn_permlane32_swap(__float_as_uint(ss), __float_as_uint(ss), false, false); ss = __uint_as_float(rr[0]) + __uint_as_float(rr[1]); }
    const float rstd = 1.0f / sqrtf(ss * (1.0f / 128.0f) + EPS);
    const int n = n0 + wid * QBLK + r32;
#pragma unroll
    for (int d0 = 0; d0 < 8; ++d0) { const f32x4 g0 = *(const f32x4*)(qg + d0 * 16 + hi * 8), g1 = *(const f32x4*)(qg + d0 * 16 + hi * 8 + 4);
#pragma unroll
      for (int e = 0; e < 4; ++e) { qf[d0][e] *= rstd * g0[e]; qf[d0][4 + e] *= rstd * g1[e]; } }
#pragma unroll
    for (int d0 = 0; d0 < 4; ++d0) { const int pos = d0 < 2 ? (n >> 6) : (n & 63); const float* rp = ropetab + 2 * (pos * 32 + (d0 & 1) * 16 + hi * 8);
#pragma unroll
      for (int e = 0; e < 8; e += 2) { const f32x4 cs = *(const f32x4*)(rp + 2 * e);
        { const float t1 = qf[d0][e], t2 = qf[d0 + 4][e]; qf[d0][e] = t1 * cs[0] - t2 * cs[1]; qf[d0 + 4][e] = t2 * cs[0] + t1 * cs[1]; }
        { const float t1 = qf[d0][e + 1], t2 = qf[d0 + 4][e + 1]; qf[d0][e + 1] = t1 * cs[2] - t2 * cs[3]; qf[d0 + 4][e + 1] = t2 * cs[2] + t1 * cs[3]; } } }
#pragma unroll
    for (int d0 = 0; d0 < 8; ++d0) { u32x4 w = {cvtpk(qf[d0][0], qf[d0][1]), cvtpk(qf[d0][2], qf[d0][3]), cvtpk(qf[d0][4], qf[d0][5]), cvtpk(qf[d0][6], qf[d0][7])}; qr[d0] = *reinterpret_cast<bf16x8*>(&w); }
  }
#endif
  float m_reg = -1e30f, l_reg = 0; f32x16 o[4] = {};
  const int sr = tid >> 4, sc = (tid & 15) * 8, vst0 = v_st(sr, sc), vst1 = v_st(32 + sr, sc);
  const int vb0 = (int)(uintptr_t)V_lds + v_rd_base(lane);
  bf16x8 sr_0vs0, sr_0vs1, sr_0ks0, sr_0ks1, sr_1vs0, sr_1vs1, sr_1ks0, sr_1ks1;
#define LD8(p) (*reinterpret_cast<const bf16x8*>(p))
#define SLOAD(i, k0) do { sr_##i##vs0 = LD8(&Vh[(long)((k0) + sr) * LDK + sc]); sr_##i##vs1 = LD8(&Vh[(long)((k0) + 32 + sr) * LDK + sc]); \
    sr_##i##ks0 = LD8(&Kh[(long)((k0) + sr) * LDK + sc]); sr_##i##ks1 = LD8(&Kh[(long)((k0) + 32 + sr) * LDK + sc]); } while (0)
#define SWRITE(b, i) do { *(bf16x8*)((char*)V_lds + (b) * SHM_V + vst0) = sr_##i##vs0;          \
    *(bf16x8*)((char*)V_lds + (b) * SHM_V + vst1) = sr_##i##vs1; int kc = sc * 2;               \
    *(bf16x8*)((char*)K_lds + (b) * SHM_K + KSWZ(sr, kc)) = sr_##i##ks0;                       \
    *(bf16x8*)((char*)K_lds + (b) * SHM_K + KSWZ(32 + sr, kc)) = sr_##i##ks1; } while (0)
#define SWAIT() asm volatile("s_waitcnt vmcnt(4)" ::: "memory")
#define RESC(a) do { if (__any((a) < 1.f)) { if (hi == 0) al_l[r32] = (a); asm volatile("s_waitcnt lgkmcnt(0)" ::: "memory"); \
    _Pragma("unroll") for (int d = 0; d < 4; ++d) _Pragma("unroll") for (int r = 0; r < 16; ++r) o[d][r] *= al_l[crow(r, hi)]; } } while (0)
  f32x16 pA0, pA1, pB0, pB1; float mnA, mnB, alA, alB; bf16x8 pa0, pa1, pa2, pa3; const int NT = seq / KVBLK;
  SLOAD(0, 0); asm volatile("s_waitcnt vmcnt(0)" ::: "memory"); SWRITE(0, 0); __syncthreads();
  qkt(pA0, pA1, K_lds, qr, r32, hi); partialSM(pA0, pA1, m_reg, mnA, alA);
  SLOAD(1, KVBLK); if (2 < NT) SLOAD(0, 2 * KVBLK);
  SWAIT(); SWRITE(1, 1); __syncthreads();
  for (int j = 1; j + 1 < NT; j += 2) {
    SBAR(); qkt(pB0, pB1, (bf16*)((char*)K_lds + SHM_K), qr, r32, hi);
    finishSM(pA0, pA1, alA, l_reg, pa0, pa1, pa2, pa3); SBAR();
    SLOAD(1, (j + 2) * KVBLK); SBAR();
    pv_d0(o, vb0, pa0, pa1, pa2, pa3); partialSM(pB0, pB1, m_reg, mnB, alB);
    __syncthreads(); SWAIT(); SWRITE(0, 0);
    RESC(alB); __syncthreads();
    SBAR(); qkt(pA0, pA1, K_lds, qr, r32, hi);
    finishSM(pB0, pB1, alB, l_reg, pa0, pa1, pa2, pa3); SBAR();
    if (j + 3 < NT) SLOAD(0, (j + 3) * KVBLK); SBAR();
    pv_d0(o, vb0 + (int)SHM_V, pa0, pa1, pa2, pa3); partialSM(pA0, pA1, m_reg, mnA, alA);
    __syncthreads(); SWAIT(); SWRITE(1, 1);
    RESC(alA); __syncthreads();
  }
  SBAR(); qkt(pB0, pB1, (bf16*)((char*)K_lds + SHM_K), qr, r32, hi);
  finishSM(pA0, pA1, alA, l_reg, pa0, pa1, pa2, pa3); SBAR();
  pv_d0(o, vb0, pa0, pa1, pa2, pa3); partialSM(pB0, pB1, m_reg, mnB, alB);
  __syncthreads(); RESC(alB);
  finishSM(pB0, pB1, alB, l_reg, pa0, pa1, pa2, pa3); SBAR();
  pv_d0(o, vb0 + (int)SHM_V, pa0, pa1, pa2, pa3);
  if (hi == 0) li_l[r32] = l_reg; asm volatile("s_waitcnt lgkmcnt(0)" ::: "memory");
  float rli[16];
#pragma unroll
  for (int r = 0; r < 16; ++r) rli[r] = __builtin_amdgcn_rcpf(li_l[crow(r, hi)]);
  int l2 = __builtin_amdgcn_mbcnt_hi(~0u, __builtin_amdgcn_mbcnt_lo(~0u, 0u)); asm volatile("" : "+v"(l2));
  const int r32b = l2 & 31, hib = l2 >> 5;
  bf16* Ow = Ob + (long)(wid * QBLK) * LDO;
#pragma unroll
  for (int r = 0; r < 16; ++r) { int orow = crow(r, hib);
    _Pragma("unroll") for (int d0 = 0; d0 < 4; ++d0) Ow[(long)orow * LDO + d0 * 32 + r32b] = __float2bfloat16(o[d0][r] * rli[r]); }
  __syncthreads();
#undef LD8
#undef SLOAD
#undef SWRITE
#undef SWAIT
#undef RESC
}
#undef SBAR
}

#define XB_TMO      128
#define XB_XCNT(j)  (256  + 64 * (j))
#define XB_XSUB(j)  (1280 + 64 * (j))
#define XB_XGEN(j)  (2304 + 64 * (j))
#define XB_TOP      3328
#define XB_TOPGEN   3392
#define XCD_BAR_WORDS 3456
#define XB_SPIN_CAP (1u << 18)
__device__ __forceinline__ unsigned xb_ld(unsigned* p)              { return __hip_atomic_load(p, __ATOMIC_RELAXED, __HIP_MEMORY_SCOPE_AGENT); }
__device__ __forceinline__ unsigned xb_add(unsigned* p, unsigned v) { return __hip_atomic_fetch_add(p, v, __ATOMIC_RELAXED, __HIP_MEMORY_SCOPE_AGENT); }
__device__ __forceinline__ unsigned xb_xcc_id() { return (unsigned)__builtin_amdgcn_s_getreg((3 << 11) | 20) & 0xFu; }
#define XB_SPIN(cond, bar) do { unsigned _sp = 0; while (cond) { __builtin_amdgcn_s_sleep(1); \
    if ((++_sp & 255u) == 0u) { if (xb_ld(&(bar)[XB_TMO])) break; if (_sp > XB_SPIN_CAP) { atomicAdd(&(bar)[XB_TMO], 1u); break; } } } } while (0)
struct XcdBarrier { unsigned* bar; unsigned x; volatile LAS unsigned* st; };
__device__ __forceinline__ XcdBarrier xcd_barrier_post(unsigned* bar, volatile LAS unsigned* st) {
    XcdBarrier b; b.bar = bar; b.x = xb_xcc_id(); b.st = st;
    if (threadIdx.x == 0) (void)xb_add(&bar[XB_XCNT(b.x)], 1u);
    return b;
}
__device__ __forceinline__ void xcd_barrier_complete(unsigned* bar, unsigned x, unsigned& nloc, unsigned& nx) {
    const unsigned G = gridDim.x * gridDim.y * gridDim.z;
    unsigned sum, cnt, mine, sp = 0u;
    for (;;) {
        sum = 0u; cnt = 0u; mine = 0u;
#pragma unroll
        for (unsigned j = 0; j < 16; ++j) { const unsigned c = xb_ld(&bar[XB_XCNT(j)]); sum += c; cnt += (c > 0u) ? 1u : 0u; mine = (j == x) ? c : mine; }
        if (sum == G) break;
        __builtin_amdgcn_s_sleep(1);
        if ((++sp & 255u) == 0u) { if (xb_ld(&bar[XB_TMO])) break; if (sp > XB_SPIN_CAP) { atomicAdd(&bar[XB_TMO], 1u); break; } }
    }
    nloc = mine > 0u ? mine : 1u; nx = cnt > 0u ? cnt : 1u;
}
__device__ __forceinline__ void xcd_barrier(const XcdBarrier& b) {
    asm volatile("s_waitcnt vmcnt(0)" ::: "memory");
    __syncthreads();
    if (threadIdx.x == 0) {
        unsigned* bar = b.bar;
        __builtin_amdgcn_s_waitcnt(0);
        unsigned nloc = b.st[0], nx = b.st[1];
        if (nloc == 0u) { xcd_barrier_complete(bar, b.x, nloc, nx); b.st[0] = nloc; b.st[1] = nx; }
        const unsigned old = xb_add(&bar[XB_XSUB(b.x)], 1u);
        const unsigned gen = old / nloc;
        if (old + 1u == (gen + 1u) * nloc) {
            __builtin_amdgcn_fence(__ATOMIC_RELEASE, "agent");
            asm volatile("s_waitcnt vmcnt(0)" ::: "memory");
            const unsigned og = xb_add(&bar[XB_TOP], 1u);
            const unsigned tg = og / nx;
            if (og + 1u == (tg + 1u) * nx) xb_add(&bar[XB_TOPGEN], 1u);
            else XB_SPIN(xb_ld(&bar[XB_TOPGEN]) == tg, bar);
            __builtin_amdgcn_fence(__ATOMIC_ACQUIRE, "agent");
            xb_add(&bar[XB_XGEN(b.x)], 1u);
            asm volatile("s_waitcnt vmcnt(0)" ::: "memory");
        } else {
            XB_SPIN(xb_ld(&bar[XB_XGEN(b.x)]) == gen, bar);
            __builtin_amdgcn_fence(__ATOMIC_ACQUIRE, "agent");
            asm volatile("s_waitcnt vmcnt(0)" ::: "memory");
        }
    }
    __syncthreads();
}

struct Params {
    const float *x, *c, *ctx, *c_ctx, *w_ada, *b_ada, *norm_ffn1, *w_ffn1_in, *w_ffn1_out, *norm_mix, *w_in, *q_norm, *k_norm, *w_ab, *w_fb, *w_out, *norm_ffn2, *w_ffn2_in, *w_ffn2_out;
    float* out; unsigned char* ws; int st_lo, st_hi;
};

__device__ __forceinline__ void transpose_item(const float* __restrict__ W, int K, int N, bf16_t* __restrict__ WT, int kb, int n0, int drow0, int lane, int ldd = 0) {
    if (ldd == 0) ldd = K;
    const int ng = lane & 15, kq = lane >> 4, k0 = 32 * kb + 8 * kq;
    const float* src = W + (size_t)k0 * N + n0 + 4 * ng;
    f32x4 v[8];
#pragma unroll
    for (int i = 0; i < 8; ++i) v[i] = __builtin_nontemporal_load((const f32x4*)(src + (size_t)i * N));
    bf16_t* dst = WT + (size_t)(drow0 + 4 * ng) * ldd + k0;
#pragma unroll
    for (int j = 0; j < 4; ++j) { u32x4 o; o.x = cvt_pk_bf16(v[0][j], v[1][j]); o.y = cvt_pk_bf16(v[2][j], v[3][j]); o.z = cvt_pk_bf16(v[4][j], v[5][j]); o.w = cvt_pk_bf16(v[6][j], v[7][j]);
        *(u32x4*)(dst + (size_t)j * ldd) = o; }
}

__device__ __forceinline__ void prep_phase(const Params& kp_, LAS unsigned char* lds, int tid, int lane, int wave, int G) {
    const Params* kp = &kp_; unsigned char* ws = kp->ws;
    LAS float* tab2048 = (LAS float*)(lds + LDS_MISC);
    LAS float* tab128 = (LAS float*)(lds + LDS_MISC + 8192);
    if (blockIdx.x < 144) {
        LAS float* s_l = (LAS float*)lds;
        LAS float* red = (LAS float*)(lds + 36864);
        for (int i = tid; i < 9216; i += 512) { const int r = i >> 10, k = i & 1023; const float v = (r < 8) ? kp->c[r * 1024 + k] : kp->c_ctx[k]; s_l[i] = v / (1.f + expf(-v)); }
        __syncthreads();
        const int c0 = blockIdx.x * 64, kr = lane >> 4, cgp = lane & 15;
        f32x4 a0 = {}, a1 = {}, a2 = {}, a3 = {}, a4 = {}, a5 = {}, a6 = {}, a7 = {}, a8 = {};
        const float* wp = kp->w_ada + (size_t)(wave * 128 + kr) * NMOD + c0 + 4 * cgp;
#pragma unroll 8
        for (int i = 0; i < 32; ++i) { const f32x4 w = __builtin_nontemporal_load((const f32x4*)(wp + (size_t)i * 4 * NMOD)); const int k = wave * 128 + 4 * i + kr;
            a0 += w * s_l[k]; a1 += w * s_l[1024 + k]; a2 += w * s_l[2048 + k]; a3 += w * s_l[3072 + k]; a4 += w * s_l[4096 + k];
            a5 += w * s_l[5120 + k]; a6 += w * s_l[6144 + k]; a7 += w * s_l[7168 + k]; a8 += w * s_l[8192 + k]; }
#define RED9(a, r) do { _Pragma("unroll") for (int e = 0; e < 4; ++e) { float v = a[e]; v += __shfl_xor(v, 16); v += __shfl_xor(v, 32); if (lane < 16) red[(wave * 9 + r) * 64 + 4 * cgp + e] = v; } } while (0)
        RED9(a0, 0); RED9(a1, 1); RED9(a2, 2); RED9(a3, 3); RED9(a4, 4); RED9(a5, 5); RED9(a6, 6); RED9(a7, 7); RED9(a8, 8);
#undef RED9
        __syncthreads();
        float* mod = (float*)(ws + WS_MOD);
        for (int i = tid; i < 576; i += 512) { const int r = i >> 6, col = i & 63; float s = 0.f;
#pragma unroll
            for (int w = 0; w < 8; ++w) s += red[(w * 9 + r) * 64 + col];
            mod[r * NMOD + c0 + col] = s + kp->b_ada[c0 + col]; }
    }
    __syncthreads();
    const int gw = blockIdx.x * 8 + wave, NGW = G * 8;
    if (blockIdx.x == G - 1) {
        float* rt = (float*)(ws + WS_ROPE);
        for (int i = tid; i < 2048; i += 512) { const int pos = i >> 5, j = i & 31; const float invf = powf(10000.0f, -(float)(2 * j) / 64.0f); const float ang = (float)pos * invf;
            rt[2 * i] = cosf(ang); rt[2 * i + 1] = sinf(ang); }
    }
    constexpr int I_1IN = 32 * 88;
    for (int r = (gw + 1152) % NGW; r < I_1IN; r += NGW) { const int kb = r / 88, n0 = (r % 88) * 64; const int isup = n0 >= DFF, j = isup ? n0 - DFF : n0;
        transpose_item(kp->w_ffn1_in, 1024, 2 * DFF, (bf16_t*)(ws + WS_W1IN), kb, n0, 256 * (j >> 7) + (j & 127) + 128 * isup, lane); }
}

__device__ __forceinline__ void late_weights(const Params& kp_, LAS unsigned char* lds, int tid, int lane, int widx, int nw) {
    const Params* kp = &kp_; unsigned char* ws = kp->ws;
    LAS float* tab2048 = (LAS float*)(lds + LDS_MISC);
    LAS float* tab128 = (LAS float*)(lds + LDS_MISC + 8192);
    for (int i = tid; i < 2048; i += 512) tab2048[i] = cospif((float)i * (1.0f / 1024.0f));
    if (tid < 128) tab128[tid] = cospif((float)tid * (1.0f / 64.0f));
    __syncthreads();
    constexpr int I_FOLD = 1024, I_IN = 32 * 64, I_AB = 32 * 16, I_FB = 16 * 16, I_O = 32 * 16, I_1OUT = 88 * 16;
    for (int r = widx; r < I_1OUT; r += nw) { const int kb = r >> 4, n0 = (r & 15) * 64; transpose_item(kp->w_ffn1_out, DFF, 1024, (bf16_t*)(ws + WS_W1OUT), kb, n0, n0, lane); }
    {
        bf16_t* dft = (bf16_t*)(ws + WS_DFT);
        for (int e8 = widx * 64 + lane; e8 < 2048 * 512; e8 += nw * 64) {
            const int k = e8 >> 9, kp0 = (e8 & 511) * 8, cs = kp0 >> 11, n0 = kp0 & 2047; float v[8];
#pragma unroll
            for (int e = 0; e < 8; ++e) { int idx = (k * (n0 + e)) & 2047; if (cs) idx = (idx + 512) & 2047; v[e] = tab2048[idx] * (1.0f / 512.0f); }
            u32x4 o; o.x = cvt_pk_bf16(v[0], v[1]); o.y = cvt_pk_bf16(v[2], v[3]); o.z = cvt_pk_bf16(v[4], v[5]); o.w = cvt_pk_bf16(v[6], v[7]);
            *(u32x4*)(dft + (size_t)e8 * 8) = o;
        }
    }
    for (int r = widx; r < I_FOLD; r += nw) {
        const int jt = r & 7, g = (r >> 3) & 3, kb = r >> 5, k0 = kb * 32;
        const int jj = jt * 32 + (lane & 31), cs = jj >> 7, m = jj & 127, hi = lane >> 5;
        const float* wrow = kp->w_in + (size_t)(k0 + (lane & 31)) * 4096 + 1536 + g * 128 + hi;
        f32x16 acc = {};
#pragma unroll 8
        for (int s2 = 0; s2 < 64; ++s2) { const int c = 2 * s2 + hi; const float a = wrow[2 * s2]; int idx = (c * m) & 127; if (cs) idx = (idx + 96) & 127;
            acc = __builtin_amdgcn_mfma_f32_32x32x2f32(a, tab128[idx], acc, 0, 0, 0); }
        bf16_t* WfT = (bf16_t*)(ws + WS_WF) + (size_t)(cs * 512 + g * 128 + m) * 1024 + k0 + 4 * hi;
#pragma unroll
        for (int q = 0; q < 4; ++q) { u32x2 o; o.x = cvt_pk_bf16(acc[4 * q], acc[4 * q + 1]); o.y = cvt_pk_bf16(acc[4 * q + 2], acc[4 * q + 3]); *(u32x2*)(WfT + 8 * q) = o; }
    }
    for (int r = widx; r < I_IN; r += nw) { const int kb = r >> 6, n0 = (r & 63) * 64; if (n0 < 1536 || n0 >= 2048) transpose_item(kp->w_in, 1024, 4096, (bf16_t*)(ws + WS_WIN), kb, n0, n0 < 1536 ? n0 : n0 - 512, lane); }
    for (int r = widx; r < I_AB; r += nw) { const int kb = r >> 4, n0 = (r & 15) * 64; transpose_item(kp->w_ab, 1024, 1024, (bf16_t*)(ws + WS_WAB), kb, n0, n0, lane); }
    for (int r = widx; r < I_O; r += nw) { const int kb = r >> 4, n0 = (r & 15) * 64; transpose_item(kp->w_out, 1024, 1024, (bf16_t*)(ws + WS_WO), kb, n0, n0, lane); }
}

template <bool LAT_BF> __device__ __forceinline__ void norm_phase(const float* lat, const float* ctxp, const float* ctxp2, int nrows, const float* gain, const float* mod, int sh_off, int sc_off, bf16_t* A, int gw, int NGW, int lane) {
    for (int r = gw; r < nrows; r += NGW) {
        const bool isctx = r >= NLAT; const float* src = isctx ? ctxp + (size_t)(r - NLAT) * DM : lat + (size_t)r * DM; const int mrow = isctx ? 8 : (r >> 11);
        f32x4 v[4]; float ss = 0.f;
#pragma unroll
        for (int j = 0; j < 4; ++j) { if (LAT_BF && !isctx) { const u32x2 w = __builtin_nontemporal_load((const u32x2*)((const bf16_t*)lat + (size_t)r * DM + 4 * lane + 256 * j)); v[j] = (f32x4){__uint_as_float(w.x << 16), __uint_as_float(w.x & 0xffff0000u), __uint_as_float(w.y << 16), __uint_as_float(w.y & 0xffff0000u)}; } else v[j] = __builtin_nontemporal_load((const f32x4*)(src + 4 * lane + 256 * j)); if (isctx && ctxp2) v[j] += *(const f32x4*)(ctxp2 + (size_t)(r - NLAT) * DM + 4 * lane + 256 * j); ss += (v[j][0] * v[j][0] + v[j][1] * v[j][1]) + (v[j][2] * v[j][2] + v[j][3] * v[j][3]); }
        const float rstd = 1.0f / sqrtf(wave_sum(ss) * (1.0f / DM) + EPS);
        const float* mp = mod + mrow * NMOD;
#pragma unroll
        for (int j = 0; j < 4; ++j) { const int c = 4 * lane + 256 * j; const f32x4 g = *(const f32x4*)(gain + c), sh = *(const f32x4*)(mp + sh_off + c), sc = *(const f32x4*)(mp + sc_off + c);
            const f32x4 o = (v[j] * rstd) * g * (sc + 1.0f) + sh; u32x2 w; w.x = cvt_pk_bf16(o[0], o[1]); w.y = cvt_pk_bf16(o[2], o[3]);
            *(u32x2*)(A + (size_t)r * DM + c) = w; }
    }
}

__device__ __forceinline__ void fix_head(bf16_t* hp, const float* g, const float* ropetab, int n, bool rope, int lane) {
    float t1 = bf2f(hp[lane]), t2 = bf2f(hp[lane + 64]);
    const float rstd = 1.0f / sqrtf(wave_sum(t1 * t1 + t2 * t2) * (1.0f / 128.0f) + EPS);
    t1 = t1 * rstd * g[lane]; t2 = t2 * rstd * g[lane + 64];
    float o1 = t1, o2 = t2;
    if (rope) { const int pos = lane < 32 ? (n >> 6) : (n & 63); const float c = ropetab[2 * (pos * 32 + (lane & 31))], s = ropetab[2 * (pos * 32 + (lane & 31)) + 1]; o1 = t1 * c - t2 * s; o2 = t2 * c + t1 * s; }
    hp[lane] = f2bf(o1); hp[lane + 64] = f2bf(o2);
}
__device__ __forceinline__ void fixup_phase(unsigned char* ws, const float* q_norm, const float* k_norm, int gw, int NGW, int lane) {
    bf16_t* Q = (bf16_t*)(ws + WS_Q); bf16_t* Kb = (bf16_t*)(ws + WS_K); const float* rt = (const float*)(ws + WS_ROPE);
    for (int r = gw; r < NTOK; r += NGW) {
        if (r < NLAT) { const int b = r >> 11, n = r & 2047;
            for (int h = 0; h < 8; ++h) fix_head(Q + (size_t)r * DM + h * 128, q_norm, rt, n, true, lane);
            for (int h = 0; h < 2; ++h) fix_head(Kb + (size_t)(b * SKV + CTXL + n) * 256 + h * 128, k_norm, rt, n, true, lane);
        } else { const int rc = r - NLAT, b = rc >> 8, n = rc & 255;
            for (int h = 0; h < 2; ++h) fix_head(Kb + (size_t)(b * SKV + n) * 256 + h * 128, k_norm, rt, 0, false, lane); }
    }
}

constexpr int NSTEPS = 15;
__host__ __device__ constexpr bool sync_after(int st) { return !(st == 7 || st == 9); }

__global__ void __launch_bounds__(512, 2) mk_fwd(Params p) {
    extern __shared__ __attribute__((aligned(16))) unsigned char lds_raw[];
    LAS unsigned char* lds = (LAS unsigned char*)lds_raw;
    const int G = gridDim.x, c = blockIdx.x, NGW = G * 8;
    const int lo = p.st_lo, hi = p.st_hi;
    unsigned char* const ws = p.ws;
    const float* const mod = (const float*)(ws + WS_MOD);
    bf16_t* const Abuf = (bf16_t*)(ws + WS_A);
#define IN(k) (lo <= (k) && (k) < hi)
    volatile LAS unsigned* bst = (volatile LAS unsigned*)(lds + LDS_MISC + 12288);
    if (threadIdx.x < 2) bst[threadIdx.x] = 0u;
    __syncthreads();
    XcdBarrier gbar; gbar.bar = (unsigned*)(ws + WS_BAR); gbar.x = 0; gbar.st = bst;
    if (hi - lo > 1) gbar = xcd_barrier_post((unsigned*)(ws + WS_BAR), bst);
    if (hi < 0) cg::this_grid().sync();
#define SEAM(k) do { if (IN(k) && IN((k) + 1)) { if (sync_after(k)) xcd_barrier(gbar); else { __syncthreads(); } } } while (0)
#define TIDS() int tid = threadIdx.x; asm volatile("" : "+v"(tid)); const int lane = tid & 63, wave = __builtin_amdgcn_readfirstlane(tid >> 6), gw = c * 8 + wave; (void)lane; (void)gw
#define GEMM1P(PRM, KK, a, b, nm, nn, kd, rm) do { const pg8::Sched S{(a), nullptr, nullptr, (b), nullptr, nullptr, (nm), 1, 1, (nn), 1, 1, (kd), (kd), (kd), (nm) * (nn), 0, 0, G, c, (KK), 0, (KK) / 64, (KK) / 64, (KK) / 64, 0, 0}; \
        const pg8::Epi E{ws, p.out, p.x, p.ctx, (rm), p.k_norm, p.norm_ffn2, (const LAS float*)(lds + LDS_MISC)}; pg8::gemm_phase<true, true, PRM>(lds, S, E, tid); } while (0)
#define GEMM1(KK, a, b, nm, nn, kd, rm) GEMM1P(true, KK, a, b, nm, nn, kd, rm)
    if (IN(0)) { TIDS(); prep_phase(p, lds, tid, lane, wave, G); }
    SEAM(0);
    if (IN(1)) { TIDS(); norm_phase<false>(p.x, p.ctx, nullptr, NTOK, p.norm_ffn1, mod, 0 * DM, 1 * DM, Abuf, gw, NGW, lane); }
    SEAM(1);
    if (IN(2)) { TIDS(); GEMM1(1024, Abuf, (const bf16_t*)(ws + WS_W1IN), NTOK / 256, 22, pg8::K_SWIGLU, 0);
        constexpr int NBUSY = (NTOK / 256) * 22 - 6 * 256;
        int t2 = threadIdx.x; asm volatile("" : "+v"(t2)); const int w2 = __builtin_amdgcn_readfirstlane(t2 >> 6);
        if (G == 256 && c >= NBUSY) late_weights(p, lds, t2, t2 & 63, (c - NBUSY) * 8 + w2, (256 - NBUSY) * 8);
        else if (G != 256) late_weights(p, lds, t2, t2 & 63, c * 8 + w2, NGW); }
    SEAM(2);
    if (IN(3)) { TIDS();
        const bf16_t* Hc = (const bf16_t*)(ws + WS_H) + (size_t)NLAT * DFF;
        const pg8::Sched S{(const bf16_t*)(ws + WS_H), Hc, Hc, (const bf16_t*)(ws + WS_W1OUT), (const bf16_t*)(ws + WS_W1OUT), (const bf16_t*)(ws + WS_W1OUT),
                           64, 8, 8, 4, 4, 4, pg8::K_RES, pg8::K_RESC0, pg8::K_RESC1, 256, 32, 32, G, c, DFF, 0, 44, 22, 22, 0, DFF / 2};
        const pg8::Epi E{ws, p.out, p.x, p.ctx, 0, p.k_norm, p.norm_ffn2, (const LAS float*)(lds + LDS_MISC)}; pg8::gemm_phase<true, true>(lds, S, E, tid); }
    SEAM(3);
    if (IN(4)) { TIDS(); norm_phase<true>(p.out, (const float*)(ws + WS_CTX1), (const float*)(ws + WS_CTX1B), NTOK, p.norm_mix, mod, 3 * DM, 4 * DM, Abuf, gw, NGW, lane); }
    SEAM(4);
    if (IN(5)) { TIDS();
        const pg8::Sched S{Abuf, (const bf16_t*)(ws + WS_WF), Abuf + (size_t)NLAT * DM, (const bf16_t*)(ws + WS_WIN), Abuf, (const bf16_t*)(ws + WS_WIN) + (size_t)1024 * DM,
                           64, 4, 8, 14, 64, 2, pg8::K_INPROJ, pg8::K_FTSWAP, pg8::K_CTXKV, 64 * 14, 256, 16, G, c, 1024, 0, 16, 16, 16, 0, 0};
        const pg8::Epi E{ws, p.out, p.x, p.ctx, 0, p.k_norm, p.norm_ffn2, (const LAS float*)(lds + LDS_MISC)}; pg8::gemm_phase<true, true>(lds, S, E, tid);
        if (G == 256 && c >= 144) {
            int t2 = threadIdx.x; asm volatile("" : "+v"(t2)); const int lane = t2 & 63;
            const int w2 = (c - 144) * 8 + __builtin_amdgcn_readfirstlane(t2 >> 6), nw2 = 112 * 8;
            for (int r = w2; r < 32 * 88; r += nw2) { const int kb = r / 88, n0 = (r % 88) * 64; const int isup = n0 >= DFF, j = isup ? n0 - DFF : n0;
                transpose_item(p.w_ffn2_in, 1024, 2 * DFF, (bf16_t*)(ws + WS_W2IN), kb, n0, 256 * (j >> 7) + (j & 127) + 128 * isup, lane); }
            for (int r = w2; r < 88 * 16; r += nw2) { const int kb = r >> 4, n0 = (r & 15) * 64; transpose_item(p.w_ffn2_out, DFF, 1024, (bf16_t*)(ws + WS_W2OUT), kb, n0, n0, lane); }
            for (int r = w2; r < 2 * 16 * 16; r += nw2) { const int hf = r >> 8, q = r & 255, kb = q >> 4, n0 = (q & 15) * 64;
                transpose_item(p.w_fb, 512, 1024, (bf16_t*)(ws + WS_WFB2) + hf * 512, kb, n0, n0, lane, 1024); }
        } }
    if (IN(5) && IN(7)) xcd_barrier(gbar);
    if (IN(7)) { TIDS();
        {
            const bf16_t* FTp = (const bf16_t*)(ws + WS_FT); bf16_t* YFp = (bf16_t*)(ws + WS_YF);
            for (int j = gw; j < 4096; j += NGW) { const bf16_t* src = FTp + (size_t)j * 4096 + 32 * lane; float acc_ = 0.f;
#pragma unroll
                for (int q4 = 0; q4 < 4; ++q4) { f32x4 a0, a1; unpack8(*(const u32x4*)(src + 8 * q4), a0, a1); acc_ += (a0[0] - a0[1]) + (a0[2] - a0[3]) + (a1[0] - a1[1]) + (a1[2] - a1[3]); }
                const float tot = wave_sum(acc_) * (1.0f / 512.0f);
                if (lane == 0) YFp[(size_t)((j >> 9) * SEQ + 1024) * 1024 + (j & 511)] = f2bf(tot); }
        }
        const pg8::Sched S{(const bf16_t*)(ws + WS_DFT), nullptr, nullptr, (const bf16_t*)(ws + WS_FT), nullptr, nullptr, 4, 1, 1, 16, 1, 1, pg8::K_FOUR2, pg8::K_FOUR2, pg8::K_FOUR2, 256, 0, 0, G, c, 4096, 1, 16, 16, 16, 0, 0};
        const pg8::Epi E{ws, p.out, p.x, p.ctx, 0, p.k_norm, p.norm_ffn2, (const LAS float*)(lds + LDS_MISC)}; pg8::gemm_phase<true, true>(lds, S, E, tid); }
    SEAM(7);
    if (IN(8)) { TIDS();
        const int x = c & 7, s = c >> 3; const int j0 = 2 * s; int nj = 2; asm volatile("" : "+s"(nj));
#pragma unroll 1
        for (int i = 0; i < nj; ++i) { const int j = j0 + i, kvh = j >> 5, h = kvh * 4 + ((j >> 3) & 3), qb = j & 7;
            att::bf16* Qb = (att::bf16*)(ws + WS_Q) + (size_t)(x * SEQ + qb * 256) * DM + h * 128;
            const att::bf16* Kh = (const att::bf16*)(ws + WS_K) + (size_t)x * SKV * 256 + kvh * 128;
            const att::bf16* Vh = (const att::bf16*)(ws + WS_V) + (size_t)x * SKV * 256 + kvh * 128;
            const int tu = tid;
            att::attn_unit(Qb, Kh, Vh, Qb, SKV, (char*)lds_raw, tu, p.q_norm, (const float*)(ws + WS_ROPE), qb * 256); }
        {
            int t2 = threadIdx.x; asm volatile("" : "+v"(t2)); const int ln = t2 & 63, wv = __builtin_amdgcn_readfirstlane(t2 >> 6);
            const bf16_t* W2 = (const bf16_t*)(ws + WS_W2IN); float* sw3 = (float*)(ws + WS_SW3);
            for (int n = c * 8 + wv; n < 2 * DFF; n += NGW) {
                const u32x4 w0 = *(const u32x4*)(W2 + (size_t)n * DM + 8 * ln), w1 = *(const u32x4*)(W2 + (size_t)n * DM + 512 + 8 * ln);
                f32x4 a0, a1, a2, a3; unpack8(w0, a0, a1); unpack8(w1, a2, a3);
#pragma unroll
                for (int b = 0; b < 8; ++b) { const float* sh = mod + b * NMOD + 6 * DM + 8 * ln;
                    const f32x4 s0 = *(const f32x4*)sh, s1 = *(const f32x4*)(sh + 4), s2 = *(const f32x4*)(sh + 512), s3 = *(const f32x4*)(sh + 516);
                    const f32x4 pr = a0 * s0 + a1 * s1 + a2 * s2 + a3 * s3; const float d = wave_sum((pr[0] + pr[1]) + (pr[2] + pr[3]));
                    if (ln == 0) sw3[b * (2 * DFF) + n] = d; }
            }
        }
    }
    SEAM(8);
    if (IN(9)) { TIDS();
        const pg8::Sched S{(const bf16_t*)(ws + WS_Q), (const bf16_t*)(ws + WS_YF), nullptr, (const bf16_t*)(ws + WS_WAB), (const bf16_t*)(ws + WS_WFB2), nullptr,
                           64, 64, 1, 4, 4, 1, pg8::K_BRA, pg8::K_BRB, pg8::K_BRB, 256, 256, 0, G, c, 1024, 2, 16, 8, 16, 0, 0};
        const pg8::Epi E{ws, p.out, p.x, p.ctx, 0, p.k_norm, p.norm_ffn2, (const LAS float*)(lds + LDS_MISC)}; pg8::gemm_phase<true, true>(lds, S, E, tid); }
    SEAM(9);
    SEAM(10);
    if (IN(11)) { TIDS(); GEMM1(1024, (const bf16_t*)(ws + WS_GA), (const bf16_t*)(ws + WS_WO), 64, 4, pg8::K_RES, 1); }
    if (IN(11) && IN(13)) xcd_barrier(gbar);
    if (IN(13)) { TIDS();
        {
            LAS float* rs = (LAS float*)(lds + LDS_MISC); const float* st3 = (const float*)(ws + WS_ST3) + (size_t)(c & 7) * 2048 * 16;
            for (int r = tid; r < 2048; r += 512) { const f32x4* sp = (const f32x4*)(st3 + (size_t)r * 16); const f32x4 q = (sp[0] + sp[1]) + (sp[2] + sp[3]);
                rs[r] = 1.0f / sqrtf(((q[0] + q[1]) + (q[2] + q[3])) * (1.0f / DM) + EPS); }
            __syncthreads();
        }
        GEMM1(1024, Abuf, (const bf16_t*)(ws + WS_W2IN), 64, 22, pg8::K_SWIGLU, 3); }
    SEAM(13);
    if (IN(14)) { TIDS(); GEMM1(DFF, (const bf16_t*)(ws + WS_H), (const bf16_t*)(ws + WS_W2OUT), 64, 4, pg8::K_RES, 2); }
#undef IN
#undef SEAM
#undef TIDS
#undef GEMM1
#undef GEMM1P
}

extern "C" void kernel_launch(void* const* d_in, const int* in_sizes, int n_in, void* d_out, int out_size, void* d_ws, size_t ws_size, hipStream_t stream) {
    static int grid = 0;
    if (grid == 0) {
        if (n_in != 19 || out_size != NLAT * DM || ws_size < WS_END) { fprintf(stderr, "kernel_launch: unexpected shapes (n_in %d out %d ws %zu)\n", n_in, out_size, ws_size); grid = -1; return; }
        int dev = 0, cus = 0, per_cu = 0;
        hipGetDevice(&dev); hipDeviceGetAttribute(&cus, hipDeviceAttributeMultiprocessorCount, dev);
        if (hipFuncSetAttribute((const void*)mk_fwd, hipFuncAttributeMaxDynamicSharedMemorySize, LDS_BYTES) != hipSuccess) { fprintf(stderr, "kernel_launch: hipFuncSetAttribute failed\n"); grid = -1; return; }
        hipOccupancyMaxActiveBlocksPerMultiprocessor(&per_cu, (const void*)mk_fwd, 512, LDS_BYTES);
        (void)hipGetLastError();
        if (cus != 256 || per_cu < 1) fprintf(stderr, "kernel_launch: note: cus %d per_cu %d (built for 256 x 1)\n", cus, per_cu);
        grid = 256;
    }
    if (grid < 0) return;
    Params p{};
    const float** pp = (const float**)&p;
    for (int i = 0; i < 19; ++i) pp[i] = (const float*)d_in[i];
    p.out = (float*)d_out; p.ws = (unsigned char*)d_ws;
    if (hipMemsetAsync((char*)d_ws + WS_BAR, 0, BAR_BYTES, stream) != hipSuccess) { fprintf(stderr, "kernel_launch: memset failed\n"); return; }
#if MK_MULTI
    int lo = 0;
    for (int st = 0; st < NSTEPS; ++st) {
        if (sync_after(st) || st == NSTEPS - 1) { p.st_lo = lo; p.st_hi = st + 1; hipLaunchKernelGGL(mk_fwd, dim3(grid), dim3(512), LDS_BYTES, stream, p); lo = st + 1; }
    }
#else
    p.st_lo = 0; p.st_hi = NSTEPS;
    void* args[] = {&p};
    hipError_t e = hipLaunchCooperativeKernel((const void*)mk_fwd, dim3(grid), dim3(512), args, LDS_BYTES, stream);
    if (e != hipSuccess) fprintf(stderr, "cooperative launch failed: %s\n", hipGetErrorString(e));
#endif
}
```

```cpp
#include <hip/hip_runtime.h>
#include <hip/hip_cooperative_groups.h>
#include <hip/hip_bf16.h>
#include <cstdio>
#include <cstdint>
namespace cg = cooperative_groups;

#ifndef MK_MULTI
#define MK_MULTI 0
#endif

#define LAS __attribute__((address_space(3)))
typedef unsigned short bf16_t;
typedef short bf16x8 __attribute__((ext_vector_type(8)));
typedef float f32x4 __attribute__((ext_vector_type(4)));
typedef float f32x16 __attribute__((ext_vector_type(16)));
typedef unsigned u32x4 __attribute__((ext_vector_type(4)));
typedef unsigned u32x2 __attribute__((ext_vector_type(2)));
typedef short s16x4 __attribute__((ext_vector_type(4)));

constexpr int DM = 1024, NB = 8, SEQ = 2048, CTXL = 256, NLAT = NB * SEQ, NCTX = NB * CTXL, NTOK = NLAT + NCTX;
constexpr int DFF = 2816, NMOD = 9 * DM, SKV = CTXL + SEQ;
constexpr float EPS = 1e-6f;

constexpr size_t MiB = 1u << 20;
constexpr size_t WS_MOD = 0, WS_ROPE = 384 * 1024, WS_BAR = 512 * 1024, WS_CNT = WS_BAR + 16384, BAR_BYTES = 16384 + 65536;
constexpr size_t WS_W1IN = 1 * MiB, WS_W1OUT = 12 * MiB, WS_WIN = 18 * MiB, WS_WF = 25 * MiB, WS_WAB = 27 * MiB, WS_WFB = 29 * MiB, WS_WO = 30 * MiB;
constexpr size_t WS_W2IN = 32 * MiB, WS_W2OUT = 43 * MiB, WS_DFT = 49 * MiB, WS_A = 65 * MiB, WS_CTX1 = 101 * MiB, WS_H = 109 * MiB;
constexpr size_t WS_Q = 109 * MiB, WS_K = 141 * MiB, WS_V = 150 * MiB, WS_GA = 159 * MiB, WS_GF = 191 * MiB, WS_FT = 223 * MiB, WS_YF = WS_A, WS_CTX1B = WS_FT, WS_X2 = WS_FT, WS_WFB2 = WS_W1IN, WS_ST3 = WS_CTX1, WS_SW3 = WS_CTX1 + 2 * MiB, WS_END = 255 * MiB;

constexpr int LDS_BYTES = 147456;
constexpr int LDS_MISC = 131072;

__device__ __forceinline__ unsigned cvt_pk_bf16(float lo, float hi) { unsigned r; asm volatile("v_cvt_pk_bf16_f32 %0, %1, %2" : "=v"(r) : "v"(lo), "v"(hi)); return r; }
__device__ __forceinline__ u32x4 pack8(f32x4 a, f32x4 b) { u32x4 w; w.x = cvt_pk_bf16(a[0], a[1]); w.y = cvt_pk_bf16(a[2], a[3]); w.z = cvt_pk_bf16(b[0], b[1]); w.w = cvt_pk_bf16(b[2], b[3]); return w; }
__device__ __forceinline__ void st16_wt(void* p, u32x4 v) {
    asm volatile("global_store_dwordx4 %0, %1, off sc1\n\ts_nop 1" :: "v"(p), "v"(v) : "memory");
}
__device__ __forceinline__ void unpack8(u32x4 w, f32x4& a, f32x4& b) {
    a[0] = __uint_as_float(w.x << 16); a[1] = __uint_as_float(w.x & 0xffff0000u); a[2] = __uint_as_float(w.y << 16); a[3] = __uint_as_float(w.y & 0xffff0000u);
    b[0] = __uint_as_float(w.z << 16); b[1] = __uint_as_float(w.z & 0xffff0000u); b[2] = __uint_as_float(w.w << 16); b[3] = __uint_as_float(w.w & 0xffff0000u); }
__device__ __forceinline__ float bf2f(bf16_t v) { return __uint_as_float((unsigned)v << 16); }
__device__ __forceinline__ bf16_t f2bf(float f) { unsigned u = __float_as_uint(f); return (bf16_t)((u + 0x7fffu + ((u >> 16) & 1u)) >> 16); }
__device__ __forceinline__ float sigmoidf_(float v) { return __builtin_amdgcn_rcpf(1.f + __builtin_amdgcn_exp2f(-1.4426950408889634f * v)); }
__device__ __forceinline__ float wave_sum(float v) {
#pragma unroll
    for (int o = 1; o < 64; o <<= 1) v += __shfl_xor(v, o);
    return v;
}

namespace pg8 {
constexpr int BM = 256, BK = 64, HALF = 128, HTB = HALF * BK * 2, STAGE_BYTES = 8 * HTB, NXCD = 8, WGM = 8;
__host__ __device__ __forceinline__ int lds_byte(int r, int c) { const int st = (r >> 4) * 2 + (c >> 5), rr = r & 15, cc = c & 31, ob = rr * 64 + cc * 2; return st * 1024 + (ob ^ (((ob >> 9) & 1) << 5)); }
__host__ __device__ __forceinline__ void stage_rc(int b, int& R, int& C) { const int st = b / 1024, sb = b % 1024, swz = sb ^ (((sb >> 9) & 1) << 5); R = (st >> 1) * 16 + swz / 64; C = (st & 1) * 32 + (swz % 64) / 2; }
__host__ __device__ __forceinline__ int perm32(int rho) { const int n = rho >> 4, i = rho & 15; return 8 * (i >> 2) + 4 * n + (i & 3); }

struct Unit { int pm, pn, sub, q; };
enum Kind { K_SWIGLU = 0, K_RES = 1, K_INPROJ = 2, K_FTSWAP = 3, K_CTXKV = 4, K_FOUR2 = 5, K_BRA = 6, K_BRB = 7, K_RESC0 = 8, K_RESC1 = 9 };

struct Sched {
    const bf16_t *A0, *A1, *A2, *B0, *B1, *B2; int nM0, nM1, nM2, nN0, nN1, nN2, k0, k1, k2; int n0, n1, n2; int G, c, K, direct; int kt0, kt1, kt2, ko1, ko2;
    static __device__ __forceinline__ int sel3(int sub, int v0, int v1, int v2) { const int m1 = -(int)(sub == 1), m2 = -(int)(sub == 2); return v0 ^ ((v0 ^ v1) & m1) ^ ((v0 ^ v2) & m2); }
    static __device__ __forceinline__ unsigned long long sel3p(int sub, const void* p0, const void* p1, const void* p2) {
        const unsigned long long v0 = (unsigned long long)p0, v1 = (unsigned long long)p1, v2 = (unsigned long long)p2, m1 = -(unsigned long long)(sub == 1), m2 = -(unsigned long long)(sub == 2);
        return v0 ^ ((v0 ^ v1) & m1) ^ ((v0 ^ v2) & m2); }
    __device__ __forceinline__ bool next(int i, Unit& u) const {
        u.q = 0;
        if (direct == 1) { if (i > 0) return false; const int x = c & 7, s = c >> 3, r = s & 7; u.sub = 0; u.q = s >> 3; u.pm = r & 3; u.pn = 2 * x + (r >> 2); return true; }
        if (direct == 2) {
            if (i > 1 || c >= n0) return false; u.sub = i;
            const int nwg = nM0 * nN0; int wgid; { const int q = nwg / NXCD, r = nwg % NXCD, xcd = c % NXCD, off = c / NXCD; wgid = (xcd < r ? xcd * (q + 1) : r * (q + 1) + (xcd - r) * q) + off; }
            const int nig = WGM * nN0, gid = wgid / nig, fm = gid * WGM, gsz = (nM0 - fm) < WGM ? (nM0 - fm) : WGM;
            u.pm = fm + ((wgid % nig) % gsz); u.pn = (wgid % nig) / gsz; return true; }
        const long L = (long)i * G + c;
        if (L >= n0 + n1 + n2) return false;
        const int sub = (L >= n0) + (L >= n0 + n1); u.sub = sub;
        const int l = (int)L - sel3(sub, 0, n0, n0 + n1), nM = sel3(sub, nM0, nM1, nM2), nN = sel3(sub, nN0, nN1, nN2);
        const int nwg = nM * nN; int wgid; { const int q = nwg / NXCD, r = nwg % NXCD, xcd = l % NXCD, off = l / NXCD; wgid = (xcd < r ? xcd * (q + 1) : r * (q + 1) + (xcd - r) * q) + off; }
        const int nig = WGM * nN, gid = wgid / nig, fm = gid * WGM, gsz = (nM - fm) < WGM ? (nM - fm) : WGM;
        u.pm = fm + ((wgid % nig) % gsz); u.pn = (wgid % nig) / gsz; return true;
    }
    __device__ __forceinline__ const char* aptr(const Unit& u) const { return (const char*)sel3p(u.sub, A0, A1, A2) + (size_t)u.pm * (size_t)(512 * K) + 2 * sel3(u.sub, 0, ko1, ko2) + (direct == 1 ? 2048 * u.q : 0); }
    __device__ __forceinline__ const char* bptr(const Unit& u) const { return (const char*)sel3p(u.sub, B0, B1, B2) + (size_t)u.pn * (size_t)(512 * K) + 2 * sel3(u.sub, 0, ko1, ko2) + (direct == 1 ? 2048 * u.q : 0); }
    __device__ __forceinline__ int ktiles(const Unit& u) const { return sel3(u.sub, kt0, kt1, kt2); }
    __device__ __forceinline__ int kind(const Unit& u) const { return sel3(u.sub, k0, k1, k2); }
};

struct Epi {
    unsigned char* ws; float* out; const float* x; const float* ctx; int res_mode; const float* kg; const float* ng; const LAS float* rs;
    template <bool PERM> __device__ __forceinline__ void run(f32x4 (&acc)[2][2][4][2], const Unit& u, int kind, int wr, int wc, int fr_in, int fq_in) const {
        int fr = fr_in, fq = fq_in; asm volatile("" : "+v"(fr), "+v"(fq));
        const int rowt = u.pm * 256 + wr * 64 + fr;
        const int cw = wc * 32 + 8 * fq;
        if (kind == K_SWIGLU) {
            bf16_t* H = (bf16_t*)(ws + WS_H);
            const bool fn = (res_mode == 3);
            f32x4 sg[2], su[2];
            if (fn) { const float* sw = (const float*)(ws + WS_SW3) + (u.pm >> 3) * (2 * DFF) + u.pn * 256 + cw;
#pragma unroll
                for (int n = 0; n < 2; ++n) { sg[n] = *(const f32x4*)(sw + 4 * n); su[n] = *(const f32x4*)(sw + 128 + 4 * n); } }
#pragma unroll
            for (int ai = 0; ai < 2; ++ai)
#pragma unroll
                for (int m = 0; m < 4; ++m) {
                    const int row = rowt + ai * 128 + m * 16; f32x4 h[2];
                    const float rstd = fn ? rs[row & 2047] : 1.f;
#pragma unroll
                    for (int n = 0; n < 2; ++n) { f32x4 g = acc[ai][0][m][n], up = acc[ai][1][m][n]; if (fn) { g = g * rstd + sg[n]; up = up * rstd + su[n]; }
#pragma unroll
                        for (int e = 0; e < 4; ++e) h[n][e] = g[e] * sigmoidf_(g[e]) * up[e]; }
                    *(u32x4*)(H + (size_t)row * DFF + u.pn * 128 + cw) = pack8(h[0], h[1]);
                }
        } else if (kind == K_RES || kind == K_RESC0 || kind == K_RESC1) {
            const float* mod = (const float*)(ws + WS_MOD);
            const bool isctx = kind != K_RES, nobase = kind == K_RESC1;
            const bool in_bf = (res_mode != 0), out_bf = (res_mode == 1) || (res_mode == 0 && !isctx);
            const float* basef = isctx ? ctx : x; float* dstf = isctx ? (float*)(ws + (nobase ? WS_CTX1B : WS_CTX1)) : out;
            const bf16_t* baseb = res_mode == 1 ? (const bf16_t*)out : (const bf16_t*)(ws + WS_X2); bf16_t* dstb = res_mode == 0 ? (bf16_t*)out : (bf16_t*)(ws + WS_X2);
            const int gate_off = res_mode == 0 ? 2 * DM : (res_mode == 1 ? 5 * DM : 8 * DM); const float coef = res_mode == 1 ? 1.f : 0.5f;
            const int mrow = isctx ? 8 : (u.pm >> 3);
            const float* gp = mod + mrow * NMOD + gate_off + u.pn * 256 + cw;
            f32x4 gv[2][2], gg[2][2];
#pragma unroll
            for (int bj = 0; bj < 2; ++bj)
#pragma unroll
                for (int n = 0; n < 2; ++n) { gv[bj][n] = *(const f32x4*)(gp + bj * 128 + 4 * n) * coef; gg[bj][n] = gv[bj][n];
                    if (res_mode == 1) gg[bj][n] = *(const f32x4*)(ng + u.pn * 256 + cw + bj * 128 + 4 * n) * (*(const f32x4*)(mod + mrow * NMOD + 7 * DM + u.pn * 256 + cw + bj * 128 + 4 * n) + 1.0f); }
#pragma unroll
            for (int ai = 0; ai < 2; ++ai) {
                f32x4 bv[4][2][2];
#pragma unroll
                for (int m = 0; m < 4; ++m) { const size_t off = (size_t)(rowt + ai * 128 + m * 16) * DM + u.pn * 256 + cw;
#pragma unroll
                    for (int bj = 0; bj < 2; ++bj) {
                        if (in_bf) unpack8(__builtin_nontemporal_load((const u32x4*)(baseb + off + bj * 128)), bv[m][bj][0], bv[m][bj][1]);
                        else if (nobase) { bv[m][bj][0] = (f32x4){0.f, 0.f, 0.f, 0.f}; bv[m][bj][1] = bv[m][bj][0]; }
                        else { bv[m][bj][0] = __builtin_nontemporal_load((const f32x4*)(basef + off + bj * 128)); bv[m][bj][1] = __builtin_nontemporal_load((const f32x4*)(basef + off + bj * 128 + 4)); } } }
#pragma unroll
                for (int m = 0; m < 4; ++m) { const size_t off = (size_t)(rowt + ai * 128 + m * 16) * DM + u.pn * 256 + cw; float ss = 0.f;
#pragma unroll
                    for (int bj = 0; bj < 2; ++bj) { const f32x4 v0 = bv[m][bj][0] + gv[bj][0] * acc[ai][bj][m][0], v1 = bv[m][bj][1] + gv[bj][1] * acc[ai][bj][m][1];
                        if (out_bf) *(u32x4*)(dstb + off + bj * 128) = pack8(v0, v1);
                        else { *(f32x4*)(dstf + off + bj * 128) = v0; *(f32x4*)(dstf + off + bj * 128 + 4) = v1; }
                        if (res_mode == 1) {
                            *(u32x4*)((bf16_t*)(ws + WS_A) + off + bj * 128) = pack8(v0 * gg[bj][0], v1 * gg[bj][1]);
                            ss += (v0[0] * v0[0] + v0[1] * v0[1]) + (v0[2] * v0[2] + v0[3] * v0[3]) + (v1[0] * v1[0] + v1[1] * v1[1]) + (v1[2] * v1[2] + v1[3] * v1[3]); } }
                    if (res_mode == 1) { ss += __shfl_xor(ss, 16); ss += __shfl_xor(ss, 32);
                        if (fq == 0) ((float*)(ws + WS_ST3))[(size_t)(rowt + ai * 128 + m * 16) * 16 + u.pn * 4 + wc] = ss; } }
            }
        } else if (kind == K_INPROJ || kind == K_CTXKV) {
            bf16_t* dstb; int ld, rowadd, colb; bool sig = false;
            if (kind == K_INPROJ) {
                const int pn = u.pn;
                if (pn < 4) { dstb = (bf16_t*)(ws + WS_Q); ld = DM; rowadd = 0; colb = pn * 256; }
                else if (pn < 6) { dstb = (bf16_t*)(ws + (pn == 4 ? WS_K : WS_V)); ld = 256; rowadd = 256 * ((u.pm >> 3) + 1); colb = 0; }
                else if (pn < 10) { dstb = (bf16_t*)(ws + WS_GA); ld = DM; rowadd = 0; colb = (pn - 6) * 256; sig = true; }
                else { dstb = (bf16_t*)(ws + WS_GF); ld = DM; rowadd = 0; colb = (pn - 10) * 256; sig = true; }
            } else { dstb = (bf16_t*)(ws + (u.pn == 0 ? WS_K : WS_V)); ld = 256; rowadd = u.pm * (SKV - CTXL); colb = 0; }
#pragma unroll
            for (int ai = 0; ai < 2; ++ai)
#pragma unroll
                for (int m = 0; m < 4; ++m) {
                    const int row = rowt + ai * 128 + m * 16 + rowadd;
#pragma unroll
                    for (int bj = 0; bj < 2; ++bj) { f32x4 a = acc[ai][bj][m][0], b = acc[ai][bj][m][1];
                        if (sig) {
#pragma unroll
                            for (int e = 0; e < 4; ++e) { a[e] = sigmoidf_(a[e]); b[e] = sigmoidf_(b[e]); } }
                        *(u32x4*)(dstb + (size_t)row * ld + colb + bj * 128 + cw) = pack8(a, b); }
                }
            const bool isk = (kind == K_INPROJ) ? (u.pn == 4) : (u.pn == 0);
            if (isk) {
                asm volatile("s_waitcnt vmcnt(0)" ::: "memory"); __builtin_amdgcn_s_barrier(); asm volatile("" ::: "memory");
                const float* rt = (const float*)(ws + WS_ROPE); const bool rope = (kind == K_INPROJ);
                const int lane = fq * 16 + fr, wid = wr * 4 + wc, l16 = lane & 15;
                const f32x4 g1 = *(const f32x4*)(kg + 4 * l16), g2 = *(const f32x4*)(kg + 64 + 4 * l16);
#pragma unroll 4
                for (int it = 0; it < 16; ++it) { const int item = it * 32 + wid * 4 + (lane >> 4), r = item >> 1, hd = item & 1;
                    bf16_t* hp = dstb + (size_t)(u.pm * 256 + r + rowadd) * 256 + hd * 128 + 4 * l16;
                    const u32x2 w1 = *(const u32x2*)hp, w2 = *(const u32x2*)(hp + 64);
                    f32x4 t1 = {__uint_as_float(w1.x << 16), __uint_as_float(w1.x & 0xffff0000u), __uint_as_float(w1.y << 16), __uint_as_float(w1.y & 0xffff0000u)};
                    f32x4 t2 = {__uint_as_float(w2.x << 16), __uint_as_float(w2.x & 0xffff0000u), __uint_as_float(w2.y << 16), __uint_as_float(w2.y & 0xffff0000u)};
                    float ss = (t1[0] * t1[0] + t1[1] * t1[1]) + (t1[2] * t1[2] + t1[3] * t1[3]) + (t2[0] * t2[0] + t2[1] * t2[1]) + (t2[2] * t2[2] + t2[3] * t2[3]);
                    ss += __shfl_xor(ss, 1); ss += __shfl_xor(ss, 2); ss += __shfl_xor(ss, 4); ss += __shfl_xor(ss, 8);
                    const float rstd = 1.0f / sqrtf(ss * (1.0f / 128.0f) + EPS);
                    t1 = t1 * rstd * g1; t2 = t2 * rstd * g2;
                    if (rope) { const int n = ((u.pm & 7) * 256 + r); const int pos = l16 < 8 ? (n >> 6) : (n & 63); const float* rp = rt + 2 * (pos * 32 + ((4 * l16) & 31));
                        const f32x4 c0 = *(const f32x4*)rp, c1 = *(const f32x4*)(rp + 4); f32x4 o1, o2;
                        o1[0] = t1[0] * c0[0] - t2[0] * c0[1]; o2[0] = t2[0] * c0[0] + t1[0] * c0[1]; o1[1] = t1[1] * c0[2] - t2[1] * c0[3]; o2[1] = t2[1] * c0[2] + t1[1] * c0[3];
                        o1[2] = t1[2] * c1[0] - t2[2] * c1[1]; o2[2] = t2[2] * c1[0] + t1[2] * c1[1]; o1[3] = t1[3] * c1[2] - t2[3] * c1[3]; o2[3] = t2[3] * c1[2] + t1[3] * c1[3];
                        t1 = o1; t2 = o2; }
                    u32x2 q1, q2; q1.x = cvt_pk_bf16(t1[0], t1[1]); q1.y = cvt_pk_bf16(t1[2], t1[3]); q2.x = cvt_pk_bf16(t2[0], t2[1]); q2.y = cvt_pk_bf16(t2[2], t2[3]);
                    *(u32x2*)hp = q1; *(u32x2*)(hp + 64) = q2; }
            }
        } else if (kind == K_FTSWAP) {
            bf16_t* FT = (bf16_t*)(ws + WS_FT);
#pragma unroll
            for (int ai = 0; ai < 2; ++ai)
#pragma unroll
                for (int m = 0; m < 4; ++m) {
                    const int j = rowt + ai * 128 + m * 16; const int cs = j >> 9, g = (j >> 7) & 3, mm = j & 127;
#pragma unroll
                    for (int bj = 0; bj < 2; ++bj) { const int t0 = u.pn * 256 + bj * 128 + cw; const int b = t0 >> 11, n = t0 & 2047;
                        *(u32x4*)(FT + ((size_t)((b * 4 + g) * 128 + mm)) * 4096 + cs * 2048 + n) = pack8(acc[ai][bj][m][0], acc[ai][bj][m][1]); }
                }
        } else if (kind == K_FOUR2) {
            bf16_t* YF = (bf16_t*)(ws + WS_YF);
            unsigned* flag = (unsigned*)(ws + WS_CNT) + (size_t)((u.pm * 16 + u.pn) * 4) * 64;
            const int lane = fq * 16 + fr, wid = wr * 4 + wc, role = u.q;
            if (role != 3) {
#pragma unroll
                for (int ai = 0; ai < 2; ++ai)
#pragma unroll
                    for (int m = 0; m < 4; ++m) { const int k = rowt + ai * 128 + m * 16;
#pragma unroll
                        for (int bj = 0; bj < 2; ++bj) { const int c = u.pn * 256 + bj * 128 + cw; const int b = c >> 9, cc = c & 511;
                            bf16_t* dstp = role == 0 ? YF + (size_t)(b * SEQ + k) * 1024 + 512 + cc : (role == 1 ? YF + (size_t)(b * SEQ + 1024 + k) * 1024 + 512 + cc : YF + (size_t)(b * SEQ + k) * 1024 + cc);
                            st16_wt(dstp, pack8(acc[ai][bj][m][0], acc[ai][bj][m][1])); } }
                asm volatile("s_waitcnt vmcnt(0)" ::: "memory");
                if (lane == 0) __hip_atomic_fetch_add(flag + 64 * role, 1u, __ATOMIC_RELAXED, __HIP_MEMORY_SCOPE_AGENT);
            } else {
                if (wid == 0) {
#pragma unroll
                    for (int f = 0; f < 3; ++f) { unsigned sp_ = 0; while ((unsigned)__builtin_amdgcn_readfirstlane(__hip_atomic_load(flag + 64 * f, __ATOMIC_RELAXED, __HIP_MEMORY_SCOPE_AGENT)) < 8u) { __builtin_amdgcn_s_sleep(2); if (++sp_ > (1u << 13)) break; } }
                    __builtin_amdgcn_fence(__ATOMIC_ACQUIRE, "agent"); asm volatile("s_waitcnt vmcnt(0)" ::: "memory"); }
                asm volatile("" ::: "memory"); __builtin_amdgcn_s_barrier(); asm volatile("" ::: "memory");
#pragma unroll
                for (int ai2 = 0; ai2 < 4; ++ai2) { const int ai = ai2 >> 1, mb = (ai2 & 1) * 2;
                    u32x4 t0[4][2], t1[4][2], t2[4][2];
#pragma unroll
                    for (int m = mb; m < mb + 2; ++m) { const int k = rowt + ai * 128 + m * 16;
#pragma unroll
                        for (int bj = 0; bj < 2; ++bj) { const int c = u.pn * 256 + bj * 128 + cw; const int b = c >> 9, cc = c & 511;
                            t0[m][bj] = __builtin_nontemporal_load((const u32x4*)(YF + (size_t)(b * SEQ + k) * 1024 + 512 + cc));
                            t1[m][bj] = __builtin_nontemporal_load((const u32x4*)(YF + (size_t)(b * SEQ + 1024 + k) * 1024 + 512 + cc));
                            t2[m][bj] = __builtin_nontemporal_load((const u32x4*)(YF + (size_t)(b * SEQ + k) * 1024 + cc)); } }
#pragma unroll
                    for (int m = mb; m < mb + 2; ++m) { const int k = rowt + ai * 128 + m * 16;
#pragma unroll
                        for (int bj = 0; bj < 2; ++bj) { const int c = u.pn * 256 + bj * 128 + cw; const int b = c >> 9, cc = c & 511;
                            f32x4 a0, a1, b0, b1, s0, s1; unpack8(t0[m][bj], a0, a1); unpack8(t1[m][bj], b0, b1); unpack8(t2[m][bj], s0, s1);
                            const f32x4 c0 = a0 + b0, c1 = a1 + b1; s0 = s0 + acc[ai][bj][m][0]; s1 = s1 + acc[ai][bj][m][1];
                            *(u32x4*)(YF + (size_t)(b * SEQ + k) * 1024 + cc) = pack8(c0 + s0, c1 + s1);
                            if (k != 0) *(u32x4*)(YF + (size_t)(b * SEQ + SEQ - k) * 1024 + cc) = pack8(c0 - s0, c1 - s1); } }
                }
            }
        } else {
            bf16_t* GA = (bf16_t*)(ws + WS_GA); const bf16_t* GF = (const bf16_t*)(ws + WS_GF);
#pragma unroll
            for (int ai = 0; ai < 2; ++ai) {
                u32x4 ra[4][2], rf[4][2];
#pragma unroll
                for (int m = 0; m < 4; ++m) { const size_t off = (size_t)(rowt + ai * 128 + m * 16) * DM + u.pn * 256 + cw;
#pragma unroll
                    for (int bj = 0; bj < 2; ++bj) { if (kind == K_BRA) { rf[m][bj] = *(const u32x4*)(GF + off + bj * 128); ra[m][bj] = __builtin_nontemporal_load((const u32x4*)(GA + off + bj * 128)); } else { rf[m][bj] = __builtin_nontemporal_load((const u32x4*)(GF + off + bj * 128)); ra[m][bj] = rf[m][bj]; } } }
#pragma unroll
                for (int m = 0; m < 4; ++m) { const size_t off = (size_t)(rowt + ai * 128 + m * 16) * DM + u.pn * 256 + cw;
#pragma unroll
                    for (int bj = 0; bj < 2; ++bj) { f32x4 g0, g1; unpack8(rf[m][bj], g0, g1);
                        if (kind == K_BRA) { f32x4 a0, a1; unpack8(ra[m][bj], a0, a1);
#pragma unroll
                            for (int e = 0; e < 4; ++e) { acc[ai][bj][m][0][e] *= a0[e] * __builtin_amdgcn_rcpf(g0[e]); acc[ai][bj][m][1][e] *= a1[e] * __builtin_amdgcn_rcpf(g1[e]); } }
                        else *(u32x4*)(GA + off + bj * 128) = pack8(g0 * acc[ai][bj][m][0], g1 * acc[ai][bj][m][1]); } }
            }
        }
    }
};

template <bool ALIGN_EPI, bool SP2, bool PERM = true>
__device__ __forceinline__ void gemm_phase(LAS unsigned char* lds, const Sched& S, const Epi& E, const int tid) {
    const int wid = __builtin_amdgcn_readfirstlane(tid >> 6), lane = tid & 63, wr = wid >> 2, wc = wid & 3, fr = lane & 15, fq = lane >> 4;
    const int K = S.K;
    unsigned voffA[2], voffB[2];
#pragma unroll
    for (int i = 0; i < 2; ++i) { int R, C; stage_rc(tid * 16 + i * 8192, R, C); const int Rb = PERM ? ((R & ~31) + perm32(R & 31)) : R;
        voffA[i] = (unsigned)(R * K + C) * 2u; voffB[i] = (unsigned)(Rb * K + C) * 2u; }
    const size_t kstep = (size_t)(BK * 2);
    const size_t hstep = (size_t)HALF * K * 2;
    const unsigned ldsw = (unsigned)wid * 1024u;
    const int aoff = lds_byte(wr * 64 + fr, fq * 8), boff = lds_byte(wc * 32 + fr, fq * 8);
#define PG8_SA(b, h) (((b) * 2 + (h)) * HTB)
#define PG8_SB(b, h) ((4 + (b) * 2 + (h)) * HTB)
#define PG8_STAGE(bufoff, gbase, voff) do { _Pragma("unroll") for (int _i = 0; _i < 2; ++_i) \
        __builtin_amdgcn_global_load_lds((const unsigned*)((const char*)(gbase) + (voff)[_i]), (LAS unsigned*)(lds + (bufoff) + ldsw + _i * 8192), 16, 0, 0); } while (0)
#define PG8_LDA(dst, b, h) do { _Pragma("unroll") for (int m = 0; m < 4; ++m) _Pragma("unroll") for (int k = 0; k < 2; ++k) dst[m][k] = *(const LAS bf16x8*)(lds + PG8_SA(b, h) + aoff + m * 2048 + k * 1024); } while (0)
#define PG8_LDB(dst, b, h) do { _Pragma("unroll") for (int n = 0; n < 2; ++n) _Pragma("unroll") for (int k = 0; k < 2; ++k) dst[n][k] = *(const LAS bf16x8*)(lds + PG8_SB(b, h) + boff + n * 2048 + k * 1024); } while (0)
#define PG8_MMA(ai, bj, At, Bt) do { __builtin_amdgcn_s_setprio(1); _Pragma("unroll") for (int m = 0; m < 4; ++m) _Pragma("unroll") for (int n = 0; n < 2; ++n) _Pragma("unroll") for (int k = 0; k < 2; ++k) \
        acc[ai][bj][m][n] = __builtin_amdgcn_mfma_f32_16x16x32_bf16(Bt[n][k], At[m][k], acc[ai][bj][m][n], 0, 0, 0); __builtin_amdgcn_s_setprio(0); } while (0)
#define PG8_WAIT_V(n) asm volatile("s_waitcnt vmcnt(" #n ")" ::: "memory")
#define PG8_WAIT_L(n) asm volatile("s_waitcnt lgkmcnt(" #n ")" ::: "memory")
#define PG8_BAR __builtin_amdgcn_s_barrier()
#define PG8_SCHED __builtin_amdgcn_sched_barrier(0)
    Unit cur, nxt; int ui = 0;
    if (!S.next(0, cur)) return;
    f32x4 acc[2][2][4][2];
#pragma unroll
    for (int a = 0; a < 2; ++a)
#pragma unroll
        for (int b = 0; b < 2; ++b)
#pragma unroll
            for (int m = 0; m < 4; ++m)
#pragma unroll
                for (int n = 0; n < 2; ++n) acc[a][b][m][n] = (f32x4){0.f, 0.f, 0.f, 0.f};
    bf16x8 At[4][2], B0[2][2], B1[2][2];
    const char* cA = S.aptr(cur); const char* cB = S.bptr(cur);
    if constexpr (SP2) {
        PG8_STAGE(PG8_SB(0, 0), cB, voffB); PG8_STAGE(PG8_SB(0, 1), cB + hstep, voffB); PG8_STAGE(PG8_SA(0, 0), cA, voffA); PG8_STAGE(PG8_SA(0, 1), cA + hstep, voffA);
        if (wr == 1) PG8_BAR;
        PG8_WAIT_V(2); PG8_BAR;
        PG8_STAGE(PG8_SB(1, 0), cB + kstep, voffB); PG8_STAGE(PG8_SA(1, 0), cA + kstep, voffA); PG8_STAGE(PG8_SB(1, 1), cB + hstep + kstep, voffB);
        PG8_WAIT_V(6); PG8_BAR;
    } else {
        PG8_STAGE(PG8_SB(0, 0), cB, voffB); PG8_STAGE(PG8_SA(0, 0), cA, voffA); PG8_STAGE(PG8_SB(0, 1), cB + hstep, voffB); PG8_STAGE(PG8_SA(0, 1), cA + hstep, voffA);
        if (wr == 1) PG8_BAR;
        PG8_WAIT_V(4); PG8_BAR;
        PG8_STAGE(PG8_SB(1, 0), cB + kstep, voffB); PG8_STAGE(PG8_SA(1, 0), cA + kstep, voffA); PG8_STAGE(PG8_SB(1, 1), cB + hstep + kstep, voffB);
        PG8_WAIT_V(6); PG8_BAR;
    }
    for (;;) {
        const bool has_next = S.next(ui + 1, nxt); const int nt = S.ktiles(cur);
        const char* nA = has_next ? S.aptr(nxt) : cA; const char* nB = has_next ? S.bptr(nxt) : cB;
        for (int t = 0; t < nt; t += 2) {
            const bool last = (t == nt - 2);
            const char* a1 = cA + (size_t)(t + 1) * kstep;
            const char* a2 = last ? nA : cA + (size_t)(t + 2) * kstep; const char* b2 = last ? nB : cB + (size_t)(t + 2) * kstep;
            const char* a3 = a2 + kstep; const char* b3 = b2 + kstep;
            if constexpr (SP2) {
            PG8_LDB(B0, 0, 0); PG8_LDB(B1, 0, 1); PG8_SCHED; PG8_LDA(At, 0, 0); PG8_STAGE(PG8_SA(1, 1), a1 + hstep, voffA);
            PG8_WAIT_V(8); PG8_WAIT_L(0); PG8_BAR; PG8_MMA(0, 0, At, B0); PG8_MMA(0, 1, At, B1); PG8_BAR; PG8_SCHED;
            PG8_LDA(At, 0, 1); PG8_STAGE(PG8_SB(0, 0), b2, voffB); PG8_STAGE(PG8_SB(0, 1), b2 + hstep, voffB); PG8_STAGE(PG8_SA(0, 0), a2, voffA);
            PG8_WAIT_V(8); PG8_WAIT_L(0); PG8_BAR; PG8_MMA(1, 0, At, B0); PG8_MMA(1, 1, At, B1); PG8_BAR; PG8_SCHED;
            PG8_LDB(B0, 1, 0); PG8_LDB(B1, 1, 1); PG8_SCHED; PG8_LDA(At, 1, 0); PG8_STAGE(PG8_SA(0, 1), a2 + hstep, voffA);
            PG8_WAIT_V(8); PG8_WAIT_L(0); PG8_BAR; PG8_MMA(0, 0, At, B0); PG8_MMA(0, 1, At, B1); PG8_BAR; PG8_SCHED;
            PG8_LDA(At, 1, 1); PG8_STAGE(PG8_SB(1, 0), b3, voffB); PG8_STAGE(PG8_SB(1, 1), b3 + hstep, voffB); PG8_STAGE(PG8_SA(1, 0), a3, voffA);
            PG8_WAIT_V(8); PG8_WAIT_L(0); PG8_BAR; PG8_MMA(1, 0, At, B0); PG8_MMA(1, 1, At, B1); PG8_BAR; PG8_SCHED;
            } else {
            PG8_LDB(B0, 0, 0); PG8_SCHED; PG8_LDA(At, 0, 0); PG8_STAGE(PG8_SA(1, 1), a1 + hstep, voffA);
            PG8_WAIT_L(8); PG8_BAR; PG8_WAIT_L(0); PG8_MMA(0, 0, At, B0); PG8_BAR; PG8_SCHED;
            PG8_LDB(B1, 0, 1); PG8_STAGE(PG8_SB(0, 0), b2, voffB);
            PG8_BAR; PG8_WAIT_L(0); PG8_MMA(0, 1, At, B1); PG8_BAR;
            PG8_LDA(At, 0, 1); PG8_STAGE(PG8_SA(0, 0), a2, voffA);
            PG8_BAR; PG8_WAIT_L(0); PG8_MMA(1, 0, At, B0); PG8_BAR; PG8_SCHED;
            PG8_STAGE(PG8_SB(0, 1), b2 + hstep, voffB);
            PG8_WAIT_V(6); PG8_BAR; PG8_MMA(1, 1, At, B1); PG8_BAR;
            PG8_LDB(B0, 1, 0); PG8_SCHED; PG8_LDA(At, 1, 0); PG8_STAGE(PG8_SA(0, 1), a2 + hstep, voffA);
            PG8_WAIT_L(8); PG8_BAR; PG8_WAIT_L(0); PG8_MMA(0, 0, At, B0); PG8_BAR; PG8_SCHED;
            PG8_LDB(B1, 1, 1); PG8_STAGE(PG8_SB(1, 0), b3, voffB);
            PG8_BAR; PG8_WAIT_L(0); PG8_MMA(0, 1, At, B1); PG8_BAR;
            PG8_LDA(At, 1, 1); PG8_STAGE(PG8_SA(1, 0), a3, voffA);
            PG8_BAR; PG8_WAIT_L(0); PG8_MMA(1, 0, At, B0); PG8_BAR; PG8_SCHED;
            PG8_STAGE(PG8_SB(1, 1), b3 + hstep, voffB);
            PG8_WAIT_V(6); PG8_BAR; PG8_MMA(1, 1, At, B1); PG8_BAR;
            }
        }
        if constexpr (ALIGN_EPI) { if (wr == 0) PG8_BAR; }
        E.template run<PERM>(acc, cur, S.kind(cur), wr, wc, fr, fq);
        if (!has_next) break;
        if (S.kind(cur) != K_BRA) {
#pragma unroll
        for (int a = 0; a < 2; ++a)
#pragma unroll
            for (int b = 0; b < 2; ++b)
#pragma unroll
                for (int m = 0; m < 4; ++m)
#pragma unroll
                    for (int n = 0; n < 2; ++n) acc[a][b][m][n] = (f32x4){0.f, 0.f, 0.f, 0.f};
        }
        cur = nxt; cA = nA; cB = nB; ++ui;
        if constexpr (ALIGN_EPI) { if (wr == 1) PG8_BAR; }
    }
    PG8_WAIT_V(0);
    if constexpr (!ALIGN_EPI) { if (wr == 0) PG8_BAR; }
    PG8_BAR;
#undef PG8_SA
#undef PG8_SB
#undef PG8_STAGE
#undef PG8_LDA
#undef PG8_LDB
#undef PG8_MMA
#undef PG8_WAIT_V
#undef PG8_WAIT_L
#undef PG8_BAR
#undef PG8_SCHED
}
}

namespace att {
using bf16 = __hip_bfloat16;
constexpr int D = 128, NW = 8, QBLK = 32, KVBLK = 64;
constexpr float SCALE = 0.088388347648318440f;
constexpr float THR = 8.f;
constexpr int LDQ = DM, LDK = 256, LDO = DM;
constexpr size_t SHM_V = KVBLK * D * 2, SHM_K = KVBLK * D * 2, SHM_ATTN = 2 * SHM_V + 2 * SHM_K + NW * 64 * 4;
#define KSWZ(row, colB) ((row) * 256 + ((colB) ^ (((row) & 7) << 4)))
#define SBAR() __builtin_amdgcn_sched_barrier(0)
__device__ __forceinline__ int crow(int r, int hi) { return (r & 3) + 8 * (r >> 2) + 4 * hi; }
__device__ __forceinline__ unsigned cvtpk(float lo, float hi) { unsigned r; asm volatile("v_cvt_pk_bf16_f32 %0, %1, %2" : "=v"(r) : "v"(lo), "v"(hi)); return r; }
__device__ __forceinline__ void partialSM(f32x16& p0, f32x16& p1, float& m_reg, float& mn, float& alpha) {
  constexpr float C = SCALE * 1.4426950408889634f;
  float pmax = p0[0];
  _Pragma("unroll") for (int r = 1; r < 16; ++r) pmax = fmaxf(pmax, p0[r]);
  _Pragma("unroll") for (int r = 0; r < 16; ++r) pmax = fmaxf(pmax, p1[r]);
  { auto rr = __builtin_amdgcn_permlane32_swap(__float_as_uint(pmax), __float_as_uint(pmax), false, false);
    pmax = fmaxf(__uint_as_float(rr[0]), __uint_as_float(rr[1])); }
  if (__builtin_expect(__all(pmax - m_reg <= THR / SCALE), 1)) { mn = m_reg; alpha = 1.f; }
  else { mn = fmaxf(m_reg, pmax); alpha = __builtin_amdgcn_exp2f((m_reg - mn) * C); m_reg = mn; }
  float mnC = -mn * C;
  _Pragma("unroll") for (int r = 0; r < 16; ++r) p0[r] = fmaf(p0[r], C, mnC);
  _Pragma("unroll") for (int r = 0; r < 16; ++r) p1[r] = fmaf(p1[r], C, mnC);
  _Pragma("unroll") for (int r = 0; r < 16; ++r) p0[r] = __builtin_amdgcn_exp2f(p0[r]);
}
__device__ __forceinline__ void finishSM(f32x16& p0, f32x16& p1, float alpha, float& l_reg, bf16x8& pa0, bf16x8& pa1, bf16x8& pa2, bf16x8& pa3) {
  _Pragma("unroll") for (int r = 0; r < 16; ++r) p1[r] = __builtin_amdgcn_exp2f(p1[r]);
  float ps = 0;
  _Pragma("unroll") for (int r = 0; r < 16; ++r) ps += p0[r];
  _Pragma("unroll") for (int r = 0; r < 16; ++r) ps += p1[r];
  { auto rr = __builtin_amdgcn_permlane32_swap(__float_as_uint(ps), __float_as_uint(ps), false, false);
    ps = __uint_as_float(rr[0]) + __uint_as_float(rr[1]); }
  l_reg = l_reg * alpha + ps;
#define PK4(P, BASE, OUT) do { unsigned a0 = cvtpk(P[BASE + 0], P[BASE + 1]), a1 = cvtpk(P[BASE + 2], P[BASE + 3]);   \
    unsigned b0 = cvtpk(P[BASE + 4], P[BASE + 5]), b1 = cvtpk(P[BASE + 6], P[BASE + 7]);                              \
    auto r0 = __builtin_amdgcn_permlane32_swap(a0, b0, false, false); auto r1 = __builtin_amdgcn_permlane32_swap(a1, b1, false, false); \
    u32x4 w = {r0[0], r1[0], r0[1], r1[1]}; OUT = *reinterpret_cast<bf16x8*>(&w); } while (0)
  PK4(p0, 0, pa0); PK4(p0, 8, pa1); PK4(p1, 0, pa2); PK4(p1, 8, pa3);
#undef PK4
}
__device__ __forceinline__ void qkt(f32x16& p0, f32x16& p1, const bf16* Ks, const bf16x8* qr, int r32, int hi) {
  p0 = f32x16{}; p1 = f32x16{};
  _Pragma("unroll") for (int d0 = 0; d0 < 8; ++d0) { int cb = (d0 * 16 + hi * 8) * 2;
    bf16x8 b0 = *reinterpret_cast<const bf16x8*>((const char*)Ks + KSWZ(r32, cb));
    bf16x8 b1 = *reinterpret_cast<const bf16x8*>((const char*)Ks + KSWZ(32 + r32, cb));
    p0 = __builtin_amdgcn_mfma_f32_32x32x16_bf16(b0, qr[d0], p0, 0, 0, 0);
    p1 = __builtin_amdgcn_mfma_f32_32x32x16_bf16(b1, qr[d0], p1, 0, 0, 0); }
}
__device__ __forceinline__ int v_st(int k, int c) { const int kk = (k & ~0xC) | ((k & 4) << 1) | ((k & 8) >> 1); return ((kk >> 3) * 4 + (c >> 5)) * 512 + ((kk & 7) * 32 + (c & 31)) * 2; }
__device__ __forceinline__ int v_rd_base(int lane) { return ((lane & 3) << 3) | (((lane >> 2) & 3) << 6) | (((lane >> 4) & 1) << 5) | (((lane >> 5) & 1) << 8); }
constexpr int v_rd_off(int d0, int ks, int half) { return d0 * 512 + ks * 4096 + half * 2048; }
template <int OFF> __device__ __forceinline__ s16x4 tr_read(int vb) {
  s16x4 r; asm volatile("ds_read_b64_tr_b16 %0, %1 offset:%2" : "=&v"(r) : "v"(vb), "i"(OFF) : "memory"); return r;
}
template <int D0> __device__ __forceinline__ void pv_one(f32x16& od, int vb, bf16x8 pa0, bf16x8 pa1, bf16x8 pa2, bf16x8 pa3) {
  const s16x4 l0 = tr_read<v_rd_off(D0, 0, 0)>(vb), h0 = tr_read<v_rd_off(D0, 0, 1)>(vb), l1 = tr_read<v_rd_off(D0, 1, 0)>(vb), h1 = tr_read<v_rd_off(D0, 1, 1)>(vb);
  const s16x4 l2 = tr_read<v_rd_off(D0, 2, 0)>(vb), h2 = tr_read<v_rd_off(D0, 2, 1)>(vb), l3 = tr_read<v_rd_off(D0, 3, 0)>(vb), h3 = tr_read<v_rd_off(D0, 3, 1)>(vb);
  asm volatile("s_waitcnt lgkmcnt(0)" ::: "memory"); SBAR();
#define PK(L, H) (bf16x8){L[0], L[1], L[2], L[3], H[0], H[1], H[2], H[3]}
  od = __builtin_amdgcn_mfma_f32_32x32x16_bf16(pa0, PK(l0, h0), od, 0, 0, 0);
  od = __builtin_amdgcn_mfma_f32_32x32x16_bf16(pa1, PK(l1, h1), od, 0, 0, 0);
  od = __builtin_amdgcn_mfma_f32_32x32x16_bf16(pa2, PK(l2, h2), od, 0, 0, 0);
  od = __builtin_amdgcn_mfma_f32_32x32x16_bf16(pa3, PK(l3, h3), od, 0, 0, 0);
#undef PK
}
__device__ __forceinline__ void pv_d0(f32x16* o, int vb, bf16x8 pa0, bf16x8 pa1, bf16x8 pa2, bf16x8 pa3) {
  pv_one<0>(o[0], vb, pa0, pa1, pa2, pa3); pv_one<1>(o[1], vb, pa0, pa1, pa2, pa3); pv_one<2>(o[2], vb, pa0, pa1, pa2, pa3); pv_one<3>(o[3], vb, pa0, pa1, pa2, pa3);
}
__device__ __forceinline__ void attn_unit(const bf16* Qb, const bf16* __restrict__ Kh, const bf16* __restrict__ Vh, bf16* Ob, int seq, char* lds, const int tid,
                                          const float* __restrict__ qg, const float* __restrict__ ropetab, int n0) {
  const int wid = __builtin_amdgcn_readfirstlane(tid >> 6), lane = tid & 63, r32 = lane & 31, hi = lane >> 5;
  bf16* V_lds = (bf16*)lds; bf16* K_lds = (bf16*)(lds + 2 * SHM_V);
  float* ws = (float*)(lds + 2 * SHM_V + 2 * SHM_K) + wid * 64; float* li_l = ws; float* al_l = ws + 32;
  bf16x8 qr[8];
  const bf16* Qw = Qb + (long)(wid * QBLK + r32) * LDQ + hi * 8;
#pragma unroll
  for (int d0 = 0; d0 < 8; ++d0) qr[d0] = *reinterpret_cast<const bf16x8*>(Qw + d0 * 16);
#ifndef NO_QFIX
  {
    float qf[8][8]; float ss = 0.f;
#pragma unroll
    for (int d0 = 0; d0 < 8; ++d0)
#pragma unroll
      for (int e = 0; e < 8; ++e) { const float v = __uint_as_float(((unsigned)(unsigned short)qr[d0][e]) << 16); qf[d0][e] = v; ss += v * v; }
    { auto rr = __builtin_amdgcn_permlane32_swap(__float_as_uint(ss), __float_as_uint(ss), false, false); ss = __uint_as_float(rr[0]) + __uint_as_float(rr[1]); }
    const float rstd = 1.0f / sqrtf(ss * (1.0f / 128.0f) + EPS);
    const int n = n0 + wid * QBLK + r32;
#pragma unroll
    for (int d0 = 0; d0 < 8; ++d0) { const f32x4 g0 = *(const f32x4*)(qg + d0 * 16 + hi * 8), g1 = *(const f32x4*)(qg + d0 * 16 + hi * 8 + 4);
#pragma unroll
      for (int e = 0; e < 4; ++e) { qf[d0][e] *= rstd * g0[e]; qf[d0][4 + e] *= rstd * g1[e]; } }
#pragma unroll
    for (int d0 = 0; d0 < 4; ++d0) { const int pos = d0 < 2 ? (n >> 6) : (n & 63); const float* rp = ropetab + 2 * (pos * 32 + (d0 & 1) * 16 + hi * 8);
#pragma unroll
      for (int e = 0; e < 8; e += 2) { const f32x4 cs = *(const f32x4*)(rp + 2 * e);
        { const float t1 = qf[d0][e], t2 = qf[d0 + 4][e]; qf[d0][e] = t1 * cs[0] - t2 * cs[1]; qf[d0 + 4][e] = t2 * cs[0] + t1 * cs[1]; }
        { const float t1 = qf[d0][e + 1], t2 = qf[d0 + 4][e + 1]; qf[d0][e + 1] = t1 * cs[2] - t2 * cs[3]; qf[d0 + 4][e + 1] = t2 * cs[2] + t1 * cs[3]; } } }
#pragma unroll
    for (int d0 = 0; d0 < 8; ++d0) { u32x4 w = {cvtpk(qf[d0][0], qf[d0][1]), cvtpk(qf[d0][2], qf[d0][3]), cvtpk(qf[d0][4], qf[d0][5]), cvtpk(qf[d0][6], qf[d0][7])}; qr[d0] = *reinterpret_cast<bf16x8*>(&w); }
  }
#endif
  float m_reg = -1e30f, l_reg = 0; f32x16 o[4] = {};
  const int sr = tid >> 4, sc = (tid & 15) * 8, vst0 = v_st(sr, sc), vst1 = v_st(32 + sr, sc);
  const int vb0 = (int)(uintptr_t)V_lds + v_rd_base(lane);
  bf16x8 sr_0vs0, sr_0vs1, sr_0ks0, sr_0ks1, sr_1vs0, sr_1vs1, sr_1ks0, sr_1ks1;
#define LD8(p) (*reinterpret_cast<const bf16x8*>(p))
#define SLOAD(i, k0) do { sr_##i##vs0 = LD8(&Vh[(long)((k0) + sr) * LDK + sc]); sr_##i##vs1 = LD8(&Vh[(long)((k0) + 32 + sr) * LDK + sc]); \
    sr_##i##ks0 = LD8(&Kh[(long)((k0) + sr) * LDK + sc]); sr_##i##ks1 = LD8(&Kh[(long)((k0) + 32 + sr) * LDK + sc]); } while (0)
#define SWRITE(b, i) do { *(bf16x8*)((char*)V_lds + (b) * SHM_V + vst0) = sr_##i##vs0;          \
    *(bf16x8*)((char*)V_lds + (b) * SHM_V + vst1) = sr_##i##vs1; int kc = sc * 2;               \
    *(bf16x8*)((char*)K_lds + (b) * SHM_K + KSWZ(sr, kc)) = sr_##i##ks0;                       \
    *(bf16x8*)((char*)K_lds + (b) * SHM_K + KSWZ(32 + sr, kc)) = sr_##i##ks1; } while (0)
#define SWAIT() asm volatile("s_waitcnt vmcnt(4)" ::: "memory")
#define RESC(a) do { if (__any((a) < 1.f)) { if (hi == 0) al_l[r32] = (a); asm volatile("s_waitcnt lgkmcnt(0)" ::: "memory"); \
    _Pragma("unroll") for (int d = 0; d < 4; ++d) _Pragma("unroll") for (int r = 0; r < 16; ++r) o[d][r] *= al_l[crow(r, hi)]; } } while (0)
  f32x16 pA0, pA1, pB0, pB1; float mnA, mnB, alA, alB; bf16x8 pa0, pa1, pa2, pa3; const int NT = seq / KVBLK;
  SLOAD(0, 0); asm volatile("s_waitcnt vmcnt(0)" ::: "memory"); SWRITE(0, 0); __syncthreads();
  qkt(pA0, pA1, K_lds, qr, r32, hi); partialSM(pA0, pA1, m_reg, mnA, alA);
  SLOAD(1, KVBLK); if (2 < NT) SLOAD(0, 2 * KVBLK);
  SWAIT(); SWRITE(1, 1); __syncthreads();
  for (int j = 1; j + 1 < NT; j += 2) {
    SBAR(); qkt(pB0, pB1, (bf16*)((char*)K_lds + SHM_K), qr, r32, hi);
    finishSM(pA0, pA1, alA, l_reg, pa0, pa1, pa2, pa3); SBAR();
    SLOAD(1, (j + 2) * KVBLK); SBAR();
    pv_d0(o, vb0, pa0, pa1, pa2, pa3); partialSM(pB0, pB1, m_reg, mnB, alB);
    __syncthreads(); SWAIT(); SWRITE(0, 0);
    RESC(alB); __syncthreads();
    SBAR(); qkt(pA0, pA1, K_lds, qr, r32, hi);
    finishSM(pB0, pB1, alB, l_reg, pa0, pa1, pa2, pa3); SBAR();
    if (j + 3 < NT) SLOAD(0, (j + 3) * KVBLK); SBAR();
    pv_d0(o, vb0 + (int)SHM_V, pa0, pa1, pa2, pa3); partialSM(pA0, pA1, m_reg, mnA, alA);
    __syncthreads(); SWAIT(); SWRITE(1, 1);
    RESC(alA); __syncthreads();
  }
  SBAR(); qkt(pB0, pB1, (bf16*)((char*)K_lds + SHM_K), qr, r32, hi);
  finishSM(pA0, pA1, alA, l_reg, pa0, pa1, pa2, pa3); SBAR();
  pv_d0(o, vb0, pa0, pa1, pa2, pa3); partialSM(pB0, pB1, m_reg, mnB, alB);
  __syncthreads(); RESC(alB);
  finishSM(pB0, pB1, alB, l_reg, pa0, pa1, pa2, pa3); SBAR();
  pv_d0(o, vb0 + (int)SHM_V, pa0, pa1, pa2, pa3);
  if (hi == 0) li_l[r32] = l_reg; asm volatile("s_waitcnt lgkmcnt(0)" ::: "memory");
  float rli[16];
#pragma unroll
  for (int r = 0; r < 16; ++r) rli[r] = __builtin_amdgcn_rcpf(li_l[crow(r, hi)]);
  int l2 = __builtin_amdgcn_mbcnt_hi(~0u, __builtin_amdgcn_mbcnt_lo(~0u, 0u)); asm volatile("" : "+v"(l2));
  const int r32b = l2 & 31, hib = l2 >> 5;
  bf16* Ow = Ob + (long)(wid * QBLK) * LDO;
#pragma unroll
  for (int r = 0; r < 16; ++r) { int orow = crow(r, hib);
    _Pragma("unroll") for (int d0 = 0; d0 < 4; ++d0) Ow[(long)orow * LDO + d0 * 32 + r32b] = __float2bfloat16(o[d0][r] * rli[r]); }
  __syncthreads();
#undef LD8
#undef SLOAD
#undef SWRITE
#undef SWAIT
#undef RESC
}
#undef SBAR
}

#define XB_TMO      128
#define XB_XCNT(j)  (256  + 64 * (j))
#define XB_XSUB(j)  (1280 + 64 * (j))
#define XB_XGEN(j)  (2304 + 64 * (j))
#define XB_TOP      3328
#define XB_TOPGEN   3392
#define XCD_BAR_WORDS 3456
#define XB_SPIN_CAP (1u << 18)
__device__ __forceinline__ unsigned xb_ld(unsigned* p)              { return __hip_atomic_load(p, __ATOMIC_RELAXED, __HIP_MEMORY_SCOPE_AGENT); }
__device__ __forceinline__ unsigned xb_add(unsigned* p, unsigned v) { return __hip_atomic_fetch_add(p, v, __ATOMIC_RELAXED, __HIP_MEMORY_SCOPE_AGENT); }
__device__ __forceinline__ unsigned xb_xcc_id() { return (unsigned)__builtin_amdgcn_s_getreg((3 << 11) | 20) & 0xFu; }
#define XB_SPIN(cond, bar) do { unsigned _sp = 0; while (cond) { __builtin_amdgcn_s_sleep(1); \
    if ((++_sp & 255u) == 0u) { if (xb_ld(&(bar)[XB_TMO])) break; if (_sp > XB_SPIN_CAP) { atomicAdd(&(bar)[XB_TMO], 1u); break; } } } } while (0)
struct XcdBarrier { unsigned* bar; unsigned x; volatile LAS unsigned* st; };
__device__ __forceinline__ XcdBarrier xcd_barrier_post(unsigned* bar, volatile LAS unsigned* st) {
    XcdBarrier b; b.bar = bar; b.x = xb_xcc_id(); b.st = st;
    if (threadIdx.x == 0) (void)xb_add(&bar[XB_XCNT(b.x)], 1u);
    return b;
}
__device__ __forceinline__ void xcd_barrier_complete(unsigned* bar, unsigned x, unsigned& nloc, unsigned& nx) {
    const unsigned G = gridDim.x * gridDim.y * gridDim.z;
    unsigned sum, cnt, mine, sp = 0u;
    for (;;) {
        sum = 0u; cnt = 0u; mine = 0u;
#pragma unroll
        for (unsigned j = 0; j < 16; ++j) { const unsigned c = xb_ld(&bar[XB_XCNT(j)]); sum += c; cnt += (c > 0u) ? 1u : 0u; mine = (j == x) ? c : mine; }
        if (sum == G) break;
        __builtin_amdgcn_s_sleep(1);
        if ((++sp & 255u) == 0u) { if (xb_ld(&bar[XB_TMO])) break; if (sp > XB_SPIN_CAP) { atomicAdd(&bar[XB_TMO], 1u); break; } }
    }
    nloc = mine > 0u ? mine : 1u; nx = cnt > 0u ? cnt : 1u;
}
__device__ __forceinline__ void xcd_barrier(const XcdBarrier& b) {
    asm volatile("s_waitcnt vmcnt(0)" ::: "memory");
    __syncthreads();
    if (threadIdx.x == 0) {
        unsigned* bar = b.bar;
        __builtin_amdgcn_s_waitcnt(0);
        unsigned nloc = b.st[0], nx = b.st[1];
        if (nloc == 0u) { xcd_barrier_complete(bar, b.x, nloc, nx); b.st[0] = nloc; b.st[1] = nx; }
        const unsigned old = xb_add(&bar[XB_XSUB(b.x)], 1u);
        const unsigned gen = old / nloc;
        if (old + 1u == (gen + 1u) * nloc) {
            __builtin_amdgcn_fence(__ATOMIC_RELEASE, "agent");
            asm volatile("s_waitcnt vmcnt(0)" ::: "memory");
            const unsigned og = xb_add(&bar[XB_TOP], 1u);
            const unsigned tg = og / nx;
            if (og + 1u == (tg + 1u) * nx) xb_add(&bar[XB_TOPGEN], 1u);
            else XB_SPIN(xb_ld(&bar[XB_TOPGEN]) == tg, bar);
            __builtin_amdgcn_fence(__ATOMIC_ACQUIRE, "agent");
            xb_add(&bar[XB_XGEN(b.x)], 1u);
            asm volatile("s_waitcnt vmcnt(0)" ::: "memory");
        } else {
            XB_SPIN(xb_ld(&bar[XB_XGEN(b.x)]) == gen, bar);
            __builtin_amdgcn_fence(__ATOMIC_ACQUIRE, "agent");
            asm volatile("s_waitcnt vmcnt(0)" ::: "memory");
        }
    }
    __syncthreads();
}

struct Params {
    const float *x, *c, *ctx, *c_ctx, *w_ada, *b_ada, *norm_ffn1, *w_ffn1_in, *w_ffn1_out, *norm_mix, *w_in, *q_norm, *k_norm, *w_ab, *w_fb, *w_out, *norm_ffn2, *w_ffn2_in, *w_ffn2_out;
    float* out; unsigned char* ws; int st_lo, st_hi;
};

__device__ __forceinline__ void transpose_item(const float* __restrict__ W, int K, int N, bf16_t* __restrict__ WT, int kb, int n0, int drow0, int lane, int ldd = 0) {
    if (ldd == 0) ldd = K;
    const int ng = lane & 15, kq = lane >> 4, k0 = 32 * kb + 8 * kq;
    const float* src = W + (size_t)k0 * N + n0 + 4 * ng;
    f32x4 v[8];
#pragma unroll
    for (int i = 0; i < 8; ++i) v[i] = __builtin_nontemporal_load((const f32x4*)(src + (size_t)i * N));
    bf16_t* dst = WT + (size_t)(drow0 + 4 * ng) * ldd + k0;
#pragma unroll
    for (int j = 0; j < 4; ++j) { u32x4 o; o.x = cvt_pk_bf16(v[0][j], v[1][j]); o.y = cvt_pk_bf16(v[2][j], v[3][j]); o.z = cvt_pk_bf16(v[4][j], v[5][j]); o.w = cvt_pk_bf16(v[6][j], v[7][j]);
        *(u32x4*)(dst + (size_t)j * ldd) = o; }
}

__device__ __forceinline__ void prep_phase(const Params& kp_, LAS unsigned char* lds, int tid, int lane, int wave, int G) {
    const Params* kp = &kp_; unsigned char* ws = kp->ws;
    LAS float* tab2048 = (LAS float*)(lds + LDS_MISC);
    LAS float* tab128 = (LAS float*)(lds + LDS_MISC + 8192);
    if (blockIdx.x < 144) {
        LAS float* s_l = (LAS float*)lds;
        LAS float* red = (LAS float*)(lds + 36864);
        for (int i = tid; i < 9216; i += 512) { const int r = i >> 10, k = i & 1023; const float v = (r < 8) ? kp->c[r * 1024 + k] : kp->c_ctx[k]; s_l[i] = v / (1.f + expf(-v)); }
        __syncthreads();
        const int c0 = blockIdx.x * 64, kr = lane >> 4, cgp = lane & 15;
        f32x4 a0 = {}, a1 = {}, a2 = {}, a3 = {}, a4 = {}, a5 = {}, a6 = {}, a7 = {}, a8 = {};
        const float* wp = kp->w_ada + (size_t)(wave * 128 + kr) * NMOD + c0 + 4 * cgp;
#pragma unroll 8
        for (int i = 0; i < 32; ++i) { const f32x4 w = __builtin_nontemporal_load((const f32x4*)(wp + (size_t)i * 4 * NMOD)); const int k = wave * 128 + 4 * i + kr;
            a0 += w * s_l[k]; a1 += w * s_l[1024 + k]; a2 += w * s_l[2048 + k]; a3 += w * s_l[3072 + k]; a4 += w * s_l[4096 + k];
            a5 += w * s_l[5120 + k]; a6 += w * s_l[6144 + k]; a7 += w * s_l[7168 + k]; a8 += w * s_l[8192 + k]; }
#define RED9(a, r) do { _Pragma("unroll") for (int e = 0; e < 4; ++e) { float v = a[e]; v += __shfl_xor(v, 16); v += __shfl_xor(v, 32); if (lane < 16) red[(wave * 9 + r) * 64 + 4 * cgp + e] = v; } } while (0)
        RED9(a0, 0); RED9(a1, 1); RED9(a2, 2); RED9(a3, 3); RED9(a4, 4); RED9(a5, 5); RED9(a6, 6); RED9(a7, 7); RED9(a8, 8);
#undef RED9
        __syncthreads();
        float* mod = (float*)(ws + WS_MOD);
        for (int i = tid; i < 576; i += 512) { const int r = i >> 6, col = i & 63; float s = 0.f;
#pragma unroll
            for (int w = 0; w < 8; ++w) s += red[(w * 9 + r) * 64 + col];
            mod[r * NMOD + c0 + col] = s + kp->b_ada[c0 + col]; }
    }
    __syncthreads();
    const int gw = blockIdx.x * 8 + wave, NGW = G * 8;
    if (blockIdx.x == G - 1) {
        float* rt = (float*)(ws + WS_ROPE);
        for (int i = tid; i < 2048; i += 512) { const int pos = i >> 5, j = i & 31; const float invf = powf(10000.0f, -(float)(2 * j) / 64.0f); const float ang = (float)pos * invf;
            rt[2 * i] = cosf(ang); rt[2 * i + 1] = sinf(ang); }
    }
    constexpr int I_1IN = 32 * 88;
    for (int r = (gw + 1152) % NGW; r < I_1IN; r += NGW) { const int kb = r / 88, n0 = (r % 88) * 64; const int isup = n0 >= DFF, j = isup ? n0 - DFF : n0;
        transpose_item(kp->w_ffn1_in, 1024, 2 * DFF, (bf16_t*)(ws + WS_W1IN), kb, n0, 256 * (j >> 7) + (j & 127) + 128 * isup, lane); }
}

__device__ __forceinline__ void late_weights(const Params& kp_, LAS unsigned char* lds, int tid, int lane, int widx, int nw) {
    const Params* kp = &kp_; unsigned char* ws = kp->ws;
    LAS float* tab2048 = (LAS float*)(lds + LDS_MISC);
    LAS float* tab128 = (LAS float*)(lds + LDS_MISC + 8192);
    for (int i = tid; i < 2048; i += 512) tab2048[i] = cospif((float)i * (1.0f / 1024.0f));
    if (tid < 128) tab128[tid] = cospif((float)tid * (1.0f / 64.0f));
    __syncthreads();
    constexpr int I_FOLD = 1024, I_IN = 32 * 64, I_AB = 32 * 16, I_FB = 16 * 16, I_O = 32 * 16, I_1OUT = 88 * 16;
    for (int r = widx; r < I_1OUT; r += nw) { const int kb = r >> 4, n0 = (r & 15) * 64; transpose_item(kp->w_ffn1_out, DFF, 1024, (bf16_t*)(ws + WS_W1OUT), kb, n0, n0, lane); }
    {
        bf16_t* dft = (bf16_t*)(ws + WS_DFT);
        for (int e8 = widx * 64 + lane; e8 < 2048 * 512; e8 += nw * 64) {
            const int k = e8 >> 9, kp0 = (e8 & 511) * 8, cs = kp0 >> 11, n0 = kp0 & 2047; float v[8];
#pragma unroll
            for (int e = 0; e < 8; ++e) { int idx = (k * (n0 + e)) & 2047; if (cs) idx = (idx + 512) & 2047; v[e] = tab2048[idx] * (1.0f / 512.0f); }
            u32x4 o; o.x = cvt_pk_bf16(v[0], v[1]); o.y = cvt_pk_bf16(v[2], v[3]); o.z = cvt_pk_bf16(v[4], v[5]); o.w = cvt_pk_bf16(v[6], v[7]);
            *(u32x4*)(dft + (size_t)e8 * 8) = o;
        }
    }
    for (int r = widx; r < I_FOLD; r += nw) {
        const int jt = r & 7, g = (r >> 3) & 3, kb = r >> 5, k0 = kb * 32;
        const int jj = jt * 32 + (lane & 31), cs = jj >> 7, m = jj & 127, hi = lane >> 5;
        const float* wrow = kp->w_in + (size_t)(k0 + (lane & 31)) * 4096 + 1536 + g * 128 + hi;
        f32x16 acc = {};
#pragma unroll 8
        for (int s2 = 0; s2 < 64; ++s2) { const int c = 2 * s2 + hi; const float a = wrow[2 * s2]; int idx = (c * m) & 127; if (cs) idx = (idx + 96) & 127;
            acc = __builtin_amdgcn_mfma_f32_32x32x2f32(a, tab128[idx], acc, 0, 0, 0); }
        bf16_t* WfT = (bf16_t*)(ws + WS_WF) + (size_t)(cs * 512 + g * 128 + m) * 1024 + k0 + 4 * hi;
#pragma unroll
        for (int q = 0; q < 4; ++q) { u32x2 o; o.x = cvt_pk_bf16(acc[4 * q], acc[4 * q + 1]); o.y = cvt_pk_bf16(acc[4 * q + 2], acc[4 * q + 3]); *(u32x2*)(WfT + 8 * q) = o; }
    }
    for (int r = widx; r < I_IN; r += nw) { const int kb = r >> 6, n0 = (r & 63) * 64; if (n0 < 1536 || n0 >= 2048) transpose_item(kp->w_in, 1024, 4096, (bf16_t*)(ws + WS_WIN), kb, n0, n0 < 1536 ? n0 : n0 - 512, lane); }
    for (int r = widx; r < I_AB; r += nw) { const int kb = r >> 4, n0 = (r & 15) * 64; transpose_item(kp->w_ab, 1024, 1024, (bf16_t*)(ws + WS_WAB), kb, n0, n0, lane); }
    for (int r = widx; r < I_O; r += nw) { const int kb = r >> 4, n0 = (r & 15) * 64; transpose_item(kp->w_out, 1024, 1024, (bf16_t*)(ws + WS_WO), kb, n0, n0, lane); }
}

template <bool LAT_BF> __device__ __forceinline__ void norm_phase(const float* lat, const float* ctxp, const float* ctxp2, int nrows, const float* gain, const float* mod, int sh_off, int sc_off, bf16_t* A, int gw, int NGW, int lane) {
    for (int r = gw; r < nrows; r += NGW) {
        const bool isctx = r >= NLAT; const float* src = isctx ? ctxp + (size_t)(r - NLAT) * DM : lat + (size_t)r * DM; const int mrow = isctx ? 8 : (r >> 11);
        f32x4 v[4]; float ss = 0.f;
#pragma unroll
        for (int j = 0; j < 4; ++j) { if (LAT_BF && !isctx) { const u32x2 w = __builtin_nontemporal_load((const u32x2*)((const bf16_t*)lat + (size_t)r * DM + 4 * lane + 256 * j)); v[j] = (f32x4){__uint_as_float(w.x << 16), __uint_as_float(w.x & 0xffff0000u), __uint_as_float(w.y << 16), __uint_as_float(w.y & 0xffff0000u)}; } else v[j] = __builtin_nontemporal_load((const f32x4*)(src + 4 * lane + 256 * j)); if (isctx && ctxp2) v[j] += *(const f32x4*)(ctxp2 + (size_t)(r - NLAT) * DM + 4 * lane + 256 * j); ss += (v[j][0] * v[j][0] + v[j][1] * v[j][1]) + (v[j][2] * v[j][2] + v[j][3] * v[j][3]); }
        const float rstd = 1.0f / sqrtf(wave_sum(ss) * (1.0f / DM) + EPS);
        const float* mp = mod + mrow * NMOD;
#pragma unroll
        for (int j = 0; j < 4; ++j) { const int c = 4 * lane + 256 * j; const f32x4 g = *(const f32x4*)(gain + c), sh = *(const f32x4*)(mp + sh_off + c), sc = *(const f32x4*)(mp + sc_off + c);
            const f32x4 o = (v[j] * rstd) * g * (sc + 1.0f) + sh; u32x2 w; w.x = cvt_pk_bf16(o[0], o[1]); w.y = cvt_pk_bf16(o[2], o[3]);
            *(u32x2*)(A + (size_t)r * DM + c) = w; }
    }
}

__device__ __forceinline__ void fix_head(bf16_t* hp, const float* g, const float* ropetab, int n, bool rope, int lane) {
    float t1 = bf2f(hp[lane]), t2 = bf2f(hp[lane + 64]);
    const float rstd = 1.0f / sqrtf(wave_sum(t1 * t1 + t2 * t2) * (1.0f / 128.0f) + EPS);
    t1 = t1 * rstd * g[lane]; t2 = t2 * rstd * g[lane + 64];
    float o1 = t1, o2 = t2;
    if (rope) { const int pos = lane < 32 ? (n >> 6) : (n & 63); const float c = ropetab[2 * (pos * 32 + (lane & 31))], s = ropetab[2 * (pos * 32 + (lane & 31)) + 1]; o1 = t1 * c - t2 * s; o2 = t2 * c + t1 * s; }
    hp[lane] = f2bf(o1); hp[lane + 64] = f2bf(o2);
}
__device__ __forceinline__ void fixup_phase(unsigned char* ws, const float* q_norm, const float* k_norm, int gw, int NGW, int lane) {
    bf16_t* Q = (bf16_t*)(ws + WS_Q); bf16_t* Kb = (bf16_t*)(ws + WS_K); const float* rt = (const float*)(ws + WS_ROPE);
    for (int r = gw; r < NTOK; r += NGW) {
        if (r < NLAT) { const int b = r >> 11, n = r & 2047;
            for (int h = 0; h < 8; ++h) fix_head(Q + (size_t)r * DM + h * 128, q_norm, rt, n, true, lane);
            for (int h = 0; h < 2; ++h) fix_head(Kb + (size_t)(b * SKV + CTXL + n) * 256 + h * 128, k_norm, rt, n, true, lane);
        } else { const int rc = r - NLAT, b = rc >> 8, n = rc & 255;
            for (int h = 0; h < 2; ++h) fix_head(Kb + (size_t)(b * SKV + n) * 256 + h * 128, k_norm, rt, 0, false, lane); }
    }
}

constexpr int NSTEPS = 15;
__host__ __device__ constexpr bool sync_after(int st) { return !(st == 7 || st == 9); }

__global__ void __launch_bounds__(512, 2) mk_fwd(Params p) {
    extern __shared__ __attribute__((aligned(16))) unsigned char lds_raw[];
    LAS unsigned char* lds = (LAS unsigned char*)lds_raw;
    const int G = gridDim.x, c = blockIdx.x, NGW = G * 8;
    const int lo = p.st_lo, hi = p.st_hi;
    unsigned char* const ws = p.ws;
    const float* const mod = (const float*)(ws + WS_MOD);
    bf16_t* const Abuf = (bf16_t*)(ws + WS_A);
#define IN(k) (lo <= (k) && (k) < hi)
    volatile LAS unsigned* bst = (volatile LAS unsigned*)(lds + LDS_MISC + 12288);
    if (threadIdx.x < 2) bst[threadIdx.x] = 0u;
    __syncthreads();
    XcdBarrier gbar; gbar.bar = (unsigned*)(ws + WS_BAR); gbar.x = 0; gbar.st = bst;
    if (hi - lo > 1) gbar = xcd_barrier_post((unsigned*)(ws + WS_BAR), bst);
    if (hi < 0) cg::this_grid().sync();
#define SEAM(k) do { if (IN(k) && IN((k) + 1)) { if (sync_after(k)) xcd_barrier(gbar); else { __syncthreads(); } } } while (0)
#define TIDS() int tid = threadIdx.x; asm volatile("" : "+v"(tid)); const int lane = tid & 63, wave = __builtin_amdgcn_readfirstlane(tid >> 6), gw = c * 8 + wave; (void)lane; (void)gw
#define GEMM1P(PRM, KK, a, b, nm, nn, kd, rm) do { const pg8::Sched S{(a), nullptr, nullptr, (b), nullptr, nullptr, (nm), 1, 1, (nn), 1, 1, (kd), (kd), (kd), (nm) * (nn), 0, 0, G, c, (KK), 0, (KK) / 64, (KK) / 64, (KK) / 64, 0, 0}; \
        const pg8::Epi E{ws, p.out, p.x, p.ctx, (rm), p.k_norm, p.norm_ffn2, (const LAS float*)(lds + LDS_MISC)}; pg8::gemm_phase<true, true, PRM>(lds, S, E, tid); } while (0)
#define GEMM1(KK, a, b, nm, nn, kd, rm) GEMM1P(true, KK, a, b, nm, nn, kd, rm)
    if (IN(0)) { TIDS(); prep_phase(p, lds, tid, lane, wave, G); }
    SEAM(0);
    if (IN(1)) { TIDS(); norm_phase<false>(p.x, p.ctx, nullptr, NTOK, p.norm_ffn1, mod, 0 * DM, 1 * DM, Abuf, gw, NGW, lane); }
    SEAM(1);
    if (IN(2)) { TIDS(); GEMM1(1024, Abuf, (const bf16_t*)(ws + WS_W1IN), NTOK / 256, 22, pg8::K_SWIGLU, 0);
        constexpr int NBUSY = (NTOK / 256) * 22 - 6 * 256;
        int t2 = threadIdx.x; asm volatile("" : "+v"(t2)); const int w2 = __builtin_amdgcn_readfirstlane(t2 >> 6);
        if (G == 256 && c >= NBUSY) late_weights(p, lds, t2, t2 & 63, (c - NBUSY) * 8 + w2, (256 - NBUSY) * 8);
        else if (G != 256) late_weights(p, lds, t2, t2 & 63, c * 8 + w2, NGW); }
    SEAM(2);
    if (IN(3)) { TIDS();
        const bf16_t* Hc = (const bf16_t*)(ws + WS_H) + (size_t)NLAT * DFF;
        const pg8::Sched S{(const bf16_t*)(ws + WS_H), Hc, Hc, (const bf16_t*)(ws + WS_W1OUT), (const bf16_t*)(ws + WS_W1OUT), (const bf16_t*)(ws + WS_W1OUT),
                           64, 8, 8, 4, 4, 4, pg8::K_RES, pg8::K_RESC0, pg8::K_RESC1, 256, 32, 32, G, c, DFF, 0, 44, 22, 22, 0, DFF / 2};
        const pg8::Epi E{ws, p.out, p.x, p.ctx, 0, p.k_norm, p.norm_ffn2, (const LAS float*)(lds + LDS_MISC)}; pg8::gemm_phase<true, true>(lds, S, E, tid); }
    SEAM(3);
    if (IN(4)) { TIDS(); norm_phase<true>(p.out, (const float*)(ws + WS_CTX1), (const float*)(ws + WS_CTX1B), NTOK, p.norm_mix, mod, 3 * DM, 4 * DM, Abuf, gw, NGW, lane); }
    SEAM(4);
    if (IN(5)) { TIDS();
        const pg8::Sched S{Abuf, (const bf16_t*)(ws + WS_WF), Abuf + (size_t)NLAT * DM, (const bf16_t*)(ws + WS_WIN), Abuf, (const bf16_t*)(ws + WS_WIN) + (size_t)1024 * DM,
                           64, 4, 8, 14, 64, 2, pg8::K_INPROJ, pg8::K_FTSWAP, pg8::K_CTXKV, 64 * 14, 256, 16, G, c, 1024, 0, 16, 16, 16, 0, 0};
        const pg8::Epi E{ws, p.out, p.x, p.ctx, 0, p.k_norm, p.norm_ffn2, (const LAS float*)(lds + LDS_MISC)}; pg8::gemm_phase<true, true>(lds, S, E, tid);
        if (G == 256 && c >= 144) {
            int t2 = threadIdx.x; asm volatile("" : "+v"(t2)); const int lane = t2 & 63;
            const int w2 = (c - 144) * 8 + __builtin_amdgcn_readfirstlane(t2 >> 6), nw2 = 112 * 8;
            for (int r = w2; r < 32 * 88; r += nw2) { const int kb = r / 88, n0 = (r % 88) * 64; const int isup = n0 >= DFF, j = isup ? n0 - DFF : n0;
                transpose_item(p.w_ffn2_in, 1024, 2 * DFF, (bf16_t*)(ws + WS_W2IN), kb, n0, 256 * (j >> 7) + (j & 127) + 128 * isup, lane); }
            for (int r = w2; r < 88 * 16; r += nw2) { const int kb = r >> 4, n0 = (r & 15) * 64; transpose_item(p.w_ffn2_out, DFF, 1024, (bf16_t*)(ws + WS_W2OUT), kb, n0, n0, lane); }
            for (int r = w2; r < 2 * 16 * 16; r += nw2) { const int hf = r >> 8, q = r & 255, kb = q >> 4, n0 = (q & 15) * 64;
                transpose_item(p.w_fb, 512, 1024, (bf16_t*)(ws + WS_WFB2) + hf * 512, kb, n0, n0, lane, 1024); }
        } }
    if (IN(5) && IN(7)) xcd_barrier(gbar);
    if (IN(7)) { TIDS();
        const pg8::Sched S{(const bf16_t*)(ws + WS_DFT), nullptr, nullptr, (const bf16_t*)(ws + WS_FT), nullptr, nullptr, 4, 1, 1, 16, 1, 1, pg8::K_FOUR2, pg8::K_FOUR2, pg8::K_FOUR2, 256, 0, 0, G, c, 4096, 1, 16, 16, 16, 0, 0};
        const pg8::Epi E{ws, p.out, p.x, p.ctx, 0, p.k_norm, p.norm_ffn2, (const LAS float*)(lds + LDS_MISC)}; pg8::gemm_phase<true, true>(lds, S, E, tid);
        if (c < 192) {
        {
            const bf16_t* FTp = (const bf16_t*)(ws + WS_FT); bf16_t* YFp = (bf16_t*)(ws + WS_YF);
            for (int j = gw; j < 4096; j += 192 * 8) { const bf16_t* src = FTp + (size_t)j * 4096 + 32 * lane; float acc_ = 0.f;
#pragma unroll
                for (int q4 = 0; q4 < 4; ++q4) { f32x4 a0, a1; unpack8(*(const u32x4*)(src + 8 * q4), a0, a1); acc_ += (a0[0] - a0[1]) + (a0[2] - a0[3]) + (a1[0] - a1[1]) + (a1[2] - a1[3]); }
                const float tot = wave_sum(acc_) * (1.0f / 512.0f);
                if (lane == 0) YFp[(size_t)((j >> 9) * SEQ + 1024) * 1024 + (j & 511)] = f2bf(tot); }
        }
        {
            int t2 = threadIdx.x; asm volatile("" : "+v"(t2)); const int ln = t2 & 63, wv = __builtin_amdgcn_readfirstlane(t2 >> 6);
            const bf16_t* W2 = (const bf16_t*)(ws + WS_W2IN); float* sw3 = (float*)(ws + WS_SW3);
            for (int n = c * 8 + wv; n < 2 * DFF; n += 192 * 8) {
                const u32x4 w0 = *(const u32x4*)(W2 + (size_t)n * DM + 8 * ln), w1 = *(const u32x4*)(W2 + (size_t)n * DM + 512 + 8 * ln);
                f32x4 a0, a1, a2, a3; unpack8(w0, a0, a1); unpack8(w1, a2, a3);
#pragma unroll
                for (int b = 0; b < 8; ++b) { const float* sh = mod + b * NMOD + 6 * DM + 8 * ln;
                    const f32x4 s0 = *(const f32x4*)sh, s1 = *(const f32x4*)(sh + 4), s2 = *(const f32x4*)(sh + 512), s3 = *(const f32x4*)(sh + 516);
                    const f32x4 pr = a0 * s0 + a1 * s1 + a2 * s2 + a3 * s3; const float d = wave_sum((pr[0] + pr[1]) + (pr[2] + pr[3]));
                    if (ln == 0) sw3[b * (2 * DFF) + n] = d; }
            }
        }
        } }
    SEAM(7);
    if (IN(8)) { TIDS();
        const int x = c & 7, s = c >> 3; const int j0 = 2 * s; int nj = 2; asm volatile("" : "+s"(nj));
#pragma unroll 1
        for (int i = 0; i < nj; ++i) { const int j = j0 + i, kvh = j >> 5, h = kvh * 4 + ((j >> 3) & 3), qb = j & 7;
            att::bf16* Qb = (att::bf16*)(ws + WS_Q) + (size_t)(x * SEQ + qb * 256) * DM + h * 128;
            const att::bf16* Kh = (const att::bf16*)(ws + WS_K) + (size_t)x * SKV * 256 + kvh * 128;
            const att::bf16* Vh = (const att::bf16*)(ws + WS_V) + (size_t)x * SKV * 256 + kvh * 128;
            const int tu = tid;
            att::attn_unit(Qb, Kh, Vh, Qb, SKV, (char*)lds_raw, tu, p.q_norm, (const float*)(ws + WS_ROPE), qb * 256); }
    }
    SEAM(8);
    if (IN(9)) { TIDS();
        const pg8::Sched S{(const bf16_t*)(ws + WS_Q), (const bf16_t*)(ws + WS_YF), nullptr, (const bf16_t*)(ws + WS_WAB), (const bf16_t*)(ws + WS_WFB2), nullptr,
                           64, 64, 1, 4, 4, 1, pg8::K_BRA, pg8::K_BRB, pg8::K_BRB, 256, 256, 0, G, c, 1024, 2, 16, 8, 16, 0, 0};
        const pg8::Epi E{ws, p.out, p.x, p.ctx, 0, p.k_norm, p.norm_ffn2, (const LAS float*)(lds + LDS_MISC)}; pg8::gemm_phase<true, true>(lds, S, E, tid); }
    SEAM(9);
    SEAM(10);
    if (IN(11)) { TIDS(); GEMM1(1024, (const bf16_t*)(ws + WS_GA), (const bf16_t*)(ws + WS_WO), 64, 4, pg8::K_RES, 1); }
    if (IN(11) && IN(13)) xcd_barrier(gbar);
    if (IN(13)) { TIDS();
        {
            LAS float* rs = (LAS float*)(lds + LDS_MISC); const float* st3 = (const float*)(ws + WS_ST3) + (size_t)(c & 7) * 2048 * 16;
            for (int r = tid; r < 2048; r += 512) { const f32x4* sp = (const f32x4*)(st3 + (size_t)r * 16); const f32x4 q = (sp[0] + sp[1]) + (sp[2] + sp[3]);
                rs[r] = 1.0f / sqrtf(((q[0] + q[1]) + (q[2] + q[3])) * (1.0f / DM) + EPS); }
            __syncthreads();
        }
        GEMM1(1024, Abuf, (const bf16_t*)(ws + WS_W2IN), 64, 22, pg8::K_SWIGLU, 3); }
    SEAM(13);
    if (IN(14)) { TIDS(); GEMM1(DFF, (const bf16_t*)(ws + WS_H), (const bf16_t*)(ws + WS_W2OUT), 64, 4, pg8::K_RES, 2); }
#undef IN
#undef SEAM
#undef TIDS
#undef GEMM1
#undef GEMM1P
}

extern "C" void kernel_launch(void* const* d_in, const int* in_sizes, int n_in, void* d_out, int out_size, void* d_ws, size_t ws_size, hipStream_t stream) {
    static int grid = 0;
    if (grid == 0) {
        if (n_in != 19 || out_size != NLAT * DM || ws_size < WS_END) { fprintf(stderr, "kernel_launch: unexpected shapes (n_in %d out %d ws %zu)\n", n_in, out_size, ws_size); grid = -1; return; }
        int dev = 0, cus = 0, per_cu = 0;
        hipGetDevice(&dev); hipDeviceGetAttribute(&cus, hipDeviceAttributeMultiprocessorCount, dev);
        if (hipFuncSetAttribute((const void*)mk_fwd, hipFuncAttributeMaxDynamicSharedMemorySize, LDS_BYTES) != hipSuccess) { fprintf(stderr, "kernel_launch: hipFuncSetAttribute failed\n"); grid = -1; return; }
        hipOccupancyMaxActiveBlocksPerMultiprocessor(&per_cu, (const void*)mk_fwd, 512, LDS_BYTES);
        (void)hipGetLastError();
        if (cus != 256 || per_cu < 1) fprintf(stderr, "kernel_launch: note: cus %d per_cu %d (built for 256 x 1)\n", cus, per_cu);
        grid = 256;
    }
    if (grid < 0) return;
    Params p{};
    const float** pp = (const float**)&p;
    for (int i = 0; i < 19; ++i) pp[i] = (const float*)d_in[i];
    p.out = (float*)d_out; p.ws = (unsigned char*)d_ws;
    if (hipMemsetAsync((char*)d_ws + WS_BAR, 0, BAR_BYTES, stream) != hipSuccess) { fprintf(stderr, "kernel_launch: memset failed\n"); return; }
#if MK_MULTI
    int lo = 0;
    for (int st = 0; st < NSTEPS; ++st) {
        if (sync_after(st) || st == NSTEPS - 1) { p.st_lo = lo; p.st_hi = st + 1; hipLaunchKernelGGL(mk_fwd, dim3(grid), dim3(512), LDS_BYTES, stream, p); lo = st + 1; }
    }
#else
    p.st_lo = 0; p.st_hi = NSTEPS;
    void* args[] = {&p};
    hipError_t e = hipLaunchCooperativeKernel((const void*)mk_fwd, dim3(grid), dim3(512), args, LDS_BYTES, stream);
    if (e != hipSuccess) fprintf(stderr, "cooperative launch failed: %s\n", hipGetErrorString(e));
#endif
}
```

```cpp
#include <hip/hip_runtime.h>
#include <hip/hip_cooperative_groups.h>
#include <hip/hip_bf16.h>
#include <cstdio>
#include <cstdint>
namespace cg = cooperative_groups;

#ifndef MK_MULTI
#define MK_MULTI 0
#endif

#define LAS __attribute__((address_space(3)))
typedef unsigned short bf16_t;
typedef short bf16x8 __attribute__((ext_vector_type(8)));
typedef float f32x4 __attribute__((ext_vector_type(4)));
typedef float f32x16 __attribute__((ext_vector_type(16)));
typedef unsigned u32x4 __attribute__((ext_vector_type(4)));
typedef unsigned u32x2 __attribute__((ext_vector_type(2)));
typedef short s16x4 __attribute__((ext_vector_type(4)));

constexpr int DM = 1024, NB = 8, SEQ = 2048, CTXL = 256, NLAT = NB * SEQ, NCTX = NB * CTXL, NTOK = NLAT + NCTX;
constexpr int DFF = 2816, NMOD = 9 * DM, SKV = CTXL + SEQ;
constexpr float EPS = 1e-6f;

constexpr size_t MiB = 1u << 20;
constexpr size_t WS_MOD = 0, WS_ROPE = 384 * 1024, WS_BAR = 512 * 1024, WS_CNT = WS_BAR + 16384, BAR_BYTES = 16384 + 65536;
constexpr size_t WS_W1IN = 1 * MiB, WS_W1OUT = 12 * MiB, WS_WIN = 18 * MiB, WS_WF = 25 * MiB, WS_WAB = 27 * MiB, WS_WFB = 29 * MiB, WS_WO = 30 * MiB;
constexpr size_t WS_W2IN = 32 * MiB, WS_W2OUT = 43 * MiB, WS_DFT = 49 * MiB, WS_A = 65 * MiB, WS_CTX1 = 101 * MiB, WS_H = 109 * MiB;
constexpr size_t WS_Q = 109 * MiB, WS_K = 141 * MiB, WS_V = 150 * MiB, WS_GA = 159 * MiB, WS_GF = 191 * MiB, WS_FT = 223 * MiB, WS_YF = WS_A, WS_CTX1B = WS_FT, WS_X2 = WS_FT, WS_WFB2 = WS_W1IN, WS_ST3 = WS_CTX1, WS_SW3 = WS_CTX1 + 2 * MiB, WS_END = 255 * MiB;

constexpr int LDS_BYTES = 147456;
constexpr int LDS_MISC = 131072;

__device__ __forceinline__ unsigned cvt_pk_bf16(float lo, float hi) { unsigned r; asm volatile("v_cvt_pk_bf16_f32 %0, %1, %2" : "=v"(r) : "v"(lo), "v"(hi)); return r; }
__device__ __forceinline__ u32x4 pack8(f32x4 a, f32x4 b) { u32x4 w; w.x = cvt_pk_bf16(a[0], a[1]); w.y = cvt_pk_bf16(a[2], a[3]); w.z = cvt_pk_bf16(b[0], b[1]); w.w = cvt_pk_bf16(b[2], b[3]); return w; }
__device__ __forceinline__ void st16_wt(void* p, u32x4 v) {
    asm volatile("global_store_dwordx4 %0, %1, off sc1\n\ts_nop 1" :: "v"(p), "v"(v) : "memory");
}
__device__ __forceinline__ void unpack8(u32x4 w, f32x4& a, f32x4& b) {
    a[0] = __uint_as_float(w.x << 16); a[1] = __uint_as_float(w.x & 0xffff0000u); a[2] = __uint_as_float(w.y << 16); a[3] = __uint_as_float(w.y & 0xffff0000u);
    b[0] = __uint_as_float(w.z << 16); b[1] = __uint_as_float(w.z & 0xffff0000u); b[2] = __uint_as_float(w.w << 16); b[3] = __uint_as_float(w.w & 0xffff0000u); }
__device__ __forceinline__ float bf2f(bf16_t v) { return __uint_as_float((unsigned)v << 16); }
__device__ __forceinline__ bf16_t f2bf(float f) { unsigned u = __float_as_uint(f); return (bf16_t)((u + 0x7fffu + ((u >> 16) & 1u)) >> 16); }
__device__ __forceinline__ float sigmoidf_(float v) { return __builtin_amdgcn_rcpf(1.f + __builtin_amdgcn_exp2f(-1.4426950408889634f * v)); }
__device__ __forceinline__ float wave_sum(float v) {
#pragma unroll
    for (int o = 1; o < 64; o <<= 1) v += __shfl_xor(v, o);
    return v;
}

namespace pg8 {
constexpr int BM = 256, BK = 64, HALF = 128, HTB = HALF * BK * 2, STAGE_BYTES = 8 * HTB, NXCD = 8, WGM = 8;
__host__ __device__ __forceinline__ int lds_byte(int r, int c) { const int st = (r >> 4) * 2 + (c >> 5), rr = r & 15, cc = c & 31, ob = rr * 64 + cc * 2; return st * 1024 + (ob ^ (((ob >> 9) & 1) << 5)); }
__host__ __device__ __forceinline__ void stage_rc(int b, int& R, int& C) { const int st = b / 1024, sb = b % 1024, swz = sb ^ (((sb >> 9) & 1) << 5); R = (st >> 1) * 16 + swz / 64; C = (st & 1) * 32 + (swz % 64) / 2; }
__host__ __device__ __forceinline__ int perm32(int rho) { const int n = rho >> 4, i = rho & 15; return 8 * (i >> 2) + 4 * n + (i & 3); }

struct Unit { int pm, pn, sub, q; };
enum Kind { K_SWIGLU = 0, K_RES = 1, K_INPROJ = 2, K_FTSWAP = 3, K_CTXKV = 4, K_FOUR2 = 5, K_BRA = 6, K_BRB = 7, K_RESC0 = 8, K_RESC1 = 9 };

struct Sched {
    const bf16_t *A0, *A1, *A2, *B0, *B1, *B2; int nM0, nM1, nM2, nN0, nN1, nN2, k0, k1, k2; int n0, n1, n2; int G, c, K, direct; int kt0, kt1, kt2, ko1, ko2;
    static __device__ __forceinline__ int sel3(int sub, int v0, int v1, int v2) { const int m1 = -(int)(sub == 1), m2 = -(int)(sub == 2); return v0 ^ ((v0 ^ v1) & m1) ^ ((v0 ^ v2) & m2); }
    static __device__ __forceinline__ unsigned long long sel3p(int sub, const void* p0, const void* p1, const void* p2) {
        const unsigned long long v0 = (unsigned long long)p0, v1 = (unsigned long long)p1, v2 = (unsigned long long)p2, m1 = -(unsigned long long)(sub == 1), m2 = -(unsigned long long)(sub == 2);
        return v0 ^ ((v0 ^ v1) & m1) ^ ((v0 ^ v2) & m2); }
    __device__ __forceinline__ bool next(int i, Unit& u) const {
        u.q = 0;
        if (direct == 1) { if (i > 0) return false; const int x = c & 7, s = c >> 3, r = s & 7; u.sub = 0; u.q = s >> 3; u.pm = r & 3; u.pn = 2 * x + (r >> 2); return true; }
        if (direct == 2) {
            if (i > 1 || c >= n0) return false; u.sub = i;
            const int nwg = nM0 * nN0; int wgid; { const int q = nwg / NXCD, r = nwg % NXCD, xcd = c % NXCD, off = c / NXCD; wgid = (xcd < r ? xcd * (q + 1) : r * (q + 1) + (xcd - r) * q) + off; }
            const int nig = WGM * nN0, gid = wgid / nig, fm = gid * WGM, gsz = (nM0 - fm) < WGM ? (nM0 - fm) : WGM;
            u.pm = fm + ((wgid % nig) % gsz); u.pn = (wgid % nig) / gsz; return true; }
        const long L = (long)i * G + c;
        if (L >= n0 + n1 + n2) return false;
        const int sub = (L >= n0) + (L >= n0 + n1); u.sub = sub;
        const int l = (int)L - sel3(sub, 0, n0, n0 + n1), nM = sel3(sub, nM0, nM1, nM2), nN = sel3(sub, nN0, nN1, nN2);
        const int nwg = nM * nN; int wgid; { const int q = nwg / NXCD, r = nwg % NXCD, xcd = l % NXCD, off = l / NXCD; wgid = (xcd < r ? xcd * (q + 1) : r * (q + 1) + (xcd - r) * q) + off; }
        const int nig = WGM * nN, gid = wgid / nig, fm = gid * WGM, gsz = (nM - fm) < WGM ? (nM - fm) : WGM;
        u.pm = fm + ((wgid % nig) % gsz); u.pn = (wgid % nig) / gsz; return true;
    }
    __device__ __forceinline__ const char* aptr(const Unit& u) const { return (const char*)sel3p(u.sub, A0, A1, A2) + (size_t)u.pm * (size_t)(512 * K) + 2 * sel3(u.sub, 0, ko1, ko2) + (direct == 1 ? 2048 * u.q : 0); }
    __device__ __forceinline__ const char* bptr(const Unit& u) const { return (const char*)sel3p(u.sub, B0, B1, B2) + (size_t)u.pn * (size_t)(512 * K) + 2 * sel3(u.sub, 0, ko1, ko2) + (direct == 1 ? 2048 * u.q : 0); }
    __device__ __forceinline__ int ktiles(const Unit& u) const { return sel3(u.sub, kt0, kt1, kt2); }
    __device__ __forceinline__ int kind(const Unit& u) const { return sel3(u.sub, k0, k1, k2); }
};

struct Epi {
    unsigned char* ws; float* out; const float* x; const float* ctx; int res_mode; const float* kg; const float* ng; const LAS float* rs;
    template <bool PERM> __device__ __forceinline__ void run(f32x4 (&acc)[2][2][4][2], const Unit& u, int kind, int wr, int wc, int fr_in, int fq_in) const {
        int fr = fr_in, fq = fq_in; asm volatile("" : "+v"(fr), "+v"(fq));
        const int rowt = u.pm * 256 + wr * 64 + fr;
        const int cw = wc * 32 + 8 * fq;
        if (kind == K_SWIGLU) {
            bf16_t* H = (bf16_t*)(ws + WS_H);
            const bool fn = (res_mode == 3);
            f32x4 sg[2], su[2];
            if (fn) { const float* sw = (const float*)(ws + WS_SW3) + (u.pm >> 3) * (2 * DFF) + u.pn * 256 + cw;
#pragma unroll
                for (int n = 0; n < 2; ++n) { sg[n] = *(const f32x4*)(sw + 4 * n); su[n] = *(const f32x4*)(sw + 128 + 4 * n); } }
#pragma unroll
            for (int ai = 0; ai < 2; ++ai)
#pragma unroll
                for (int m = 0; m < 4; ++m) {
                    const int row = rowt + ai * 128 + m * 16; f32x4 h[2];
                    const float rstd = fn ? rs[row & 2047] : 1.f;
#pragma unroll
                    for (int n = 0; n < 2; ++n) { f32x4 g = acc[ai][0][m][n], up = acc[ai][1][m][n]; if (fn) { g = g * rstd + sg[n]; up = up * rstd + su[n]; }
#pragma unroll
                        for (int e = 0; e < 4; ++e) h[n][e] = g[e] * sigmoidf_(g[e]) * up[e]; }
                    *(u32x4*)(H + (size_t)row * DFF + u.pn * 128 + cw) = pack8(h[0], h[1]);
                }
        } else if (kind == K_RES || kind == K_RESC0 || kind == K_RESC1) {
            const float* mod = (const float*)(ws + WS_MOD);
            const bool isctx = kind != K_RES, nobase = kind == K_RESC1;
            const bool in_bf = (res_mode != 0), out_bf = (res_mode == 1) || (res_mode == 0 && !isctx);
            const float* basef = isctx ? ctx : x; float* dstf = isctx ? (float*)(ws + (nobase ? WS_CTX1B : WS_CTX1)) : out;
            const bf16_t* baseb = res_mode == 1 ? (const bf16_t*)out : (const bf16_t*)(ws + WS_X2); bf16_t* dstb = res_mode == 0 ? (bf16_t*)out : (bf16_t*)(ws + WS_X2);
            const int gate_off = res_mode == 0 ? 2 * DM : (res_mode == 1 ? 5 * DM : 8 * DM); const float coef = res_mode == 1 ? 1.f : 0.5f;
            const int mrow = isctx ? 8 : (u.pm >> 3);
            const float* gp = mod + mrow * NMOD + gate_off + u.pn * 256 + cw;
            f32x4 gv[2][2], gg[2][2];
#pragma unroll
            for (int bj = 0; bj < 2; ++bj)
#pragma unroll
                for (int n = 0; n < 2; ++n) { gv[bj][n] = *(const f32x4*)(gp + bj * 128 + 4 * n) * coef; gg[bj][n] = gv[bj][n];
                    if (res_mode == 1) gg[bj][n] = *(const f32x4*)(ng + u.pn * 256 + cw + bj * 128 + 4 * n) * (*(const f32x4*)(mod + mrow * NMOD + 7 * DM + u.pn * 256 + cw + bj * 128 + 4 * n) + 1.0f); }
#pragma unroll
            for (int ai = 0; ai < 2; ++ai) {
                f32x4 bv[4][2][2];
#pragma unroll
                for (int m = 0; m < 4; ++m) { const size_t off = (size_t)(rowt + ai * 128 + m * 16) * DM + u.pn * 256 + cw;
#pragma unroll
                    for (int bj = 0; bj < 2; ++bj) {
                        if (in_bf) unpack8(__builtin_nontemporal_load((const u32x4*)(baseb + off + bj * 128)), bv[m][bj][0], bv[m][bj][1]);
                        else if (nobase) { bv[m][bj][0] = (f32x4){0.f, 0.f, 0.f, 0.f}; bv[m][bj][1] = bv[m][bj][0]; }
                        else { bv[m][bj][0] = __builtin_nontemporal_load((const f32x4*)(basef + off + bj * 128)); bv[m][bj][1] = __builtin_nontemporal_load((const f32x4*)(basef + off + bj * 128 + 4)); } } }
#pragma unroll
                for (int m = 0; m < 4; ++m) { const size_t off = (size_t)(rowt + ai * 128 + m * 16) * DM + u.pn * 256 + cw; float ss = 0.f;
#pragma unroll
                    for (int bj = 0; bj < 2; ++bj) { const f32x4 v0 = bv[m][bj][0] + gv[bj][0] * acc[ai][bj][m][0], v1 = bv[m][bj][1] + gv[bj][1] * acc[ai][bj][m][1];
                        if (out_bf) *(u32x4*)(dstb + off + bj * 128) = pack8(v0, v1);
                        else { *(f32x4*)(dstf + off + bj * 128) = v0; *(f32x4*)(dstf + off + bj * 128 + 4) = v1; }
                        if (res_mode == 1) {
                            *(u32x4*)((bf16_t*)(ws + WS_A) + off + bj * 128) = pack8(v0 * gg[bj][0], v1 * gg[bj][1]);
                            ss += (v0[0] * v0[0] + v0[1] * v0[1]) + (v0[2] * v0[2] + v0[3] * v0[3]) + (v1[0] * v1[0] + v1[1] * v1[1]) + (v1[2] * v1[2] + v1[3] * v1[3]); } }
                    if (res_mode == 1) { ss += __shfl_xor(ss, 16); ss += __shfl_xor(ss, 32);
                        if (fq == 0) ((float*)(ws + WS_ST3))[(size_t)(rowt + ai * 128 + m * 16) * 16 + u.pn * 4 + wc] = ss; } }
            }
        } else if (kind == K_INPROJ || kind == K_CTXKV) {
            bf16_t* dstb; int ld, rowadd, colb; bool sig = false;
            if (kind == K_INPROJ) {
                const int pn = u.pn;
                if (pn < 4) { dstb = (bf16_t*)(ws + WS_Q); ld = DM; rowadd = 0; colb = pn * 256; }
                else if (pn < 6) { dstb = (bf16_t*)(ws + (pn == 4 ? WS_K : WS_V)); ld = 256; rowadd = 256 * ((u.pm >> 3) + 1); colb = 0; }
                else if (pn < 10) { dstb = (bf16_t*)(ws + WS_GA); ld = DM; rowadd = 0; colb = (pn - 6) * 256; sig = true; }
                else { dstb = (bf16_t*)(ws + WS_GF); ld = DM; rowadd = 0; colb = (pn - 10) * 256; sig = true; }
            } else { dstb = (bf16_t*)(ws + (u.pn == 0 ? WS_K : WS_V)); ld = 256; rowadd = u.pm * (SKV - CTXL); colb = 0; }
#pragma unroll
            for (int ai = 0; ai < 2; ++ai)
#pragma unroll
                for (int m = 0; m < 4; ++m) {
                    const int row = rowt + ai * 128 + m * 16 + rowadd;
#pragma unroll
                    for (int bj = 0; bj < 2; ++bj) { f32x4 a = acc[ai][bj][m][0], b = acc[ai][bj][m][1];
                        if (sig) {
#pragma unroll
                            for (int e = 0; e < 4; ++e) { a[e] = sigmoidf_(a[e]); b[e] = sigmoidf_(b[e]); } }
                        *(u32x4*)(dstb + (size_t)row * ld + colb + bj * 128 + cw) = pack8(a, b); }
                }
            const bool isk = (kind == K_INPROJ) ? (u.pn == 4) : (u.pn == 0);
            if (isk) {
                asm volatile("s_waitcnt vmcnt(0)" ::: "memory"); __builtin_amdgcn_s_barrier(); asm volatile("" ::: "memory");
                const float* rt = (const float*)(ws + WS_ROPE); const bool rope = (kind == K_INPROJ);
                const int lane = fq * 16 + fr, wid = wr * 4 + wc, l16 = lane & 15;
                const f32x4 g1 = *(const f32x4*)(kg + 4 * l16), g2 = *(const f32x4*)(kg + 64 + 4 * l16);
#pragma unroll 4
                for (int it = 0; it < 16; ++it) { const int item = it * 32 + wid * 4 + (lane >> 4), r = item >> 1, hd = item & 1;
                    bf16_t* hp = dstb + (size_t)(u.pm * 256 + r + rowadd) * 256 + hd * 128 + 4 * l16;
                    const u32x2 w1 = *(const u32x2*)hp, w2 = *(const u32x2*)(hp + 64);
                    f32x4 t1 = {__uint_as_float(w1.x << 16), __uint_as_float(w1.x & 0xffff0000u), __uint_as_float(w1.y << 16), __uint_as_float(w1.y & 0xffff0000u)};
                    f32x4 t2 = {__uint_as_float(w2.x << 16), __uint_as_float(w2.x & 0xffff0000u), __uint_as_float(w2.y << 16), __uint_as_float(w2.y & 0xffff0000u)};
                    float ss = (t1[0] * t1[0] + t1[1] * t1[1]) + (t1[2] * t1[2] + t1[3] * t1[3]) + (t2[0] * t2[0] + t2[1] * t2[1]) + (t2[2] * t2[2] + t2[3] * t2[3]);
                    ss += __shfl_xor(ss, 1); ss += __shfl_xor(ss, 2); ss += __shfl_xor(ss, 4); ss += __shfl_xor(ss, 8);
                    const float rstd = 1.0f / sqrtf(ss * (1.0f / 128.0f) + EPS);
                    t1 = t1 * rstd * g1; t2 = t2 * rstd * g2;
                    if (rope) { const int n = ((u.pm & 7) * 256 + r); const int pos = l16 < 8 ? (n >> 6) : (n & 63); const float* rp = rt + 2 * (pos * 32 + ((4 * l16) & 31));
                        const f32x4 c0 = *(const f32x4*)rp, c1 = *(const f32x4*)(rp + 4); f32x4 o1, o2;
                        o1[0] = t1[0] * c0[0] - t2[0] * c0[1]; o2[0] = t2[0] * c0[0] + t1[0] * c0[1]; o1[1] = t1[1] * c0[2] - t2[1] * c0[3]; o2[1] = t2[1] * c0[2] + t1[1] * c0[3];
                        o1[2] = t1[2] * c1[0] - t2[2] * c1[1]; o2[2] = t2[2] * c1[0] + t1[2] * c1[1]; o1[3] = t1[3] * c1[2] - t2[3] * c1[3]; o2[3] = t2[3] * c1[2] + t1[3] * c1[3];
                        t1 = o1; t2 = o2; }
                    u32x2 q1, q2; q1.x = cvt_pk_bf16(t1[0], t1[1]); q1.y = cvt_pk_bf16(t1[2], t1[3]); q2.x = cvt_pk_bf16(t2[0], t2[1]); q2.y = cvt_pk_bf16(t2[2], t2[3]);
                    *(u32x2*)hp = q1; *(u32x2*)(hp + 64) = q2; }
            }
        } else if (kind == K_FTSWAP) {
            bf16_t* FT = (bf16_t*)(ws + WS_FT);
#pragma unroll
            for (int ai = 0; ai < 2; ++ai)
#pragma unroll
                for (int m = 0; m < 4; ++m) {
                    const int j = rowt + ai * 128 + m * 16; const int cs = j >> 9, g = (j >> 7) & 3, mm = j & 127;
#pragma unroll
                    for (int bj = 0; bj < 2; ++bj) { const int t0 = u.pn * 256 + bj * 128 + cw; const int b = t0 >> 11, n = t0 & 2047;
                        *(u32x4*)(FT + ((size_t)((b * 4 + g) * 128 + mm)) * 4096 + cs * 2048 + n) = pack8(acc[ai][bj][m][0], acc[ai][bj][m][1]); }
                }
        } else if (kind == K_FOUR2) {
            bf16_t* YF = (bf16_t*)(ws + WS_YF);
            unsigned* flag = (unsigned*)(ws + WS_CNT) + (size_t)((u.pm * 16 + u.pn) * 4) * 64;
            const int lane = fq * 16 + fr, wid = wr * 4 + wc, role = u.q;
            if (role != 3) {
#pragma unroll
                for (int ai = 0; ai < 2; ++ai)
#pragma unroll
                    for (int m = 0; m < 4; ++m) { const int k = rowt + ai * 128 + m * 16;
#pragma unroll
                        for (int bj = 0; bj < 2; ++bj) { const int c = u.pn * 256 + bj * 128 + cw; const int b = c >> 9, cc = c & 511;
                            bf16_t* dstp = role == 0 ? YF + (size_t)(b * SEQ + k) * 1024 + 512 + cc : (role == 1 ? YF + (size_t)(b * SEQ + 1024 + k) * 1024 + 512 + cc : YF + (size_t)(b * SEQ + k) * 1024 + cc);
                            st16_wt(dstp, pack8(acc[ai][bj][m][0], acc[ai][bj][m][1])); } }
                asm volatile("s_waitcnt vmcnt(0)" ::: "memory");
                if (lane == 0) __hip_atomic_fetch_add(flag + 64 * role, 1u, __ATOMIC_RELAXED, __HIP_MEMORY_SCOPE_AGENT);
            } else {
                if (wid == 0) {
#pragma unroll
                    for (int f = 0; f < 3; ++f) { unsigned sp_ = 0; while ((unsigned)__builtin_amdgcn_readfirstlane(__hip_atomic_load(flag + 64 * f, __ATOMIC_RELAXED, __HIP_MEMORY_SCOPE_AGENT)) < 8u) { __builtin_amdgcn_s_sleep(2); if (++sp_ > (1u << 13)) break; } }
                    __builtin_amdgcn_fence(__ATOMIC_ACQUIRE, "agent"); asm volatile("s_waitcnt vmcnt(0)" ::: "memory"); }
                asm volatile("" ::: "memory"); __builtin_amdgcn_s_barrier(); asm volatile("" ::: "memory");
#pragma unroll
                for (int ai2 = 0; ai2 < 4; ++ai2) { const int ai = ai2 >> 1, mb = (ai2 & 1) * 2;
                    u32x4 t0[4][2], t1[4][2], t2[4][2];
#pragma unroll
                    for (int m = mb; m < mb + 2; ++m) { const int k = rowt + ai * 128 + m * 16;
#pragma unroll
                        for (int bj = 0; bj < 2; ++bj) { const int c = u.pn * 256 + bj * 128 + cw; const int b = c >> 9, cc = c & 511;
                            t0[m][bj] = __builtin_nontemporal_load((const u32x4*)(YF + (size_t)(b * SEQ + k) * 1024 + 512 + cc));
                            t1[m][bj] = __builtin_nontemporal_load((const u32x4*)(YF + (size_t)(b * SEQ + 1024 + k) * 1024 + 512 + cc));
                            t2[m][bj] = __builtin_nontemporal_load((const u32x4*)(YF + (size_t)(b * SEQ + k) * 1024 + cc)); } }
#pragma unroll
                    for (int m = mb; m < mb + 2; ++m) { const int k = rowt + ai * 128 + m * 16;
#pragma unroll
                        for (int bj = 0; bj < 2; ++bj) { const int c = u.pn * 256 + bj * 128 + cw; const int b = c >> 9, cc = c & 511;
                            f32x4 a0, a1, b0, b1, s0, s1; unpack8(t0[m][bj], a0, a1); unpack8(t1[m][bj], b0, b1); unpack8(t2[m][bj], s0, s1);
                            const f32x4 c0 = a0 + b0, c1 = a1 + b1; s0 = s0 + acc[ai][bj][m][0]; s1 = s1 + acc[ai][bj][m][1];
                            *(u32x4*)(YF + (size_t)(b * SEQ + k) * 1024 + cc) = pack8(c0 + s0, c1 + s1);
                            if (k != 0) *(u32x4*)(YF + (size_t)(b * SEQ + SEQ - k) * 1024 + cc) = pack8(c0 - s0, c1 - s1); } }
                }
            }
        } else {
            bf16_t* GA = (bf16_t*)(ws + WS_GA); const bf16_t* GF = (const bf16_t*)(ws + WS_GF);
#pragma unroll
            for (int ai = 0; ai < 2; ++ai) {
                u32x4 ra[4][2], rf[4][2];
#pragma unroll
                for (int m = 0; m < 4; ++m) { const size_t off = (size_t)(rowt + ai * 128 + m * 16) * DM + u.pn * 256 + cw;
#pragma unroll
                    for (int bj = 0; bj < 2; ++bj) { if (kind == K_BRA) { rf[m][bj] = *(const u32x4*)(GF + off + bj * 128); ra[m][bj] = __builtin_nontemporal_load((const u32x4*)(GA + off + bj * 128)); } else { rf[m][bj] = __builtin_nontemporal_load((const u32x4*)(GF + off + bj * 128)); ra[m][bj] = rf[m][bj]; } } }
#pragma unroll
                for (int m = 0; m < 4; ++m) { const size_t off = (size_t)(rowt + ai * 128 + m * 16) * DM + u.pn * 256 + cw;
#pragma unroll
                    for (int bj = 0; bj < 2; ++bj) { f32x4 g0, g1; unpack8(rf[m][bj], g0, g1);
                        if (kind == K_BRA) { f32x4 a0, a1; unpack8(ra[m][bj], a0, a1);
#pragma unroll
                            for (int e = 0; e < 4; ++e) { acc[ai][bj][m][0][e] *= a0[e] * __builtin_amdgcn_rcpf(g0[e]); acc[ai][bj][m][1][e] *= a1[e] * __builtin_amdgcn_rcpf(g1[e]); } }
                        else *(u32x4*)(GA + off + bj * 128) = pack8(g0 * acc[ai][bj][m][0], g1 * acc[ai][bj][m][1]); } }
            }
        }
    }
};

template <bool ALIGN_EPI, bool SP2, bool PERM = true>
__device__ __forceinline__ void gemm_phase(LAS unsigned char* lds, const Sched& S, const Epi& E, const int tid) {
    const int wid = __builtin_amdgcn_readfirstlane(tid >> 6), lane = tid & 63, wr = wid >> 2, wc = wid & 3, fr = lane & 15, fq = lane >> 4;
    const int K = S.K;
    unsigned voffA[2], voffB[2];
#pragma unroll
    for (int i = 0; i < 2; ++i) { int R, C; stage_rc(tid * 16 + i * 8192, R, C); const int Rb = PERM ? ((R & ~31) + perm32(R & 31)) : R;
        voffA[i] = (unsigned)(R * K + C) * 2u; voffB[i] = (unsigned)(Rb * K + C) * 2u; }
    const size_t kstep = (size_t)(BK * 2);
    const size_t hstep = (size_t)HALF * K * 2;
    const unsigned ldsw = (unsigned)wid * 1024u;
    const int aoff = lds_byte(wr * 64 + fr, fq * 8), boff = lds_byte(wc * 32 + fr, fq * 8);
#define PG8_SA(b, h) (((b) * 2 + (h)) * HTB)
#define PG8_SB(b, h) ((4 + (b) * 2 + (h)) * HTB)
#define PG8_STAGE(bufoff, gbase, voff) do { _Pragma("unroll") for (int _i = 0; _i < 2; ++_i) \
        __builtin_amdgcn_global_load_lds((const unsigned*)((const char*)(gbase) + (voff)[_i]), (LAS unsigned*)(lds + (bufoff) + ldsw + _i * 8192), 16, 0, 0); } while (0)
#define PG8_LDA(dst, b, h) do { _Pragma("unroll") for (int m = 0; m < 4; ++m) _Pragma("unroll") for (int k = 0; k < 2; ++k) dst[m][k] = *(const LAS bf16x8*)(lds + PG8_SA(b, h) + aoff + m * 2048 + k * 1024); } while (0)
#define PG8_LDB(dst, b, h) do { _Pragma("unroll") for (int n = 0; n < 2; ++n) _Pragma("unroll") for (int k = 0; k < 2; ++k) dst[n][k] = *(const LAS bf16x8*)(lds + PG8_SB(b, h) + boff + n * 2048 + k * 1024); } while (0)
#define PG8_MMA(ai, bj, At, Bt) do { __builtin_amdgcn_s_setprio(1); _Pragma("unroll") for (int m = 0; m < 4; ++m) _Pragma("unroll") for (int n = 0; n < 2; ++n) _Pragma("unroll") for (int k = 0; k < 2; ++k) \
        acc[ai][bj][m][n] = __builtin_amdgcn_mfma_f32_16x16x32_bf16(Bt[n][k], At[m][k], acc[ai][bj][m][n], 0, 0, 0); __builtin_amdgcn_s_setprio(0); } while (0)
#define PG8_WAIT_V(n) asm volatile("s_waitcnt vmcnt(" #n ")" ::: "memory")
#define PG8_WAIT_L(n) asm volatile("s_waitcnt lgkmcnt(" #n ")" ::: "memory")
#define PG8_BAR __builtin_amdgcn_s_barrier()
#define PG8_SCHED __builtin_amdgcn_sched_barrier(0)
    Unit cur, nxt; int ui = 0;
    if (!S.next(0, cur)) return;
    f32x4 acc[2][2][4][2];
#pragma unroll
    for (int a = 0; a < 2; ++a)
#pragma unroll
        for (int b = 0; b < 2; ++b)
#pragma unroll
            for (int m = 0; m < 4; ++m)
#pragma unroll
                for (int n = 0; n < 2; ++n) acc[a][b][m][n] = (f32x4){0.f, 0.f, 0.f, 0.f};
    bf16x8 At[4][2], B0[2][2], B1[2][2];
    const char* cA = S.aptr(cur); const char* cB = S.bptr(cur);
    if constexpr (SP2) {
        PG8_STAGE(PG8_SB(0, 0), cB, voffB); PG8_STAGE(PG8_SB(0, 1), cB + hstep, voffB); PG8_STAGE(PG8_SA(0, 0), cA, voffA); PG8_STAGE(PG8_SA(0, 1), cA + hstep, voffA);
        if (wr == 1) PG8_BAR;
        PG8_WAIT_V(2); PG8_BAR;
        PG8_STAGE(PG8_SB(1, 0), cB + kstep, voffB); PG8_STAGE(PG8_SA(1, 0), cA + kstep, voffA); PG8_STAGE(PG8_SB(1, 1), cB + hstep + kstep, voffB);
        PG8_WAIT_V(6); PG8_BAR;
    } else {
        PG8_STAGE(PG8_SB(0, 0), cB, voffB); PG8_STAGE(PG8_SA(0, 0), cA, voffA); PG8_STAGE(PG8_SB(0, 1), cB + hstep, voffB); PG8_STAGE(PG8_SA(0, 1), cA + hstep, voffA);
        if (wr == 1) PG8_BAR;
        PG8_WAIT_V(4); PG8_BAR;
        PG8_STAGE(PG8_SB(1, 0), cB + kstep, voffB); PG8_STAGE(PG8_SA(1, 0), cA + kstep, voffA); PG8_STAGE(PG8_SB(1, 1), cB + hstep + kstep, voffB);
        PG8_WAIT_V(6); PG8_BAR;
    }
    for (;;) {
        const bool has_next = S.next(ui + 1, nxt); const int nt = S.ktiles(cur);
        const char* nA = has_next ? S.aptr(nxt) : cA; const char* nB = has_next ? S.bptr(nxt) : cB;
        for (int t = 0; t < nt; t += 2) {
            const bool last = (t == nt - 2);
            const char* a1 = cA + (size_t)(t + 1) * kstep;
            const char* a2 = last ? nA : cA + (size_t)(t + 2) * kstep; const char* b2 = last ? nB : cB + (size_t)(t + 2) * kstep;
            const char* a3 = a2 + kstep; const char* b3 = b2 + kstep;
            if constexpr (SP2) {
            PG8_LDB(B0, 0, 0); PG8_LDB(B1, 0, 1); PG8_SCHED; PG8_LDA(At, 0, 0); PG8_STAGE(PG8_SA(1, 1), a1 + hstep, voffA);
            PG8_WAIT_V(8); PG8_WAIT_L(0); PG8_BAR; PG8_MMA(0, 0, At, B0); PG8_MMA(0, 1, At, B1); PG8_BAR; PG8_SCHED;
            PG8_LDA(At, 0, 1); PG8_STAGE(PG8_SB(0, 0), b2, voffB); PG8_STAGE(PG8_SB(0, 1), b2 + hstep, voffB); PG8_STAGE(PG8_SA(0, 0), a2, voffA);
            PG8_WAIT_V(8); PG8_WAIT_L(0); PG8_BAR; PG8_MMA(1, 0, At, B0); PG8_MMA(1, 1, At, B1); PG8_BAR; PG8_SCHED;
            PG8_LDB(B0, 1, 0); PG8_LDB(B1, 1, 1); PG8_SCHED; PG8_LDA(At, 1, 0); PG8_STAGE(PG8_SA(0, 1), a2 + hstep, voffA);
            PG8_WAIT_V(8); PG8_WAIT_L(0); PG8_BAR; PG8_MMA(0, 0, At, B0); PG8_MMA(0, 1, At, B1); PG8_BAR; PG8_SCHED;
            PG8_LDA(At, 1, 1); PG8_STAGE(PG8_SB(1, 0), b3, voffB); PG8_STAGE(PG8_SB(1, 1), b3 + hstep, voffB); PG8_STAGE(PG8_SA(1, 0), a3, voffA);
            PG8_WAIT_V(8); PG8_WAIT_L(0); PG8_BAR; PG8_MMA(1, 0, At, B0); PG8_MMA(1, 1, At, B1); PG8_BAR; PG8_SCHED;
            } else {
            PG8_LDB(B0, 0, 0); PG8_SCHED; PG8_LDA(At, 0, 0); PG8_STAGE(PG8_SA(1, 1), a1 + hstep, voffA);
            PG8_WAIT_L(8); PG8_BAR; PG8_WAIT_L(0); PG8_MMA(0, 0, At, B0); PG8_BAR; PG8_SCHED;
            PG8_LDB(B1, 0, 1); PG8_STAGE(PG8_SB(0, 0), b2, voffB);
            PG8_BAR; PG8_WAIT_L(0); PG8_MMA(0, 1, At, B1); PG8_BAR;
            PG8_LDA(At, 0, 1); PG8_STAGE(PG8_SA(0, 0), a2, voffA);
            PG8_BAR; PG8_WAIT_L(0); PG8_MMA(1, 0, At, B0); PG8_BAR; PG8_SCHED;
            PG8_STAGE(PG8_SB(0, 1), b2 + hstep, voffB);
            PG8_WAIT_V(6); PG8_BAR; PG8_MMA(1, 1, At, B1); PG8_BAR;
            PG8_LDB(B0, 1, 0); PG8_SCHED; PG8_LDA(At, 1, 0); PG8_STAGE(PG8_SA(0, 1), a2 + hstep, voffA);
            PG8_WAIT_L(8); PG8_BAR; PG8_WAIT_L(0); PG8_MMA(0, 0, At, B0); PG8_BAR; PG8_SCHED;
            PG8_LDB(B1, 1, 1); PG8_STAGE(PG8_SB(1, 0), b3, voffB);
            PG8_BAR; PG8_WAIT_L(0); PG8_MMA(0, 1, At, B1); PG8_BAR;
            PG8_LDA(At, 1, 1); PG8_STAGE(PG8_SA(1, 0), a3, voffA);
            PG8_BAR; PG8_WAIT_L(0); PG8_MMA(1, 0, At, B0); PG8_BAR; PG8_SCHED;
            PG8_STAGE(PG8_SB(1, 1), b3 + hstep, voffB);
            PG8_WAIT_V(6); PG8_BAR; PG8_MMA(1, 1, At, B1); PG8_BAR;
            }
        }
        if constexpr (ALIGN_EPI) { if (wr == 0) PG8_BAR; }
        E.template run<PERM>(acc, cur, S.kind(cur), wr, wc, fr, fq);
        if (!has_next) break;
        if (S.kind(cur) != K_BRA) {
#pragma unroll
        for (int a = 0; a < 2; ++a)
#pragma unroll
            for (int b = 0; b < 2; ++b)
#pragma unroll
                for (int m = 0; m < 4; ++m)
#pragma unroll
                    for (int n = 0; n < 2; ++n) acc[a][b][m][n] = (f32x4){0.f, 0.f, 0.f, 0.f};
        }
        cur = nxt; cA = nA; cB = nB; ++ui;
        if constexpr (ALIGN_EPI) { if (wr == 1) PG8_BAR; }
    }
    PG8_WAIT_V(0);
    if constexpr (!ALIGN_EPI) { if (wr == 0) PG8_BAR; }
    PG8_BAR;
#undef PG8_SA
#undef PG8_SB
#undef PG8_STAGE
#undef PG8_LDA
#undef PG8_LDB
#undef PG8_MMA
#undef PG8_WAIT_V
#undef PG8_WAIT_L
#undef PG8_BAR
#undef PG8_SCHED
}
}

namespace att {
using bf16 = __hip_bfloat16;
constexpr int D = 128, NW = 8, QBLK = 32, KVBLK = 64;
constexpr float SCALE = 0.088388347648318440f;
constexpr float THR = 8.f;
constexpr int LDQ = DM, LDK = 256, LDO = DM;
constexpr size_t SHM_V = KVBLK * D * 2, SHM_K = KVBLK * D * 2, SHM_ATTN = 2 * SHM_V + 2 * SHM_K + NW * 64 * 4;
#define KSWZ(row, colB) ((row) * 256 + ((colB) ^ (((row) & 7) << 4)))
#define SBAR() __builtin_amdgcn_sched_barrier(0)
__device__ __forceinline__ int crow(int r, int hi) { return (r & 3) + 8 * (r >> 2) + 4 * hi; }
__device__ __forceinline__ unsigned cvtpk(float lo, float hi) { unsigned r; asm volatile("v_cvt_pk_bf16_f32 %0, %1, %2" : "=v"(r) : "v"(lo), "v"(hi)); return r; }
__device__ __forceinline__ void partialSM(f32x16& p0, f32x16& p1, float& m_reg, float& mn, float& alpha) {
  constexpr float C = SCALE * 1.4426950408889634f;
  float pmax = p0[0];
  _Pragma("unroll") for (int r = 1; r < 16; ++r) pmax = fmaxf(pmax, p0[r]);
  _Pragma("unroll") for (int r = 0; r < 16; ++r) pmax = fmaxf(pmax, p1[r]);
  { auto rr = __builtin_amdgcn_permlane32_swap(__float_as_uint(pmax), __float_as_uint(pmax), false, false);
    pmax = fmaxf(__uint_as_float(rr[0]), __uint_as_float(rr[1])); }
  if (__builtin_expect(__all(pmax - m_reg <= THR / SCALE), 1)) { mn = m_reg; alpha = 1.f; }
  else { mn = fmaxf(m_reg, pmax); alpha = __builtin_amdgcn_exp2f((m_reg - mn) * C); m_reg = mn; }
  float mnC = -mn * C;
  _Pragma("unroll") for (int r = 0; r < 16; ++r) p0[r] = fmaf(p0[r], C, mnC);
  _Pragma("unroll") for (int r = 0; r < 16; ++r) p1[r] = fmaf(p1[r], C, mnC);
  _Pragma("unroll") for (int r = 0; r < 16; ++r) p0[r] = __builtin_amdgcn_exp2f(p0[r]);
}
__device__ __forceinline__ void finishSM(f32x16& p0, f32x16& p1, float alpha, float& l_reg, bf16x8& pa0, bf16x8& pa1, bf16x8& pa2, bf16x8& pa3) {
  _Pragma("unroll") for (int r = 0; r < 16; ++r) p1[r] = __builtin_amdgcn_exp2f(p1[r]);
  float ps = 0;
  _Pragma("unroll") for (int r = 0; r < 16; ++r) ps += p0[r];
  _Pragma("unroll") for (int r = 0; r < 16; ++r) ps += p1[r];
  { auto rr = __builtin_amdgcn_permlane32_swap(__float_as_uint(ps), __float_as_uint(ps), false, false);
    ps = __uint_as_float(rr[0]) + __uint_as_float(rr[1]); }
  l_reg = l_reg * alpha + ps;
#define PK4(P, BASE, OUT) do { unsigned a0 = cvtpk(P[BASE + 0], P[BASE + 1]), a1 = cvtpk(P[BASE + 2], P[BASE + 3]);   \
    unsigned b0 = cvtpk(P[BASE + 4], P[BASE + 5]), b1 = cvtpk(P[BASE + 6], P[BASE + 7]);                              \
    auto r0 = __builtin_amdgcn_permlane32_swap(a0, b0, false, false); auto r1 = __builtin_amdgcn_permlane32_swap(a1, b1, false, false); \
    u32x4 w = {r0[0], r1[0], r0[1], r1[1]}; OUT = *reinterpret_cast<bf16x8*>(&w); } while (0)
  PK4(p0, 0, pa0); PK4(p0, 8, pa1); PK4(p1, 0, pa2); PK4(p1, 8, pa3);
#undef PK4
}
__device__ __forceinline__ void qkt(f32x16& p0, f32x16& p1, const bf16* Ks, const bf16x8* qr, int r32, int hi) {
  p0 = f32x16{}; p1 = f32x16{};
  _Pragma("unroll") for (int d0 = 0; d0 < 8; ++d0) { int cb = (d0 * 16 + hi * 8) * 2;
    bf16x8 b0 = *reinterpret_cast<const bf16x8*>((const char*)Ks + KSWZ(r32, cb));
    bf16x8 b1 = *reinterpret_cast<const bf16x8*>((const char*)Ks + KSWZ(32 + r32, cb));
    p0 = __builtin_amdgcn_mfma_f32_32x32x16_bf16(b0, qr[d0], p0, 0, 0, 0);
    p1 = __builtin_amdgcn_mfma_f32_32x32x16_bf16(b1, qr[d0], p1, 0, 0, 0); }
}
__device__ __forceinline__ int v_st(int k, int c) { const int kk = (k & ~0xC) | ((k & 4) << 1) | ((k & 8) >> 1); return ((kk >> 3) * 4 + (c >> 5)) * 512 + ((kk & 7) * 32 + (c & 31)) * 2; }
__device__ __forceinline__ int v_rd_base(int lane) { return ((lane & 3) << 3) | (((lane >> 2) & 3) << 6) | (((lane >> 4) & 1) << 5) | (((lane >> 5) & 1) << 8); }
constexpr int v_rd_off(int d0, int ks, int half) { return d0 * 512 + ks * 4096 + half * 2048; }
template <int OFF> __device__ __forceinline__ s16x4 tr_read(int vb) {
  s16x4 r; asm volatile("ds_read_b64_tr_b16 %0, %1 offset:%2" : "=&v"(r) : "v"(vb), "i"(OFF) : "memory"); return r;
}
template <int D0> __device__ __forceinline__ void pv_one(f32x16& od, int vb, bf16x8 pa0, bf16x8 pa1, bf16x8 pa2, bf16x8 pa3) {
  const s16x4 l0 = tr_read<v_rd_off(D0, 0, 0)>(vb), h0 = tr_read<v_rd_off(D0, 0, 1)>(vb), l1 = tr_read<v_rd_off(D0, 1, 0)>(vb), h1 = tr_read<v_rd_off(D0, 1, 1)>(vb);
  const s16x4 l2 = tr_read<v_rd_off(D0, 2, 0)>(vb), h2 = tr_read<v_rd_off(D0, 2, 1)>(vb), l3 = tr_read<v_rd_off(D0, 3, 0)>(vb), h3 = tr_read<v_rd_off(D0, 3, 1)>(vb);
  asm volatile("s_waitcnt lgkmcnt(0)" ::: "memory"); SBAR();
#define PK(L, H) (bf16x8){L[0], L[1], L[2], L[3], H[0], H[1], H[2], H[3]}
  od = __builtin_amdgcn_mfma_f32_32x32x16_bf16(pa0, PK(l0, h0), od, 0, 0, 0);
  od = __builtin_amdgcn_mfma_f32_32x32x16_bf16(pa1, PK(l1, h1), od, 0, 0, 0);
  od = __builtin_amdgcn_mfma_f32_32x32x16_bf16(pa2, PK(l2, h2), od, 0, 0, 0);
  od = __builtin_amdgcn_mfma_f32_32x32x16_bf16(pa3, PK(l3, h3), od, 0, 0, 0);
#undef PK
}
__device__ __forceinline__ void pv_d0(f32x16* o, int vb, bf16x8 pa0, bf16x8 pa1, bf16x8 pa2, bf16x8 pa3) {
  pv_one<0>(o[0], vb, pa0, pa1, pa2, pa3); pv_one<1>(o[1], vb, pa0, pa1, pa2, pa3); pv_one<2>(o[2], vb, pa0, pa1, pa2, pa3); pv_one<3>(o[3], vb, pa0, pa1, pa2, pa3);
}
__device__ __forceinline__ void attn_unit(const bf16* Qb, const bf16* __restrict__ Kh, const bf16* __restrict__ Vh, bf16* Ob, int seq, char* lds, const int tid,
                                          const float* __restrict__ qg, const float* __restrict__ ropetab, int n0) {
  const int wid = __builtin_amdgcn_readfirstlane(tid >> 6), lane = tid & 63, r32 = lane & 31, hi = lane >> 5;
  bf16* V_lds = (bf16*)lds; bf16* K_lds = (bf16*)(lds + 2 * SHM_V);
  float* ws = (float*)(lds + 2 * SHM_V + 2 * SHM_K) + wid * 64; float* li_l = ws; float* al_l = ws + 32;
  bf16x8 qr[8];
  const bf16* Qw = Qb + (long)(wid * QBLK + r32) * LDQ + hi * 8;
#pragma unroll
  for (int d0 = 0; d0 < 8; ++d0) qr[d0] = *reinterpret_cast<const bf16x8*>(Qw + d0 * 16);
#ifndef NO_QFIX
  {
    float qf[8][8]; float ss = 0.f;
#pragma unroll
    for (int d0 = 0; d0 < 8; ++d0)
#pragma unroll
      for (int e = 0; e < 8; ++e) { const float v = __uint_as_float(((unsigned)(unsigned short)qr[d0][e]) << 16); qf[d0][e] = v; ss += v * v; }
    { auto rr = __builtin_amdgcn_permlane32_swap(__float_as_uint(ss), __float_as_uint(ss), false, false); ss = __uint_as_float(rr[0]) + __uint_as_float(rr[1]); }
    const float rstd = 1.0f / sqrtf(ss * (1.0f / 128.0f) + EPS);
    const int n = n0 + wid * QBLK + r32;
#pragma unroll
    for (int d0 = 0; d0 < 8; ++d0) { const f32x4 g0 = *(const f32x4*)(qg + d0 * 16 + hi * 8), g1 = *(const f32x4*)(qg + d0 * 16 + hi * 8 + 4);
#pragma unroll
      for (int e = 0; e < 4; ++e) { qf[d0][e] *= rstd * g0[e]; qf[d0][4 + e] *= rstd * g1[e]; } }
#pragma unroll
    for (int d0 = 0; d0 < 4; ++d0) { const int pos = d0 < 2 ? (n >> 6) : (n & 63); const float* rp = ropetab + 2 * (pos * 32 + (d0 & 1) * 16 + hi * 8);
#pragma unroll
      for (int e = 0; e < 8; e += 2) { const f32x4 cs = *(const f32x4*)(rp + 2 * e);
        { const float t1 = qf[d0][e], t2 = qf[d0 + 4][e]; qf[d0][e] = t1 * cs[0] - t2 * cs[1]; qf[d0 + 4][e] = t2 * cs[0] + t1 * cs[1]; }
        { const float t1 = qf[d0][e + 1], t2 = qf[d0 + 4][e + 1]; qf[d0][e + 1] = t1 * cs[2] - t2 * cs[3]; qf[d0 + 4][e + 1] = t2 * cs[2] + t1 * cs[3]; } } }
#pragma unroll
    for (int d0 = 0; d0 < 8; ++d0) { u32x4 w = {cvtpk(qf[d0][0], qf[d0][1]), cvtpk(qf[d0][2], qf[d0][3]), cvtpk(qf[d0][4], qf[d0][5]), cvtpk(qf[d0][6], qf[d0][7])}; qr[d0] = *reinterpret_cast<bf16x8*>(&w); }
  }
#endif
  float m_reg = -1e30f, l_reg = 0; f32x16 o[4] = {};
  const int sr = tid >> 4, sc = (tid & 15) * 8, vst0 = v_st(sr, sc), vst1 = v_st(32 + sr, sc);
  const int vb0 = (int)(uintptr_t)V_lds + v_rd_base(lane);
  bf16x8 sr_0vs0, sr_0vs1, sr_0ks0, sr_0ks1, sr_1vs0, sr_1vs1, sr_1ks0, sr_1ks1;
#define LD8(p) (*reinterpret_cast<const bf16x8*>(p))
#define SLOAD(i, k0) do { sr_##i##vs0 = LD8(&Vh[(long)((k0) + sr) * LDK + sc]); sr_##i##vs1 = LD8(&Vh[(long)((k0) + 32 + sr) * LDK + sc]); \
    sr_##i##ks0 = LD8(&Kh[(long)((k0) + sr) * LDK + sc]); sr_##i##ks1 = LD8(&Kh[(long)((k0) + 32 + sr) * LDK + sc]); } while (0)
#define SWRITE(b, i) do { *(bf16x8*)((char*)V_lds + (b) * SHM_V + vst0) = sr_##i##vs0;          \
    *(bf16x8*)((char*)V_lds + (b) * SHM_V + vst1) = sr_##i##vs1; int kc = sc * 2;               \
    *(bf16x8*)((char*)K_lds + (b) * SHM_K + KSWZ(sr, kc)) = sr_##i##ks0;                       \
    *(bf16x8*)((char*)K_lds + (b) * SHM_K + KSWZ(32 + sr, kc)) = sr_##i##ks1; } while (0)
#define SWAIT() asm volatile("s_waitcnt vmcnt(4)" ::: "memory")
#define RESC(a) do { if (__any((a) < 1.f)) { if (hi == 0) al_l[r32] = (a); asm volatile("s_waitcnt lgkmcnt(0)" ::: "memory"); \
    _Pragma("unroll") for (int d = 0; d < 4; ++d) _Pragma("unroll") for (int r = 0; r < 16; ++r) o[d][r] *= al_l[crow(r, hi)]; } } while (0)
  f32x16 pA0, pA1, pB0, pB1; float mnA, mnB, alA, alB; bf16x8 pa0, pa1, pa2, pa3; const int NT = seq / KVBLK;
  SLOAD(0, 0); asm volatile("s_waitcnt vmcnt(0)" ::: "memory"); SWRITE(0, 0); __syncthreads();
  qkt(pA0, pA1, K_lds, qr, r32, hi); partialSM(pA0, pA1, m_reg, mnA, alA);
  SLOAD(1, KVBLK); if (2 < NT) SLOAD(0, 2 * KVBLK);
  SWAIT(); SWRITE(1, 1); __syncthreads();
  for (int j = 1; j + 1 < NT; j += 2) {
    SBAR(); qkt(pB0, pB1, (bf16*)((char*)K_lds + SHM_K), qr, r32, hi);
    finishSM(pA0, pA1, alA, l_reg, pa0, pa1, pa2, pa3); SBAR();
    SLOAD(1, (j + 2) * KVBLK); SBAR();
    pv_d0(o, vb0, pa0, pa1, pa2, pa3); partialSM(pB0, pB1, m_reg, mnB, alB);
    __syncthreads(); SWAIT(); SWRITE(0, 0);
    RESC(alB); __syncthreads();
    SBAR(); qkt(pA0, pA1, K_lds, qr, r32, hi);
    finishSM(pB0, pB1, alB, l_reg, pa0, pa1, pa2, pa3); SBAR();
    if (j + 3 < NT) SLOAD(0, (j + 3) * KVBLK); SBAR();
    pv_d0(o, vb0 + (int)SHM_V, pa0, pa1, pa2, pa3); partialSM(pA0, pA1, m_reg, mnA, alA);
    __syncthreads(); SWAIT(); SWRITE(1, 1);
    RESC(alA); __syncthreads();
  }
  SBAR(); qkt(pB0, pB1, (bf16*)((char*)K_lds + SHM_K), qr, r32, hi);
  finishSM(pA0, pA1, alA, l_reg, pa0, pa1, pa2, pa3); SBAR();
  pv_d0(o, vb0, pa0, pa1, pa2, pa3); partialSM(pB0, pB1, m_reg, mnB, alB);
  __syncthreads(); RESC(alB);
  finishSM(pB0, pB1, alB, l_reg, pa0, pa1, pa2, pa3); SBAR();
  pv_d0(o, vb0 + (int)SHM_V, pa0, pa1, pa2, pa3);
  if (hi == 0) li_l[r32] = l_reg; asm volatile("s_waitcnt lgkmcnt(0)" ::: "memory");
  float rli[16];
#pragma unroll
  for (int r = 0; r < 16; ++r) rli[r] = __builtin_amdgcn_rcpf(li_l[crow(r, hi)]);
  int l2 = __builtin_amdgcn_mbcnt_hi(~0u, __builtin_amdgcn_mbcnt_lo(~0u, 0u)); asm volatile("" : "+v"(l2));
  const int r32b = l2 & 31, hib = l2 >> 5;
  bf16* Ow = Ob + (long)(wid * QBLK) * LDO;
#pragma unroll
  for (int r = 0; r < 16; ++r) { int orow = crow(r, hib);
    _Pragma("unroll") for (int d0 = 0; d0 < 4; ++d0) Ow[(long)orow * LDO + d0 * 32 + r32b] = __float2bfloat16(o[d0][r] * rli[r]); }
  __syncthreads();
#undef LD8
#undef SLOAD
#undef SWRITE
#undef SWAIT
#undef RESC
}
#undef SBAR
}

#define XB_TMO      128
#define XB_XCNT(j)  (256  + 64 * (j))
#define XB_XSUB(j)  (1280 + 64 * (j))
#define XB_XGEN(j)  (2304 + 64 * (j))
#define XB_TOP      3328
#define XB_TOPGEN   3392
#define XCD_BAR_WORDS 3456
#define XB_SPIN_CAP (1u << 18)
__device__ __forceinline__ unsigned xb_ld(unsigned* p)              { return __hip_atomic_load(p, __ATOMIC_RELAXED, __HIP_MEMORY_SCOPE_AGENT); }
__device__ __forceinline__ unsigned xb_add(unsigned* p, unsigned v) { return __hip_atomic_fetch_add(p, v, __ATOMIC_RELAXED, __HIP_MEMORY_SCOPE_AGENT); }
__device__ __forceinline__ unsigned xb_xcc_id() { return (unsigned)__builtin_amdgcn_s_getreg((3 << 11) | 20) & 0xFu; }
#define XB_SPIN(cond, bar) do { unsigned _sp = 0; while (cond) { __builtin_amdgcn_s_sleep(1); \
    if ((++_sp & 255u) == 0u) { if (xb_ld(&(bar)[XB_TMO])) break; if (_sp > XB_SPIN_CAP) { atomicAdd(&(bar)[XB_TMO], 1u); break; } } } } while (0)
struct XcdBarrier { unsigned* bar; unsigned x; volatile LAS unsigned* st; };
__device__ __forceinline__ XcdBarrier xcd_barrier_post(unsigned* bar, volatile LAS unsigned* st) {
    XcdBarrier b; b.bar = bar; b.x = xb_xcc_id(); b.st = st;
    if (threadIdx.x == 0) (void)xb_add(&bar[XB_XCNT(b.x)], 1u);
    return b;
}
__device__ __forceinline__ void xcd_barrier_complete(unsigned* bar, unsigned x, unsigned& nloc, unsigned& nx) {
    const unsigned G = gridDim.x * gridDim.y * gridDim.z;
    unsigned sum, cnt, mine, sp = 0u;
    for (;;) {
        sum = 0u; cnt = 0u; mine = 0u;
#pragma unroll
        for (unsigned j = 0; j < 16; ++j) { const unsigned c = xb_ld(&bar[XB_XCNT(j)]); sum += c; cnt += (c > 0u) ? 1u : 0u; mine = (j == x) ? c : mine; }
        if (sum == G) break;
        __builtin_amdgcn_s_sleep(1);
        if ((++sp & 255u) == 0u) { if (xb_ld(&bar[XB_TMO])) break; if (sp > XB_SPIN_CAP) { atomicAdd(&bar[XB_TMO], 1u); break; } }
    }
    nloc = mine > 0u ? mine : 1u; nx = cnt > 0u ? cnt : 1u;
}
__device__ __forceinline__ void xcd_barrier(const XcdBarrier& b) {
    asm volatile("s_waitcnt vmcnt(0)" ::: "memory");
    __syncthreads();
    if (threadIdx.x == 0) {
        unsigned* bar = b.bar;
        __builtin_amdgcn_s_waitcnt(0);
        unsigned nloc = b.st[0], nx = b.st[1];
        if (nloc == 0u) { xcd_barrier_complete(bar, b.x, nloc, nx); b.st[0] = nloc; b.st[1] = nx; }
        const unsigned old = xb_add(&bar[XB_XSUB(b.x)], 1u);
        const unsigned gen = old / nloc;
        if (old + 1u == (gen + 1u) * nloc) {
            __builtin_amdgcn_fence(__ATOMIC_RELEASE, "agent");
            asm volatile("s_waitcnt vmcnt(0)" ::: "memory");
            const unsigned og = xb_add(&bar[XB_TOP], 1u);
            const unsigned tg = og / nx;
            if (og + 1u == (tg + 1u) * nx) xb_add(&bar[XB_TOPGEN], 1u);
            else XB_SPIN(xb_ld(&bar[XB_TOPGEN]) == tg, bar);
            __builtin_amdgcn_fence(__ATOMIC_ACQUIRE, "agent");
            xb_add(&bar[XB_XGEN(b.x)], 1u);
            asm volatile("s_waitcnt vmcnt(0)" ::: "memory");
        } else {
            XB_SPIN(xb_ld(&bar[XB_XGEN(b.x)]) == gen, bar);
            __builtin_amdgcn_fence(__ATOMIC_ACQUIRE, "agent");
            asm volatile("s_waitcnt vmcnt(0)" ::: "memory");
        }
    }
    __syncthreads();
}

struct Params {
    const float *x, *c, *ctx, *c_ctx, *w_ada, *b_ada, *norm_ffn1, *w_ffn1_in, *w_ffn1_out, *norm_mix, *w_in, *q_norm, *k_norm, *w_ab, *w_fb, *w_out, *norm_ffn2, *w_ffn2_in, *w_ffn2_out;
    float* out; unsigned char* ws; int st_lo, st_hi;
};

__device__ __forceinline__ void transpose_item(const float* __restrict__ W, int K, int N, bf16_t* __restrict__ WT, int kb, int n0, int drow0, int lane, int ldd = 0) {
    if (ldd == 0) ldd = K;
    const int ng = lane & 15, kq = lane >> 4, k0 = 32 * kb + 8 * kq;
    const float* src = W + (size_t)k0 * N + n0 + 4 * ng;
    f32x4 v[8];
#pragma unroll
    for (int i = 0; i < 8; ++i) v[i] = __builtin_nontemporal_load((const f32x4*)(src + (size_t)i * N));
    bf16_t* dst = WT + (size_t)(drow0 + 4 * ng) * ldd + k0;
#pragma unroll
    for (int j = 0; j < 4; ++j) { u32x4 o; o.x = cvt_pk_bf16(v[0][j], v[1][j]); o.y = cvt_pk_bf16(v[2][j], v[3][j]); o.z = cvt_pk_bf16(v[4][j], v[5][j]); o.w = cvt_pk_bf16(v[6][j], v[7][j]);
        *(u32x4*)(dst + (size_t)j * ldd) = o; }
}

__device__ __forceinline__ void prep_phase(const Params& kp_, LAS unsigned char* lds, int tid, int lane, int wave, int G) {
    const Params* kp = &kp_; unsigned char* ws = kp->ws;
    LAS float* tab2048 = (LAS float*)(lds + LDS_MISC);
    LAS float* tab128 = (LAS float*)(lds + LDS_MISC + 8192);
    if (blockIdx.x < 144) {
        LAS float* s_l = (LAS float*)lds;
        LAS float* red = (LAS float*)(lds + 36864);
        for (int i = tid; i < 9216; i += 512) { const int r = i >> 10, k = i & 1023; const float v = (r < 8) ? kp->c[r * 1024 + k] : kp->c_ctx[k]; s_l[i] = v / (1.f + expf(-v)); }
        __syncthreads();
        const int c0 = blockIdx.x * 64, kr = lane >> 4, cgp = lane & 15;
        f32x4 a0 = {}, a1 = {}, a2 = {}, a3 = {}, a4 = {}, a5 = {}, a6 = {}, a7 = {}, a8 = {};
        const float* wp = kp->w_ada + (size_t)(wave * 128 + kr) * NMOD + c0 + 4 * cgp;
#pragma unroll 8
        for (int i = 0; i < 32; ++i) { const f32x4 w = __builtin_nontemporal_load((const f32x4*)(wp + (size_t)i * 4 * NMOD)); const int k = wave * 128 + 4 * i + kr;
            a0 += w * s_l[k]; a1 += w * s_l[1024 + k]; a2 += w * s_l[2048 + k]; a3 += w * s_l[3072 + k]; a4 += w * s_l[4096 + k];
            a5 += w * s_l[5120 + k]; a6 += w * s_l[6144 + k]; a7 += w * s_l[7168 + k]; a8 += w * s_l[8192 + k]; }
#define RED9(a, r) do { _Pragma("unroll") for (int e = 0; e < 4; ++e) { float v = a[e]; v += __shfl_xor(v, 16); v += __shfl_xor(v, 32); if (lane < 16) red[(wave * 9 + r) * 64 + 4 * cgp + e] = v; } } while (0)
        RED9(a0, 0); RED9(a1, 1); RED9(a2, 2); RED9(a3, 3); RED9(a4, 4); RED9(a5, 5); RED9(a6, 6); RED9(a7, 7); RED9(a8, 8);
#undef RED9
        __syncthreads();
        float* mod = (float*)(ws + WS_MOD);
        for (int i = tid; i < 576; i += 512) { const int r = i >> 6, col = i & 63; float s = 0.f;
#pragma unroll
            for (int w = 0; w < 8; ++w) s += red[(w * 9 + r) * 64 + col];
            mod[r * NMOD + c0 + col] = s + kp->b_ada[c0 + col]; }
    }
    __syncthreads();
    const int gw = blockIdx.x * 8 + wave, NGW = G * 8;
    if (blockIdx.x == G - 1) {
        float* rt = (float*)(ws + WS_ROPE);
        for (int i = tid; i < 2048; i += 512) { const int pos = i >> 5, j = i & 31; const float invf = powf(10000.0f, -(float)(2 * j) / 64.0f); const float ang = (float)pos * invf;
            rt[2 * i] = cosf(ang); rt[2 * i + 1] = sinf(ang); }
    }
    constexpr int I_1IN = 32 * 88;
    for (int r = (gw + 1152) % NGW; r < I_1IN; r += NGW) { const int kb = r / 88, n0 = (r % 88) * 64; const int isup = n0 >= DFF, j = isup ? n0 - DFF : n0;
        transpose_item(kp->w_ffn1_in, 1024, 2 * DFF, (bf16_t*)(ws + WS_W1IN), kb, n0, 256 * (j >> 7) + (j & 127) + 128 * isup, lane); }
}

__device__ __forceinline__ void late_weights(const Params& kp_, LAS unsigned char* lds, int tid, int lane, int widx, int nw) {
    const Params* kp = &kp_; unsigned char* ws = kp->ws;
    LAS float* tab2048 = (LAS float*)(lds + LDS_MISC);
    LAS float* tab128 = (LAS float*)(lds + LDS_MISC + 8192);
    for (int i = tid; i < 2048; i += 512) tab2048[i] = cospif((float)i * (1.0f / 1024.0f));
    if (tid < 128) tab128[tid] = cospif((float)tid * (1.0f / 64.0f));
    __syncthreads();
    constexpr int I_FOLD = 1024, I_IN = 32 * 64, I_AB = 32 * 16, I_FB = 16 * 16, I_O = 32 * 16, I_1OUT = 88 * 16;
    for (int r = widx; r < I_1OUT; r += nw) { const int kb = r >> 4, n0 = (r & 15) * 64; transpose_item(kp->w_ffn1_out, DFF, 1024, (bf16_t*)(ws + WS_W1OUT), kb, n0, n0, lane); }
    {
        bf16_t* dft = (bf16_t*)(ws + WS_DFT);
        for (int e8 = widx * 64 + lane; e8 < 1024 * 512; e8 += nw * 64) {
            const int k = e8 >> 9, kp0 = (e8 & 511) * 8, cs = kp0 >> 11, n0 = kp0 & 2047; float v[8];
#pragma unroll
            for (int e = 0; e < 8; ++e) { int idx = (k * (n0 + e)) & 2047; if (cs) idx = (idx + 512) & 2047; v[e] = tab2048[idx] * (1.0f / 512.0f); }
            u32x4 o; o.x = cvt_pk_bf16(v[0], v[1]); o.y = cvt_pk_bf16(v[2], v[3]); o.z = cvt_pk_bf16(v[4], v[5]); o.w = cvt_pk_bf16(v[6], v[7]);
            *(u32x4*)(dft + (size_t)e8 * 8) = o;
        }
    }
    for (int r = widx; r < I_FOLD; r += nw) {
        const int jt = r & 7, g = (r >> 3) & 3, kb = r >> 5, k0 = kb * 32;
        const int jj = jt * 32 + (lane & 31), cs = jj >> 7, m = jj & 127, hi = lane >> 5;
        const float* wrow = kp->w_in + (size_t)(k0 + (lane & 31)) * 4096 + 1536 + g * 128 + hi;
        f32x16 acc = {};
#pragma unroll 8
        for (int s2 = 0; s2 < 64; ++s2) { const int c = 2 * s2 + hi; const float a = wrow[2 * s2]; int idx = (c * m) & 127; if (cs) idx = (idx + 96) & 127;
            acc = __builtin_amdgcn_mfma_f32_32x32x2f32(a, tab128[idx], acc, 0, 0, 0); }
        bf16_t* WfT = (bf16_t*)(ws + WS_WF) + (size_t)(cs * 512 + g * 128 + m) * 1024 + k0 + 4 * hi;
#pragma unroll
        for (int q = 0; q < 4; ++q) { u32x2 o; o.x = cvt_pk_bf16(acc[4 * q], acc[4 * q + 1]); o.y = cvt_pk_bf16(acc[4 * q + 2], acc[4 * q + 3]); *(u32x2*)(WfT + 8 * q) = o; }
    }
    for (int r = widx; r < I_IN; r += nw) { const int kb = r >> 6, n0 = (r & 63) * 64; if (n0 < 1536 || n0 >= 2048) transpose_item(kp->w_in, 1024, 4096, (bf16_t*)(ws + WS_WIN), kb, n0, n0 < 1536 ? n0 : n0 - 512, lane); }
    for (int r = widx; r < I_AB; r += nw) { const int kb = r >> 4, n0 = (r & 15) * 64; transpose_item(kp->w_ab, 1024, 1024, (bf16_t*)(ws + WS_WAB), kb, n0, n0, lane); }
    for (int r = widx; r < I_O; r += nw) { const int kb = r >> 4, n0 = (r & 15) * 64; transpose_item(kp->w_out, 1024, 1024, (bf16_t*)(ws + WS_WO), kb, n0, n0, lane); }
}

template <bool LAT_BF> __device__ __forceinline__ void norm_phase(const float* lat, const float* ctxp, const float* ctxp2, int nrows, const float* gain, const float* mod, int sh_off, int sc_off, bf16_t* A, int gw, int NGW, int lane) {
    for (int r = gw; r < nrows; r += NGW) {
        const bool isctx = r >= NLAT; const float* src = isctx ? ctxp + (size_t)(r - NLAT) * DM : lat + (size_t)r * DM; const int mrow = isctx ? 8 : (r >> 11);
        f32x4 v[4]; float ss = 0.f;
#pragma unroll
        for (int j = 0; j < 4; ++j) { if (LAT_BF && !isctx) { const u32x2 w = __builtin_nontemporal_load((const u32x2*)((const bf16_t*)lat + (size_t)r * DM + 4 * lane + 256 * j)); v[j] = (f32x4){__uint_as_float(w.x << 16), __uint_as_float(w.x & 0xffff0000u), __uint_as_float(w.y << 16), __uint_as_float(w.y & 0xffff0000u)}; } else v[j] = __builtin_nontemporal_load((const f32x4*)(src + 4 * lane + 256 * j)); if (isctx && ctxp2) v[j] += *(const f32x4*)(ctxp2 + (size_t)(r - NLAT) * DM + 4 * lane + 256 * j); ss += (v[j][0] * v[j][0] + v[j][1] * v[j][1]) + (v[j][2] * v[j][2] + v[j][3] * v[j][3]); }
        const float rstd = 1.0f / sqrtf(wave_sum(ss) * (1.0f / DM) + EPS);
        const float* mp = mod + mrow * NMOD;
#pragma unroll
        for (int j = 0; j < 4; ++j) { const int c = 4 * lane + 256 * j; const f32x4 g = *(const f32x4*)(gain + c), sh = *(const f32x4*)(mp + sh_off + c), sc = *(const f32x4*)(mp + sc_off + c);
            const f32x4 o = (v[j] * rstd) * g * (sc + 1.0f) + sh; u32x2 w; w.x = cvt_pk_bf16(o[0], o[1]); w.y = cvt_pk_bf16(o[2], o[3]);
            *(u32x2*)(A + (size_t)r * DM + c) = w; }
    }
}

__device__ __forceinline__ void fix_head(bf16_t* hp, const float* g, const float* ropetab, int n, bool rope, int lane) {
    float t1 = bf2f(hp[lane]), t2 = bf2f(hp[lane + 64]);
    const float rstd = 1.0f / sqrtf(wave_sum(t1 * t1 + t2 * t2) * (1.0f / 128.0f) + EPS);
    t1 = t1 * rstd * g[lane]; t2 = t2 * rstd * g[lane + 64];
    float o1 = t1, o2 = t2;
    if (rope) { const int pos = lane < 32 ? (n >> 6) : (n & 63); const float c = ropetab[2 * (pos * 32 + (lane & 31))], s = ropetab[2 * (pos * 32 + (lane & 31)) + 1]; o1 = t1 * c - t2 * s; o2 = t2 * c + t1 * s; }
    hp[lane] = f2bf(o1); hp[lane + 64] = f2bf(o2);
}
__device__ __forceinline__ void fixup_phase(unsigned char* ws, const float* q_norm, const float* k_norm, int gw, int NGW, int lane) {
    bf16_t* Q = (bf16_t*)(ws + WS_Q); bf16_t* Kb = (bf16_t*)(ws + WS_K); const float* rt = (const float*)(ws + WS_ROPE);
    for (int r = gw; r < NTOK; r += NGW) {
        if (r < NLAT) { const int b = r >> 11, n = r & 2047;
            for (int h = 0; h < 8; ++h) fix_head(Q + (size_t)r * DM + h * 128, q_norm, rt, n, true, lane);
            for (int h = 0; h < 2; ++h) fix_head(Kb + (size_t)(b * SKV + CTXL + n) * 256 + h * 128, k_norm, rt, n, true, lane);
        } else { const int rc = r - NLAT, b = rc >> 8, n = rc & 255;
            for (int h = 0; h < 2; ++h) fix_head(Kb + (size_t)(b * SKV + n) * 256 + h * 128, k_norm, rt, 0, false, lane); }
    }
}

constexpr int NSTEPS = 15;
__host__ __device__ constexpr bool sync_after(int st) { return !(st == 7 || st == 9); }

__global__ void __launch_bounds__(512, 2) mk_fwd(Params p) {
    extern __shared__ __attribute__((aligned(16))) unsigned char lds_raw[];
    LAS unsigned char* lds = (LAS unsigned char*)lds_raw;
    const int G = gridDim.x, c = blockIdx.x, NGW = G * 8;
    const int lo = p.st_lo, hi = p.st_hi;
    unsigned char* const ws = p.ws;
    const float* const mod = (const float*)(ws + WS_MOD);
    bf16_t* const Abuf = (bf16_t*)(ws + WS_A);
#define IN(k) (lo <= (k) && (k) < hi)
    volatile LAS unsigned* bst = (volatile LAS unsigned*)(lds + LDS_MISC + 12288);
    if (threadIdx.x < 2) bst[threadIdx.x] = 0u;
    __syncthreads();
    XcdBarrier gbar; gbar.bar = (unsigned*)(ws + WS_BAR); gbar.x = 0; gbar.st = bst;
    if (hi - lo > 1) gbar = xcd_barrier_post((unsigned*)(ws + WS_BAR), bst);
    if (hi < 0) cg::this_grid().sync();
#define SEAM(k) do { if (IN(k) && IN((k) + 1)) { if (sync_after(k)) xcd_barrier(gbar); else { __syncthreads(); } } } while (0)
#define TIDS() int tid = threadIdx.x; asm volatile("" : "+v"(tid)); const int lane = tid & 63, wave = __builtin_amdgcn_readfirstlane(tid >> 6), gw = c * 8 + wave; (void)lane; (void)gw
#define GEMM1P(PRM, KK, a, b, nm, nn, kd, rm) do { const pg8::Sched S{(a), nullptr, nullptr, (b), nullptr, nullptr, (nm), 1, 1, (nn), 1, 1, (kd), (kd), (kd), (nm) * (nn), 0, 0, G, c, (KK), 0, (KK) / 64, (KK) / 64, (KK) / 64, 0, 0}; \
        const pg8::Epi E{ws, p.out, p.x, p.ctx, (rm), p.k_norm, p.norm_ffn2, (const LAS float*)(lds + LDS_MISC)}; pg8::gemm_phase<true, true, PRM>(lds, S, E, tid); } while (0)
#define GEMM1(KK, a, b, nm, nn, kd, rm) GEMM1P(true, KK, a, b, nm, nn, kd, rm)
    if (IN(0)) { TIDS(); prep_phase(p, lds, tid, lane, wave, G); }
    SEAM(0);
    if (IN(1)) { TIDS(); norm_phase<false>(p.x, p.ctx, nullptr, NTOK, p.norm_ffn1, mod, 0 * DM, 1 * DM, Abuf, gw, NGW, lane); }
    SEAM(1);
    if (IN(2)) { TIDS(); GEMM1(1024, Abuf, (const bf16_t*)(ws + WS_W1IN), NTOK / 256, 22, pg8::K_SWIGLU, 0);
        constexpr int NBUSY = (NTOK / 256) * 22 - 6 * 256;
        int t2 = threadIdx.x; asm volatile("" : "+v"(t2)); const int w2 = __builtin_amdgcn_readfirstlane(t2 >> 6);
        if (G == 256 && c >= NBUSY) late_weights(p, lds, t2, t2 & 63, (c - NBUSY) * 8 + w2, (256 - NBUSY) * 8);
        else if (G != 256) late_weights(p, lds, t2, t2 & 63, c * 8 + w2, NGW); }
    SEAM(2);
    if (IN(3)) { TIDS();
        const bf16_t* Hc = (const bf16_t*)(ws + WS_H) + (size_t)NLAT * DFF;
        const pg8::Sched S{(const bf16_t*)(ws + WS_H), Hc, Hc, (const bf16_t*)(ws + WS_W1OUT), (const bf16_t*)(ws + WS_W1OUT), (const bf16_t*)(ws + WS_W1OUT),
                           64, 8, 8, 4, 4, 4, pg8::K_RES, pg8::K_RESC0, pg8::K_RESC1, 256, 32, 32, G, c, DFF, 0, 44, 22, 22, 0, DFF / 2};
        const pg8::Epi E{ws, p.out, p.x, p.ctx, 0, p.k_norm, p.norm_ffn2, (const LAS float*)(lds + LDS_MISC)}; pg8::gemm_phase<true, true>(lds, S, E, tid); }
    SEAM(3);
    if (IN(4)) { TIDS(); norm_phase<true>(p.out, (const float*)(ws + WS_CTX1), (const float*)(ws + WS_CTX1B), NTOK, p.norm_mix, mod, 3 * DM, 4 * DM, Abuf, gw, NGW, lane); }
    SEAM(4);
    if (IN(5)) { TIDS();
        const pg8::Sched S{Abuf, (const bf16_t*)(ws + WS_WF), Abuf + (size_t)NLAT * DM, (const bf16_t*)(ws + WS_WIN), Abuf, (const bf16_t*)(ws + WS_WIN) + (size_t)1024 * DM,
                           64, 4, 8, 14, 64, 2, pg8::K_INPROJ, pg8::K_FTSWAP, pg8::K_CTXKV, 64 * 14, 256, 16, G, c, 1024, 0, 16, 16, 16, 0, 0};
        const pg8::Epi E{ws, p.out, p.x, p.ctx, 0, p.k_norm, p.norm_ffn2, (const LAS float*)(lds + LDS_MISC)}; pg8::gemm_phase<true, true>(lds, S, E, tid);
        if (G == 256 && c >= 144) {
            int t2 = threadIdx.x; asm volatile("" : "+v"(t2)); const int lane = t2 & 63;
            const int w2 = (c - 144) * 8 + __builtin_amdgcn_readfirstlane(t2 >> 6), nw2 = 112 * 8;
            for (int r = w2; r < 32 * 88; r += nw2) { const int kb = r / 88, n0 = (r % 88) * 64; const int isup = n0 >= DFF, j = isup ? n0 - DFF : n0;
                transpose_item(p.w_ffn2_in, 1024, 2 * DFF, (bf16_t*)(ws + WS_W2IN), kb, n0, 256 * (j >> 7) + (j & 127) + 128 * isup, lane); }
            for (int r = w2; r < 88 * 16; r += nw2) { const int kb = r >> 4, n0 = (r & 15) * 64; transpose_item(p.w_ffn2_out, DFF, 1024, (bf16_t*)(ws + WS_W2OUT), kb, n0, n0, lane); }
            for (int r = w2; r < 16 * 16; r += nw2) { const int hf = 0, q = r & 255, kb = q >> 4, n0 = (q & 15) * 64;
                transpose_item(p.w_fb, 512, 1024, (bf16_t*)(ws + WS_WFB2) + hf * 512, kb, n0, n0, lane, 1024); }
        } }
    if (IN(5) && IN(7)) xcd_barrier(gbar);
    if (IN(7)) { TIDS();
        const pg8::Sched S{(const bf16_t*)(ws + WS_DFT), nullptr, nullptr, (const bf16_t*)(ws + WS_FT), nullptr, nullptr, 4, 1, 1, 16, 1, 1, pg8::K_FOUR2, pg8::K_FOUR2, pg8::K_FOUR2, 256, 0, 0, G, c, 4096, 1, 16, 16, 16, 0, 0};
        const pg8::Epi E{ws, p.out, p.x, p.ctx, 0, p.k_norm, p.norm_ffn2, (const LAS float*)(lds + LDS_MISC)}; pg8::gemm_phase<true, true>(lds, S, E, tid);
        if (c < 192) {
        {
            const bf16_t* FTp = (const bf16_t*)(ws + WS_FT); bf16_t* YFp = (bf16_t*)(ws + WS_YF);
            for (int j = gw; j < 4096; j += 192 * 8) { const bf16_t* src = FTp + (size_t)j * 4096 + 32 * lane; float acc_ = 0.f;
#pragma unroll
                for (int q4 = 0; q4 < 4; ++q4) { f32x4 a0, a1; unpack8(*(const u32x4*)(src + 8 * q4), a0, a1); acc_ += (a0[0] - a0[1]) + (a0[2] - a0[3]) + (a1[0] - a1[1]) + (a1[2] - a1[3]); }
                const float tot = wave_sum(acc_) * (1.0f / 512.0f);
                if (lane == 0) YFp[(size_t)((j >> 9) * SEQ + 1024) * 1024 + (j & 511)] = f2bf(tot); }
        }
        {
            int t2 = threadIdx.x; asm volatile("" : "+v"(t2)); const int ln = t2 & 63, wv = __builtin_amdgcn_readfirstlane(t2 >> 6);
            const bf16_t* W2 = (const bf16_t*)(ws + WS_W2IN); float* sw3 = (float*)(ws + WS_SW3);
            for (int n = c * 8 + wv; n < 2 * DFF; n += 192 * 8) {
                const u32x4 w0 = *(const u32x4*)(W2 + (size_t)n * DM + 8 * ln), w1 = *(const u32x4*)(W2 + (size_t)n * DM + 512 + 8 * ln);
                f32x4 a0, a1, a2, a3; unpack8(w0, a0, a1); unpack8(w1, a2, a3);
#pragma unroll
                for (int b = 0; b < 8; ++b) { const float* sh = mod + b * NMOD + 6 * DM + 8 * ln;
                    const f32x4 s0 = *(const f32x4*)sh, s1 = *(const f32x4*)(sh + 4), s2 = *(const f32x4*)(sh + 512), s3 = *(const f32x4*)(sh + 516);
                    const f32x4 pr = a0 * s0 + a1 * s1 + a2 * s2 + a3 * s3; const float d = wave_sum((pr[0] + pr[1]) + (pr[2] + pr[3]));
                    if (ln == 0) sw3[b * (2 * DFF) + n] = d; }
            }
        }
        } }
    SEAM(7);
    if (IN(8)) { TIDS();
        const int x = c & 7, s = c >> 3; const int j0 = 2 * s; int nj = 2; asm volatile("" : "+s"(nj));
#pragma unroll 1
        for (int i = 0; i < nj; ++i) { const int j = j0 + i, kvh = j >> 5, h = kvh * 4 + ((j >> 3) & 3), qb = j & 7;
            att::bf16* Qb = (att::bf16*)(ws + WS_Q) + (size_t)(x * SEQ + qb * 256) * DM + h * 128;
            const att::bf16* Kh = (const att::bf16*)(ws + WS_K) + (size_t)x * SKV * 256 + kvh * 128;
            const att::bf16* Vh = (const att::bf16*)(ws + WS_V) + (size_t)x * SKV * 256 + kvh * 128;
            const int tu = tid;
            att::attn_unit(Qb, Kh, Vh, Qb, SKV, (char*)lds_raw, tu, p.q_norm, (const float*)(ws + WS_ROPE), qb * 256); }
    }
    SEAM(8);
    if (IN(9)) { TIDS();
        const pg8::Sched S{(const bf16_t*)(ws + WS_Q), (const bf16_t*)(ws + WS_YF), nullptr, (const bf16_t*)(ws + WS_WAB), (const bf16_t*)(ws + WS_WFB2), nullptr,
                           64, 64, 1, 4, 4, 1, pg8::K_BRA, pg8::K_BRB, pg8::K_BRB, 256, 256, 0, G, c, 1024, 2, 16, 8, 16, 0, 0};
        const pg8::Epi E{ws, p.out, p.x, p.ctx, 0, p.k_norm, p.norm_ffn2, (const LAS float*)(lds + LDS_MISC)}; pg8::gemm_phase<true, true>(lds, S, E, tid); }
    SEAM(9);
    SEAM(10);
    if (IN(11)) { TIDS(); GEMM1(1024, (const bf16_t*)(ws + WS_GA), (const bf16_t*)(ws + WS_WO), 64, 4, pg8::K_RES, 1); }
    if (IN(11) && IN(13)) xcd_barrier(gbar);
    if (IN(13)) { TIDS();
        {
            LAS float* rs = (LAS float*)(lds + LDS_MISC); const float* st3 = (const float*)(ws + WS_ST3) + (size_t)(c & 7) * 2048 * 16;
            for (int r = tid; r < 2048; r += 512) { const f32x4* sp = (const f32x4*)(st3 + (size_t)r * 16); const f32x4 q = (sp[0] + sp[1]) + (sp[2] + sp[3]);
                rs[r] = 1.0f / sqrtf(((q[0] + q[1]) + (q[2] + q[3])) * (1.0f / DM) + EPS); }
            __syncthreads();
        }
        GEMM1(1024, Abuf, (const bf16_t*)(ws + WS_W2IN), 64, 22, pg8::K_SWIGLU, 3); }
    SEAM(13);
    if (IN(14)) { TIDS(); GEMM1(DFF, (const bf16_t*)(ws + WS_H), (const bf16_t*)(ws + WS_W2OUT), 64, 4, pg8::K_RES, 2); }
#undef IN
#undef SEAM
#undef TIDS
#undef GEMM1
#undef GEMM1P
}

extern "C" void kernel_launch(void* const* d_in, const int* in_sizes, int n_in, void* d_out, int out_size, void* d_ws, size_t ws_size, hipStream_t stream) {
    static int grid = 0;
    if (grid == 0) {
        if (n_in != 19 || out_size != NLAT * DM || ws_size < WS_END) { fprintf(stderr, "kernel_launch: unexpected shapes (n_in %d out %d ws %zu)\n", n_in, out_size, ws_size); grid = -1; return; }
        int dev = 0, cus = 0, per_cu = 0;
        hipGetDevice(&dev); hipDeviceGetAttribute(&cus, hipDeviceAttributeMultiprocessorCount, dev);
        if (hipFuncSetAttribute((const void*)mk_fwd, hipFuncAttributeMaxDynamicSharedMemorySize, LDS_BYTES) != hipSuccess) { fprintf(stderr, "kernel_launch: hipFuncSetAttribute failed\n"); grid = -1; return; }
        hipOccupancyMaxActiveBlocksPerMultiprocessor(&per_cu, (const void*)mk_fwd, 512, LDS_BYTES);
        (void)hipGetLastError();
        if (cus != 256 || per_cu < 1) fprintf(stderr, "kernel_launch: note: cus %d per_cu %d (built for 256 x 1)\n", cus, per_cu);
        grid = 256;
    }
    if (grid < 0) return;
    Params p{};
    const float** pp = (const float**)&p;
    for (int i = 0; i < 19; ++i) pp[i] = (const float*)d_in[i];
    p.out = (float*)d_out; p.ws = (unsigned char*)d_ws;
    if (hipMemsetAsync((char*)d_ws + WS_BAR, 0, BAR_BYTES, stream) != hipSuccess) { fprintf(stderr, "kernel_launch: memset failed\n"); return; }
#if MK_MULTI
    int lo = 0;
    for (int st = 0; st < NSTEPS; ++st) {
        if (sync_after(st) || st == NSTEPS - 1) { p.st_lo = lo; p.st_hi = st + 1; hipLaunchKernelGGL(mk_fwd, dim3(grid), dim3(512), LDS_BYTES, stream, p); lo = st + 1; }
    }
#else
    p.st_lo = 0; p.st_hi = NSTEPS;
    void* args[] = {&p};
    hipError_t e = hipLaunchCooperativeKernel((const void*)mk_fwd, dim3(grid), dim3(512), args, LDS_BYTES, stream);
    if (e != hipSuccess) fprintf(stderr, "cooperative launch failed: %s\n", hipGetErrorString(e));
#endif
}
```

```cpp
#include <hip/hip_runtime.h>
#include <hip/hip_cooperative_groups.h>
#include <hip/hip_bf16.h>
#include <cstdio>
#include <cstdint>
namespace cg = cooperative_groups;

#ifndef MK_MULTI
#define MK_MULTI 0
#endif

#define LAS __attribute__((address_space(3)))
typedef unsigned short bf16_t;
typedef short bf16x8 __attribute__((ext_vector_type(8)));
typedef float f32x4 __attribute__((ext_vector_type(4)));
typedef float f32x16 __attribute__((ext_vector_type(16)));
typedef unsigned u32x4 __attribute__((ext_vector_type(4)));
typedef unsigned u32x2 __attribute__((ext_vector_type(2)));
typedef short s16x4 __attribute__((ext_vector_type(4)));

constexpr int DM = 1024, NB = 8, SEQ = 2048, CTXL = 256, NLAT = NB * SEQ, NCTX = NB * CTXL, NTOK = NLAT + NCTX;
constexpr int DFF = 2816, NMOD = 9 * DM, SKV = CTXL + SEQ;
constexpr float EPS = 1e-6f;

constexpr size_t MiB = 1u << 20;
constexpr size_t WS_MOD = 0, WS_ROPE = 384 * 1024, WS_BAR = 512 * 1024, WS_CNT = WS_BAR + 16384, BAR_BYTES = 16384 + 65536;
constexpr size_t WS_W1IN = 1 * MiB, WS_W1OUT = 12 * MiB, WS_WIN = 18 * MiB, WS_WF = 25 * MiB, WS_WAB = 27 * MiB, WS_WFB = 29 * MiB, WS_WO = 30 * MiB;
constexpr size_t WS_W2IN = 32 * MiB, WS_W2OUT = 43 * MiB, WS_DFT = 49 * MiB, WS_A = 65 * MiB, WS_CTX1 = 101 * MiB, WS_H = 109 * MiB;
constexpr size_t WS_Q = 109 * MiB, WS_K = 141 * MiB, WS_V = 150 * MiB, WS_GA = 159 * MiB, WS_GF = 191 * MiB, WS_FT = 223 * MiB, WS_YF = WS_A, WS_CTX1B = WS_FT, WS_X2 = WS_FT, WS_WFB2 = WS_W1IN, WS_ST3 = WS_CTX1, WS_SW3 = WS_CTX1 + 2 * MiB, WS_END = 255 * MiB;

constexpr int LDS_BYTES = 147456;
constexpr int LDS_MISC = 131072;

__device__ __forceinline__ unsigned cvt_pk_bf16(float lo, float hi) { unsigned r; asm volatile("v_cvt_pk_bf16_f32 %0, %1, %2" : "=v"(r) : "v"(lo), "v"(hi)); return r; }
__device__ __forceinline__ u32x4 pack8(f32x4 a, f32x4 b) { u32x4 w; w.x = cvt_pk_bf16(a[0], a[1]); w.y = cvt_pk_bf16(a[2], a[3]); w.z = cvt_pk_bf16(b[0], b[1]); w.w = cvt_pk_bf16(b[2], b[3]); return w; }
__device__ __forceinline__ void st16_wt(void* p, u32x4 v) {
    asm volatile("global_store_dwordx4 %0, %1, off sc1\n\ts_nop 1" :: "v"(p), "v"(v) : "memory");
}
__device__ __forceinline__ void unpack8(u32x4 w, f32x4& a, f32x4& b) {
    a[0] = __uint_as_float(w.x << 16); a[1] = __uint_as_float(w.x & 0xffff0000u); a[2] = __uint_as_float(w.y << 16); a[3] = __uint_as_float(w.y & 0xffff0000u);
    b[0] = __uint_as_float(w.z << 16); b[1] = __uint_as_float(w.z & 0xffff0000u); b[2] = __uint_as_float(w.w << 16); b[3] = __uint_as_float(w.w & 0xffff0000u); }
__device__ __forceinline__ float bf2f(bf16_t v) { return __uint_as_float((unsigned)v << 16); }
__device__ __forceinline__ bf16_t f2bf(float f) { unsigned u = __float_as_uint(f); return (bf16_t)((u + 0x7fffu + ((u >> 16) & 1u)) >> 16); }
__device__ __forceinline__ float sigmoidf_(float v) { return __builtin_amdgcn_rcpf(1.f + __builtin_amdgcn_exp2f(-1.4426950408889634f * v)); }
__device__ __forceinline__ float wave_sum(float v) {
#pragma unroll
    for (int o = 1; o < 64; o <<= 1) v += __shfl_xor(v, o);
    return v;
}

namespace pg8 {
constexpr int BM = 256, BK = 64, HALF = 128, HTB = HALF * BK * 2, STAGE_BYTES = 8 * HTB, NXCD = 8, WGM = 8;
__host__ __device__ __forceinline__ int lds_byte(int r, int c) { const int st = (r >> 4) * 2 + (c >> 5), rr = r & 15, cc = c & 31, ob = rr * 64 + cc * 2; return st * 1024 + (ob ^ (((ob >> 9) & 1) << 5)); }
__host__ __device__ __forceinline__ void stage_rc(int b, int& R, int& C) { const int st = b / 1024, sb = b % 1024, swz = sb ^ (((sb >> 9) & 1) << 5); R = (st >> 1) * 16 + swz / 64; C = (st & 1) * 32 + (swz % 64) / 2; }
__host__ __device__ __forceinline__ int perm32(int rho) { const int n = rho >> 4, i = rho & 15; return 8 * (i >> 2) + 4 * n + (i & 3); }

struct Unit { int pm, pn, sub, q; };
enum Kind { K_SWIGLU = 0, K_RES = 1, K_INPROJ = 2, K_FTSWAP = 3, K_CTXKV = 4, K_FOUR2 = 5, K_BRA = 6, K_BRB = 7, K_RESC0 = 8, K_RESC1 = 9 };

struct Sched {
    const bf16_t *A0, *A1, *A2, *B0, *B1, *B2; int nM0, nM1, nM2, nN0, nN1, nN2, k0, k1, k2; int n0, n1, n2; int G, c, K, direct; int kt0, kt1, kt2, ko1, ko2;
    static __device__ __forceinline__ int sel3(int sub, int v0, int v1, int v2) { const int m1 = -(int)(sub == 1), m2 = -(int)(sub == 2); return v0 ^ ((v0 ^ v1) & m1) ^ ((v0 ^ v2) & m2); }
    static __device__ __forceinline__ unsigned long long sel3p(int sub, const void* p0, const void* p1, const void* p2) {
        const unsigned long long v0 = (unsigned long long)p0, v1 = (unsigned long long)p1, v2 = (unsigned long long)p2, m1 = -(unsigned long long)(sub == 1), m2 = -(unsigned long long)(sub == 2);
        return v0 ^ ((v0 ^ v1) & m1) ^ ((v0 ^ v2) & m2); }
    __device__ __forceinline__ bool next(int i, Unit& u) const {
        u.q = 0;
        if (direct == 1) { if (i > 0) return false; const int x = c & 7, s = c >> 3, r = s & 7; u.sub = 0; u.q = s >> 3; u.pm = r & 3; u.pn = 2 * x + (r >> 2); return true; }
        if (direct == 2) {
            if (i > 1 || c >= n0) return false; u.sub = i;
            const int nwg = nM0 * nN0; int wgid; { const int q = nwg / NXCD, r = nwg % NXCD, xcd = c % NXCD, off = c / NXCD; wgid = (xcd < r ? xcd * (q + 1) : r * (q + 1) + (xcd - r) * q) + off; }
            const int nig = WGM * nN0, gid = wgid / nig, fm = gid * WGM, gsz = (nM0 - fm) < WGM ? (nM0 - fm) : WGM;
            u.pm = fm + ((wgid % nig) % gsz); u.pn = (wgid % nig) / gsz; return true; }
        const long L = (long)i * G + c;
        if (L >= n0 + n1 + n2) return false;
        const int sub = (L >= n0) + (L >= n0 + n1); u.sub = sub;
        const int l = (int)L - sel3(sub, 0, n0, n0 + n1), nM = sel3(sub, nM0, nM1, nM2), nN = sel3(sub, nN0, nN1, nN2);
        const int nwg = nM * nN; int wgid; { const int q = nwg / NXCD, r = nwg % NXCD, xcd = l % NXCD, off = l / NXCD; wgid = (xcd < r ? xcd * (q + 1) : r * (q + 1) + (xcd - r) * q) + off; }
        const int nig = WGM * nN, gid = wgid / nig, fm = gid * WGM, gsz = (nM - fm) < WGM ? (nM - fm) : WGM;
        u.pm = fm + ((wgid % nig) % gsz); u.pn = (wgid % nig) / gsz; return true;
    }
    __device__ __forceinline__ const char* aptr(const Unit& u) const { return (const char*)sel3p(u.sub, A0, A1, A2) + (size_t)u.pm * (size_t)(512 * K) + 2 * sel3(u.sub, 0, ko1, ko2) + (direct == 1 ? 2048 * u.q : 0); }
    __device__ __forceinline__ const char* bptr(const Unit& u) const { return (const char*)sel3p(u.sub, B0, B1, B2) + (size_t)u.pn * (size_t)(512 * K) + 2 * sel3(u.sub, 0, ko1, ko2) + (direct == 1 ? 2048 * u.q : 0); }
    __device__ __forceinline__ int ktiles(const Unit& u) const { return sel3(u.sub, kt0, kt1, kt2); }
    __device__ __forceinline__ int kind(const Unit& u) const { return sel3(u.sub, k0, k1, k2); }
};

struct Epi {
    unsigned char* ws; float* out; const float* x; const float* ctx; int res_mode; const float* kg; const float* ng; const LAS float* rs;
    template <bool PERM> __device__ __forceinline__ void run(f32x4 (&acc)[2][2][4][2], const Unit& u, int kind, int wr, int wc, int fr_in, int fq_in) const {
        int fr = fr_in, fq = fq_in; asm volatile("" : "+v"(fr), "+v"(fq));
        const int rowt = u.pm * 256 + wr * 64 + fr;
        const int cw = wc * 32 + 8 * fq;
        if (kind == K_SWIGLU) {
            bf16_t* H = (bf16_t*)(ws + WS_H);
            const bool fn = (res_mode == 3);
            f32x4 sg[2], su[2];
            if (fn) { const float* sw = (const float*)(ws + WS_SW3) + (u.pm >> 3) * (2 * DFF) + u.pn * 256 + cw;
#pragma unroll
                for (int n = 0; n < 2; ++n) { sg[n] = *(const f32x4*)(sw + 4 * n); su[n] = *(const f32x4*)(sw + 128 + 4 * n); } }
#pragma unroll
            for (int ai = 0; ai < 2; ++ai)
#pragma unroll
                for (int m = 0; m < 4; ++m) {
                    const int row = rowt + ai * 128 + m * 16; f32x4 h[2];
                    const float rstd = fn ? rs[row & 2047] : 1.f;
#pragma unroll
                    for (int n = 0; n < 2; ++n) { f32x4 g = acc[ai][0][m][n], up = acc[ai][1][m][n]; if (fn) { g = g * rstd + sg[n]; up = up * rstd + su[n]; }
#pragma unroll
                        for (int e = 0; e < 4; ++e) h[n][e] = g[e] * sigmoidf_(g[e]) * up[e]; }
                    *(u32x4*)(H + (size_t)row * DFF + u.pn * 128 + cw) = pack8(h[0], h[1]);
                }
        } else if (kind == K_RES || kind == K_RESC0 || kind == K_RESC1) {
            const float* mod = (const float*)(ws + WS_MOD);
            const bool isctx = kind != K_RES, nobase = kind == K_RESC1;
            const bool in_bf = (res_mode != 0), out_bf = (res_mode == 1) || (res_mode == 0 && !isctx);
            const float* basef = isctx ? ctx : x; float* dstf = isctx ? (float*)(ws + (nobase ? WS_CTX1B : WS_CTX1)) : out;
            const bf16_t* baseb = res_mode == 1 ? (const bf16_t*)out : (const bf16_t*)(ws + WS_X2); bf16_t* dstb = res_mode == 0 ? (bf16_t*)out : (bf16_t*)(ws + WS_X2);
            const int gate_off = res_mode == 0 ? 2 * DM : (res_mode == 1 ? 5 * DM : 8 * DM); const float coef = res_mode == 1 ? 1.f : 0.5f;
            const int mrow = isctx ? 8 : (u.pm >> 3);
            const float* gp = mod + mrow * NMOD + gate_off + u.pn * 256 + cw;
            f32x4 gv[2][2], gg[2][2];
#pragma unroll
            for (int bj = 0; bj < 2; ++bj)
#pragma unroll
                for (int n = 0; n < 2; ++n) { gv[bj][n] = *(const f32x4*)(gp + bj * 128 + 4 * n) * coef; gg[bj][n] = gv[bj][n];
                    if (res_mode == 1) gg[bj][n] = *(const f32x4*)(ng + u.pn * 256 + cw + bj * 128 + 4 * n) * (*(const f32x4*)(mod + mrow * NMOD + 7 * DM + u.pn * 256 + cw + bj * 128 + 4 * n) + 1.0f); }
#pragma unroll
            for (int ai = 0; ai < 2; ++ai) {
                f32x4 bv[4][2][2];
#pragma unroll
                for (int m = 0; m < 4; ++m) { const size_t off = (size_t)(rowt + ai * 128 + m * 16) * DM + u.pn * 256 + cw;
#pragma unroll
                    for (int bj = 0; bj < 2; ++bj) {
                        if (in_bf) unpack8(__builtin_nontemporal_load((const u32x4*)(baseb + off + bj * 128)), bv[m][bj][0], bv[m][bj][1]);
                        else if (nobase) { bv[m][bj][0] = (f32x4){0.f, 0.f, 0.f, 0.f}; bv[m][bj][1] = bv[m][bj][0]; }
                        else { bv[m][bj][0] = __builtin_nontemporal_load((const f32x4*)(basef + off + bj * 128)); bv[m][bj][1] = __builtin_nontemporal_load((const f32x4*)(basef + off + bj * 128 + 4)); } } }
#pragma unroll
                for (int m = 0; m < 4; ++m) { const size_t off = (size_t)(rowt + ai * 128 + m * 16) * DM + u.pn * 256 + cw; float ss = 0.f;
#pragma unroll
                    for (int bj = 0; bj < 2; ++bj) { const f32x4 v0 = bv[m][bj][0] + gv[bj][0] * acc[ai][bj][m][0], v1 = bv[m][bj][1] + gv[bj][1] * acc[ai][bj][m][1];
                        if (out_bf) *(u32x4*)(dstb + off + bj * 128) = pack8(v0, v1);
                        else { *(f32x4*)(dstf + off + bj * 128) = v0; *(f32x4*)(dstf + off + bj * 128 + 4) = v1; }
                        if (res_mode == 1) {
                            *(u32x4*)((bf16_t*)(ws + WS_A) + off + bj * 128) = pack8(v0 * gg[bj][0], v1 * gg[bj][1]);
                            ss += (v0[0] * v0[0] + v0[1] * v0[1]) + (v0[2] * v0[2] + v0[3] * v0[3]) + (v1[0] * v1[0] + v1[1] * v1[1]) + (v1[2] * v1[2] + v1[3] * v1[3]); } }
                    if (res_mode == 1) { ss += __shfl_xor(ss, 16); ss += __shfl_xor(ss, 32);
                        if (fq == 0) ((float*)(ws + WS_ST3))[(size_t)(rowt + ai * 128 + m * 16) * 16 + u.pn * 4 + wc] = ss; } }
            }
        } else if (kind == K_INPROJ || kind == K_CTXKV) {
            bf16_t* dstb; int ld, rowadd, colb; bool sig = false;
            if (kind == K_INPROJ) {
                const int pn = u.pn;
                if (pn < 4) { dstb = (bf16_t*)(ws + WS_Q); ld = DM; rowadd = 0; colb = pn * 256; }
                else if (pn < 6) { dstb = (bf16_t*)(ws + (pn == 4 ? WS_K : WS_V)); ld = 256; rowadd = 256 * ((u.pm >> 3) + 1); colb = 0; }
                else if (pn < 10) { dstb = (bf16_t*)(ws + WS_GA); ld = DM; rowadd = 0; colb = (pn - 6) * 256; sig = true; }
                else { dstb = (bf16_t*)(ws + WS_GF); ld = DM; rowadd = 0; colb = (pn - 10) * 256; sig = true; }
            } else { dstb = (bf16_t*)(ws + (u.pn == 0 ? WS_K : WS_V)); ld = 256; rowadd = u.pm * (SKV - CTXL); colb = 0; }
#pragma unroll
            for (int ai = 0; ai < 2; ++ai)
#pragma unroll
                for (int m = 0; m < 4; ++m) {
                    const int row = rowt + ai * 128 + m * 16 + rowadd;
#pragma unroll
                    for (int bj = 0; bj < 2; ++bj) { f32x4 a = acc[ai][bj][m][0], b = acc[ai][bj][m][1];
                        if (sig) {
#pragma unroll
                            for (int e = 0; e < 4; ++e) { a[e] = sigmoidf_(a[e]); b[e] = sigmoidf_(b[e]); } }
                        *(u32x4*)(dstb + (size_t)row * ld + colb + bj * 128 + cw) = pack8(a, b); }
                }
            const bool isk = (kind == K_INPROJ) ? (u.pn == 4) : (u.pn == 0);
            if (isk) {
                asm volatile("s_waitcnt vmcnt(0)" ::: "memory"); __builtin_amdgcn_s_barrier(); asm volatile("" ::: "memory");
                const float* rt = (const float*)(ws + WS_ROPE); const bool rope = (kind == K_INPROJ);
                const int lane = fq * 16 + fr, wid = wr * 4 + wc, l16 = lane & 15;
                const f32x4 g1 = *(const f32x4*)(kg + 4 * l16), g2 = *(const f32x4*)(kg + 64 + 4 * l16);
#pragma unroll 4
                for (int it = 0; it < 16; ++it) { const int item = it * 32 + wid * 4 + (lane >> 4), r = item >> 1, hd = item & 1;
                    bf16_t* hp = dstb + (size_t)(u.pm * 256 + r + rowadd) * 256 + hd * 128 + 4 * l16;
                    const u32x2 w1 = *(const u32x2*)hp, w2 = *(const u32x2*)(hp + 64);
                    f32x4 t1 = {__uint_as_float(w1.x << 16), __uint_as_float(w1.x & 0xffff0000u), __uint_as_float(w1.y << 16), __uint_as_float(w1.y & 0xffff0000u)};
                    f32x4 t2 = {__uint_as_float(w2.x << 16), __uint_as_float(w2.x & 0xffff0000u), __uint_as_float(w2.y << 16), __uint_as_float(w2.y & 0xffff0000u)};
                    float ss = (t1[0] * t1[0] + t1[1] * t1[1]) + (t1[2] * t1[2] + t1[3] * t1[3]) + (t2[0] * t2[0] + t2[1] * t2[1]) + (t2[2] * t2[2] + t2[3] * t2[3]);
                    ss += __shfl_xor(ss, 1); ss += __shfl_xor(ss, 2); ss += __shfl_xor(ss, 4); ss += __shfl_xor(ss, 8);
                    const float rstd = 1.0f / sqrtf(ss * (1.0f / 128.0f) + EPS);
                    t1 = t1 * rstd * g1; t2 = t2 * rstd * g2;
                    if (rope) { const int n = ((u.pm & 7) * 256 + r); const int pos = l16 < 8 ? (n >> 6) : (n & 63); const float* rp = rt + 2 * (pos * 32 + ((4 * l16) & 31));
                        const f32x4 c0 = *(const f32x4*)rp, c1 = *(const f32x4*)(rp + 4); f32x4 o1, o2;
                        o1[0] = t1[0] * c0[0] - t2[0] * c0[1]; o2[0] = t2[0] * c0[0] + t1[0] * c0[1]; o1[1] = t1[1] * c0[2] - t2[1] * c0[3]; o2[1] = t2[1] * c0[2] + t1[1] * c0[3];
                        o1[2] = t1[2] * c1[0] - t2[2] * c1[1]; o2[2] = t2[2] * c1[0] + t1[2] * c1[1]; o1[3] = t1[3] * c1[2] - t2[3] * c1[3]; o2[3] = t2[3] * c1[2] + t1[3] * c1[3];
                        t1 = o1; t2 = o2; }
                    u32x2 q1, q2; q1.x = cvt_pk_bf16(t1[0], t1[1]); q1.y = cvt_pk_bf16(t1[2], t1[3]); q2.x = cvt_pk_bf16(t2[0], t2[1]); q2.y = cvt_pk_bf16(t2[2], t2[3]);
                    *(u32x2*)hp = q1; *(u32x2*)(hp + 64) = q2; }
            }
        } else if (kind == K_FTSWAP) {
            bf16_t* FT = (bf16_t*)(ws + WS_FT);
#pragma unroll
            for (int ai = 0; ai < 2; ++ai)
#pragma unroll
                for (int m = 0; m < 4; ++m) {
                    const int j = rowt + ai * 128 + m * 16; const int cs = j >> 9, g = (j >> 7) & 3, mm = j & 127;
#pragma unroll
                    for (int bj = 0; bj < 2; ++bj) { const int t0 = u.pn * 256 + bj * 128 + cw; const int b = t0 >> 11, n = t0 & 2047;
                        *(u32x4*)(FT + ((size_t)((b * 4 + g) * 128 + mm)) * 4096 + cs * 2048 + n) = pack8(acc[ai][bj][m][0], acc[ai][bj][m][1]); }
                }
        } else if (kind == K_FOUR2) {
            bf16_t* YF = (bf16_t*)(ws + WS_YF);
            unsigned* flag = (unsigned*)(ws + WS_CNT) + (size_t)((u.pm * 16 + u.pn) * 4) * 64;
            const int lane = fq * 16 + fr, wid = wr * 4 + wc, role = u.q;
            if (role != 3) {
#pragma unroll
                for (int ai = 0; ai < 2; ++ai)
#pragma unroll
                    for (int m = 0; m < 4; ++m) { const int k = rowt + ai * 128 + m * 16;
#pragma unroll
                        for (int bj = 0; bj < 2; ++bj) { const int c = u.pn * 256 + bj * 128 + cw; const int b = c >> 9, cc = c & 511;
                            bf16_t* dstp = role == 0 ? YF + (size_t)(b * SEQ + k) * 1024 + 512 + cc : (role == 1 ? YF + (size_t)(b * SEQ + 1024 + k) * 1024 + 512 + cc : YF + (size_t)(b * SEQ + k) * 1024 + cc);
                            st16_wt(dstp, pack8(acc[ai][bj][m][0], acc[ai][bj][m][1])); } }
                asm volatile("s_waitcnt vmcnt(0)" ::: "memory");
                if (lane == 0) __hip_atomic_fetch_add(flag + 64 * role, 1u, __ATOMIC_RELAXED, __HIP_MEMORY_SCOPE_AGENT);
            } else {
                if (wid == 0) {
#pragma unroll
                    for (int f = 0; f < 3; ++f) { unsigned sp_ = 0; while ((unsigned)__builtin_amdgcn_readfirstlane(__hip_atomic_load(flag + 64 * f, __ATOMIC_RELAXED, __HIP_MEMORY_SCOPE_AGENT)) < 8u) { __builtin_amdgcn_s_sleep(2); if (++sp_ > (1u << 13)) break; } }
                    __builtin_amdgcn_fence(__ATOMIC_ACQUIRE, "agent"); asm volatile("s_waitcnt vmcnt(0)" ::: "memory"); }
                asm volatile("" ::: "memory"); __builtin_amdgcn_s_barrier(); asm volatile("" ::: "memory");
#pragma unroll
                for (int ai2 = 0; ai2 < 4; ++ai2) { const int ai = ai2 >> 1, mb = (ai2 & 1) * 2;
                    u32x4 t0[4][2], t1[4][2], t2[4][2];
#pragma unroll
                    for (int m = mb; m < mb + 2; ++m) { const int k = rowt + ai * 128 + m * 16;
#pragma unroll
                        for (int bj = 0; bj < 2; ++bj) { const int c = u.pn * 256 + bj * 128 + cw; const int b = c >> 9, cc = c & 511;
                            t0[m][bj] = __builtin_nontemporal_load((const u32x4*)(YF + (size_t)(b * SEQ + k) * 1024 + 512 + cc));
                            t1[m][bj] = __builtin_nontemporal_load((const u32x4*)(YF + (size_t)(b * SEQ + 1024 + k) * 1024 + 512 + cc));
                            t2[m][bj] = __builtin_nontemporal_load((const u32x4*)(YF + (size_t)(b * SEQ + k) * 1024 + cc)); } }
#pragma unroll
                    for (int m = mb; m < mb + 2; ++m) { const int k = rowt + ai * 128 + m * 16;
#pragma unroll
                        for (int bj = 0; bj < 2; ++bj) { const int c = u.pn * 256 + bj * 128 + cw; const int b = c >> 9, cc = c & 511;
                            f32x4 a0, a1, b0, b1, s0, s1; unpack8(t0[m][bj], a0, a1); unpack8(t1[m][bj], b0, b1); unpack8(t2[m][bj], s0, s1);
                            const f32x4 c0 = a0 + b0, c1 = a1 + b1; s0 = s0 + acc[ai][bj][m][0]; s1 = s1 + acc[ai][bj][m][1];
                            *(u32x4*)(YF + (size_t)(b * SEQ + k) * 1024 + cc) = pack8(c0 + s0, c1 + s1);
                            if (k != 0) *(u32x4*)(YF + (size_t)(b * SEQ + SEQ - k) * 1024 + cc) = pack8(c0 - s0, c1 - s1); } }
                }
            }
        } else {
            bf16_t* GA = (bf16_t*)(ws + WS_GA); const bf16_t* GF = (const bf16_t*)(ws + WS_GF);
#pragma unroll
            for (int ai = 0; ai < 2; ++ai) {
                u32x4 ra[4][2], rf[4][2];
#pragma unroll
                for (int m = 0; m < 4; ++m) { const size_t off = (size_t)(rowt + ai * 128 + m * 16) * DM + u.pn * 256 + cw;
#pragma unroll
                    for (int bj = 0; bj < 2; ++bj) { if (kind == K_BRA) { rf[m][bj] = *(const u32x4*)(GF + off + bj * 128); ra[m][bj] = __builtin_nontemporal_load((const u32x4*)(GA + off + bj * 128)); } else { rf[m][bj] = __builtin_nontemporal_load((const u32x4*)(GF + off + bj * 128)); ra[m][bj] = rf[m][bj]; } } }
#pragma unroll
                for (int m = 0; m < 4; ++m) { const size_t off = (size_t)(rowt + ai * 128 + m * 16) * DM + u.pn * 256 + cw;
#pragma unroll
                    for (int bj = 0; bj < 2; ++bj) { f32x4 g0, g1; unpack8(rf[m][bj], g0, g1);
                        if (kind == K_BRA) { f32x4 a0, a1; unpack8(ra[m][bj], a0, a1);
#pragma unroll
                            for (int e = 0; e < 4; ++e) { acc[ai][bj][m][0][e] *= a0[e] * __builtin_amdgcn_rcpf(g0[e]); acc[ai][bj][m][1][e] *= a1[e] * __builtin_amdgcn_rcpf(g1[e]); } }
                        else *(u32x4*)(GA + off + bj * 128) = pack8(g0 * acc[ai][bj][m][0], g1 * acc[ai][bj][m][1]); } }
            }
        }
    }
};

template <bool ALIGN_EPI, bool SP2, bool PERM = true>
__device__ __forceinline__ void gemm_phase(LAS unsigned char* lds, const Sched& S, const Epi& E, const int tid) {
    const int wid = __builtin_amdgcn_readfirstlane(tid >> 6), lane = tid & 63, wr = wid >> 2, wc = wid & 3, fr = lane & 15, fq = lane >> 4;
    const int K = S.K;
    unsigned voffA[2], voffB[2];
#pragma unroll
    for (int i = 0; i < 2; ++i) { int R, C; stage_rc(tid * 16 + i * 8192, R, C); const int Rb = PERM ? ((R & ~31) + perm32(R & 31)) : R;
        voffA[i] = (unsigned)(R * K + C) * 2u; voffB[i] = (unsigned)(Rb * K + C) * 2u; }
    const size_t kstep = (size_t)(BK * 2);
    const size_t hstep = (size_t)HALF * K * 2;
    const unsigned ldsw = (unsigned)wid * 1024u;
    const int aoff = lds_byte(wr * 64 + fr, fq * 8), boff = lds_byte(wc * 32 + fr, fq * 8);
#define PG8_SA(b, h) (((b) * 2 + (h)) * HTB)
#define PG8_SB(b, h) ((4 + (b) * 2 + (h)) * HTB)
#define PG8_STAGE(bufoff, gbase, voff) do { _Pragma("unroll") for (int _i = 0; _i < 2; ++_i) \
        __builtin_amdgcn_global_load_lds((const unsigned*)((const char*)(gbase) + (voff)[_i]), (LAS unsigned*)(lds + (bufoff) + ldsw + _i * 8192), 16, 0, 0); } while (0)
#define PG8_LDA(dst, b, h) do { _Pragma("unroll") for (int m = 0; m < 4; ++m) _Pragma("unroll") for (int k = 0; k < 2; ++k) dst[m][k] = *(const LAS bf16x8*)(lds + PG8_SA(b, h) + aoff + m * 2048 + k * 1024); } while (0)
#define PG8_LDB(dst, b, h) do { _Pragma("unroll") for (int n = 0; n < 2; ++n) _Pragma("unroll") for (int k = 0; k < 2; ++k) dst[n][k] = *(const LAS bf16x8*)(lds + PG8_SB(b, h) + boff + n * 2048 + k * 1024); } while (0)
#define PG8_MMA(ai, bj, At, Bt) do { __builtin_amdgcn_s_setprio(1); _Pragma("unroll") for (int m = 0; m < 4; ++m) _Pragma("unroll") for (int n = 0; n < 2; ++n) _Pragma("unroll") for (int k = 0; k < 2; ++k) \
        acc[ai][bj][m][n] = __builtin_amdgcn_mfma_f32_16x16x32_bf16(Bt[n][k], At[m][k], acc[ai][bj][m][n], 0, 0, 0); __builtin_amdgcn_s_setprio(0); } while (0)
#define PG8_WAIT_V(n) asm volatile("s_waitcnt vmcnt(" #n ")" ::: "memory")
#define PG8_WAIT_L(n) asm volatile("s_waitcnt lgkmcnt(" #n ")" ::: "memory")
#define PG8_BAR __builtin_amdgcn_s_barrier()
#define PG8_SCHED __builtin_amdgcn_sched_barrier(0)
    Unit cur, nxt; int ui = 0;
    if (!S.next(0, cur)) return;
    f32x4 acc[2][2][4][2];
#pragma unroll
    for (int a = 0; a < 2; ++a)
#pragma unroll
        for (int b = 0; b < 2; ++b)
#pragma unroll
            for (int m = 0; m < 4; ++m)
#pragma unroll
                for (int n = 0; n < 2; ++n) acc[a][b][m][n] = (f32x4){0.f, 0.f, 0.f, 0.f};
    bf16x8 At[4][2], B0[2][2], B1[2][2];
    const char* cA = S.aptr(cur); const char* cB = S.bptr(cur);
    if constexpr (SP2) {
        PG8_STAGE(PG8_SB(0, 0), cB, voffB); PG8_STAGE(PG8_SB(0, 1), cB + hstep, voffB); PG8_STAGE(PG8_SA(0, 0), cA, voffA); PG8_STAGE(PG8_SA(0, 1), cA + hstep, voffA);
        if (wr == 1) PG8_BAR;
        PG8_WAIT_V(2); PG8_BAR;
        PG8_STAGE(PG8_SB(1, 0), cB + kstep, voffB); PG8_STAGE(PG8_SA(1, 0), cA + kstep, voffA); PG8_STAGE(PG8_SB(1, 1), cB + hstep + kstep, voffB);
        PG8_WAIT_V(6); PG8_BAR;
    } else {
        PG8_STAGE(PG8_SB(0, 0), cB, voffB); PG8_STAGE(PG8_SA(0, 0), cA, voffA); PG8_STAGE(PG8_SB(0, 1), cB + hstep, voffB); PG8_STAGE(PG8_SA(0, 1), cA + hstep, voffA);
        if (wr == 1) PG8_BAR;
        PG8_WAIT_V(4); PG8_BAR;
        PG8_STAGE(PG8_SB(1, 0), cB + kstep, voffB); PG8_STAGE(PG8_SA(1, 0), cA + kstep, voffA); PG8_STAGE(PG8_SB(1, 1), cB + hstep + kstep, voffB);
        PG8_WAIT_V(6); PG8_BAR;
    }
    for (;;) {
        const bool has_next = S.next(ui + 1, nxt); const int nt = S.ktiles(cur);
        const char* nA = has_next ? S.aptr(nxt) : cA; const char* nB = has_next ? S.bptr(nxt) : cB;
        for (int t = 0; t < nt; t += 2) {
            const bool last = (t == nt - 2);
            const char* a1 = cA + (size_t)(t + 1) * kstep;
            const char* a2 = last ? nA : cA + (size_t)(t + 2) * kstep; const char* b2 = last ? nB : cB + (size_t)(t + 2) * kstep;
            const char* a3 = a2 + kstep; const char* b3 = b2 + kstep;
            if constexpr (SP2) {
            PG8_LDB(B0, 0, 0); PG8_LDB(B1, 0, 1); PG8_SCHED; PG8_LDA(At, 0, 0); PG8_STAGE(PG8_SA(1, 1), a1 + hstep, voffA);
            PG8_WAIT_V(8); PG8_WAIT_L(0); PG8_BAR; PG8_MMA(0, 0, At, B0); PG8_MMA(0, 1, At, B1); PG8_BAR; PG8_SCHED;
            PG8_LDA(At, 0, 1); PG8_STAGE(PG8_SB(0, 0), b2, voffB); PG8_STAGE(PG8_SB(0, 1), b2 + hstep, voffB); PG8_STAGE(PG8_SA(0, 0), a2, voffA);
            PG8_WAIT_V(8); PG8_WAIT_L(0); PG8_BAR; PG8_MMA(1, 0, At, B0); PG8_MMA(1, 1, At, B1); PG8_BAR; PG8_SCHED;
            PG8_LDB(B0, 1, 0); PG8_LDB(B1, 1, 1); PG8_SCHED; PG8_LDA(At, 1, 0); PG8_STAGE(PG8_SA(0, 1), a2 + hstep, voffA);
            PG8_WAIT_V(8); PG8_WAIT_L(0); PG8_BAR; PG8_MMA(0, 0, At, B0); PG8_MMA(0, 1, At, B1); PG8_BAR; PG8_SCHED;
            PG8_LDA(At, 1, 1); PG8_STAGE(PG8_SB(1, 0), b3, voffB); PG8_STAGE(PG8_SB(1, 1), b3 + hstep, voffB); PG8_STAGE(PG8_SA(1, 0), a3, voffA);
            PG8_WAIT_V(8); PG8_WAIT_L(0); PG8_BAR; PG8_MMA(1, 0, At, B0); PG8_MMA(1, 1, At, B1); PG8_BAR; PG8_SCHED;
            } else {
            PG8_LDB(B0, 0, 0); PG8_SCHED; PG8_LDA(At, 0, 0); PG8_STAGE(PG8_SA(1, 1), a1 + hstep, voffA);
            PG8_WAIT_L(8); PG8_BAR; PG8_WAIT_L(0); PG8_MMA(0, 0, At, B0); PG8_BAR; PG8_SCHED;
            PG8_LDB(B1, 0, 1); PG8_STAGE(PG8_SB(0, 0), b2, voffB);
            PG8_BAR; PG8_WAIT_L(0); PG8_MMA(0, 1, At, B1); PG8_BAR;
            PG8_LDA(At, 0, 1); PG8_STAGE(PG8_SA(0, 0), a2, voffA);
            PG8_BAR; PG8_WAIT_L(0); PG8_MMA(1, 0, At, B0); PG8_BAR; PG8_SCHED;
            PG8_STAGE(PG8_SB(0, 1), b2 + hstep, voffB);
            PG8_WAIT_V(6); PG8_BAR; PG8_MMA(1, 1, At, B1); PG8_BAR;
            PG8_LDB(B0, 1, 0); PG8_SCHED; PG8_LDA(At, 1, 0); PG8_STAGE(PG8_SA(0, 1), a2 + hstep, voffA);
            PG8_WAIT_L(8); PG8_BAR; PG8_WAIT_L(0); PG8_MMA(0, 0, At, B0); PG8_BAR; PG8_SCHED;
            PG8_LDB(B1, 1, 1); PG8_STAGE(PG8_SB(1, 0), b3, voffB);
            PG8_BAR; PG8_WAIT_L(0); PG8_MMA(0, 1, At, B1); PG8_BAR;
            PG8_LDA(At, 1, 1); PG8_STAGE(PG8_SA(1, 0), a3, voffA);
            PG8_BAR; PG8_WAIT_L(0); PG8_MMA(1, 0, At, B0); PG8_BAR; PG8_SCHED;
            PG8_STAGE(PG8_SB(1, 1), b3 + hstep, voffB);
            PG8_WAIT_V(6); PG8_BAR; PG8_MMA(1, 1, At, B1); PG8_BAR;
            }
        }
        if constexpr (ALIGN_EPI) { if (wr == 0) PG8_BAR; }
        E.template run<PERM>(acc, cur, S.kind(cur), wr, wc, fr, fq);
        if (!has_next) break;
        if (S.kind(cur) != K_BRA) {
#pragma unroll
        for (int a = 0; a < 2; ++a)
#pragma unroll
            for (int b = 0; b < 2; ++b)
#pragma unroll
                for (int m = 0; m < 4; ++m)
#pragma unroll
                    for (int n = 0; n < 2; ++n) acc[a][b][m][n] = (f32x4){0.f, 0.f, 0.f, 0.f};
        }
        cur = nxt; cA = nA; cB = nB; ++ui;
        if constexpr (ALIGN_EPI) { if (wr == 1) PG8_BAR; }
    }
    PG8_WAIT_V(0);
    if constexpr (!ALIGN_EPI) { if (wr == 0) PG8_BAR; }
    PG8_BAR;
#undef PG8_SA
#undef PG8_SB
#undef PG8_STAGE
#undef PG8_LDA
#undef PG8_LDB
#undef PG8_MMA
#undef PG8_WAIT_V
#undef PG8_WAIT_L
#undef PG8_BAR
#undef PG8_SCHED
}
}

namespace att {
using bf16 = __hip_bfloat16;
constexpr int D = 128, NW = 8, QBLK = 32, KVBLK = 64;
constexpr float SCALE = 0.088388347648318440f;
constexpr float THR = 8.f;
constexpr int LDQ = DM, LDK = 256, LDO = DM;
constexpr size_t SHM_V = KVBLK * D * 2, SHM_K = KVBLK * D * 2, SHM_ATTN = 2 * SHM_V + 2 * SHM_K + NW * 64 * 4;
#define KSWZ(row, colB) ((row) * 256 + ((colB) ^ (((row) & 7) << 4)))
#define SBAR() __builtin_amdgcn_sched_barrier(0)
__device__ __forceinline__ int crow(int r, int hi) { return (r & 3) + 8 * (r >> 2) + 4 * hi; }
__device__ __forceinline__ unsigned cvtpk(float lo, float hi) { unsigned r; asm volatile("v_cvt_pk_bf16_f32 %0, %1, %2" : "=v"(r) : "v"(lo), "v"(hi)); return r; }
__device__ __forceinline__ void partialSM(f32x16& p0, f32x16& p1, float& m_reg, float& mn, float& alpha) {
  constexpr float C = SCALE * 1.4426950408889634f;
  float pmax = p0[0];
  _Pragma("unroll") for (int r = 1; r < 16; ++r) pmax = fmaxf(pmax, p0[r]);
  _Pragma("unroll") for (int r = 0; r < 16; ++r) pmax = fmaxf(pmax, p1[r]);
  { auto rr = __builtin_amdgcn_permlane32_swap(__float_as_uint(pmax), __float_as_uint(pmax), false, false);
    pmax = fmaxf(__uint_as_float(rr[0]), __uint_as_float(rr[1])); }
  if (__builtin_expect(__all(pmax - m_reg <= THR / SCALE), 1)) { mn = m_reg; alpha = 1.f; }
  else { mn = fmaxf(m_reg, pmax); alpha = __builtin_amdgcn_exp2f((m_reg - mn) * C); m_reg = mn; }
  float mnC = -mn * C;
  _Pragma("unroll") for (int r = 0; r < 16; ++r) p0[r] = fmaf(p0[r], C, mnC);
  _Pragma("unroll") for (int r = 0; r < 16; ++r) p1[r] = fmaf(p1[r], C, mnC);
  _Pragma("unroll") for (int r = 0; r < 16; ++r) p0[r] = __builtin_amdgcn_exp2f(p0[r]);
}
__device__ __forceinline__ void finishSM(f32x16& p0, f32x16& p1, float alpha, float& l_reg, bf16x8& pa0, bf16x8& pa1, bf16x8& pa2, bf16x8& pa3) {
  _Pragma("unroll") for (int r = 0; r < 16; ++r) p1[r] = __builtin_amdgcn_exp2f(p1[r]);
  float ps = 0;
  _Pragma("unroll") for (int r = 0; r < 16; ++r) ps += p0[r];
  _Pragma("unroll") for (int r = 0; r < 16; ++r) ps += p1[r];
  { auto rr = __builtin_amdgcn_permlane32_swap(__float_as_uint(ps), __float_as_uint(ps), false, false);
    ps = __uint_as_float(rr[0]) + __uint_as_float(rr[1]); }
  l_reg = l_reg * alpha + ps;
#define PK4(P, BASE, OUT) do { unsigned a0 = cvtpk(P[BASE + 0], P[BASE + 1]), a1 = cvtpk(P[BASE + 2], P[BASE + 3]);   \
    unsigned b0 = cvtpk(P[BASE + 4], P[BASE + 5]), b1 = cvtpk(P[BASE + 6], P[BASE + 7]);                              \
    auto r0 = __builtin_amdgcn_permlane32_swap(a0, b0, false, false); auto r1 = __builtin_amdgcn_permlane32_swap(a1, b1, false, false); \
    u32x4 w = {r0[0], r1[0], r0[1], r1[1]}; OUT = *reinterpret_cast<bf16x8*>(&w); } while (0)
  PK4(p0, 0, pa0); PK4(p0, 8, pa1); PK4(p1, 0, pa2); PK4(p1, 8, pa3);
#undef PK4
}
__device__ __forceinline__ void qkt(f32x16& p0, f32x16& p1, const bf16* Ks, const bf16x8* qr, int r32, int hi) {
  p0 = f32x16{}; p1 = f32x16{};
  _Pragma("unroll") for (int d0 = 0; d0 < 8; ++d0) { int cb = (d0 * 16 + hi * 8) * 2;
    bf16x8 b0 = *reinterpret_cast<const bf16x8*>((const char*)Ks + KSWZ(r32, cb));
    bf16x8 b1 = *reinterpret_cast<const bf16x8*>((const char*)Ks + KSWZ(32 + r32, cb));
    p0 = __builtin_amdgcn_mfma_f32_32x32x16_bf16(b0, qr[d0], p0, 0, 0, 0);
    p1 = __builtin_amdgcn_mfma_f32_32x32x16_bf16(b1, qr[d0], p1, 0, 0, 0); }
}
__device__ __forceinline__ int v_st(int k, int c) { const int kk = (k & ~0xC) | ((k & 4) << 1) | ((k & 8) >> 1); return ((kk >> 3) * 4 + (c >> 5)) * 512 + ((kk & 7) * 32 + (c & 31)) * 2; }
__device__ __forceinline__ int v_rd_base(int lane) { return ((lane & 3) << 3) | (((lane >> 2) & 3) << 6) | (((lane >> 4) & 1) << 5) | (((lane >> 5) & 1) << 8); }
constexpr int v_rd_off(int d0, int ks, int half) { return d0 * 512 + ks * 4096 + half * 2048; }
template <int OFF> __device__ __forceinline__ s16x4 tr_read(int vb) {
  s16x4 r; asm volatile("ds_read_b64_tr_b16 %0, %1 offset:%2" : "=&v"(r) : "v"(vb), "i"(OFF) : "memory"); return r;
}
template <int D0> __device__ __forceinline__ void pv_one(f32x16& od, int vb, bf16x8 pa0, bf16x8 pa1, bf16x8 pa2, bf16x8 pa3) {
  const s16x4 l0 = tr_read<v_rd_off(D0, 0, 0)>(vb), h0 = tr_read<v_rd_off(D0, 0, 1)>(vb), l1 = tr_read<v_rd_off(D0, 1, 0)>(vb), h1 = tr_read<v_rd_off(D0, 1, 1)>(vb);
  const s16x4 l2 = tr_read<v_rd_off(D0, 2, 0)>(vb), h2 = tr_read<v_rd_off(D0, 2, 1)>(vb), l3 = tr_read<v_rd_off(D0, 3, 0)>(vb), h3 = tr_read<v_rd_off(D0, 3, 1)>(vb);
  asm volatile("s_waitcnt lgkmcnt(0)" ::: "memory"); SBAR();
#define PK(L, H) (bf16x8){L[0], L[1], L[2], L[3], H[0], H[1], H[2], H[3]}
  od = __builtin_amdgcn_mfma_f32_32x32x16_bf16(pa0, PK(l0, h0), od, 0, 0, 0);
  od = __builtin_amdgcn_mfma_f32_32x32x16_bf16(pa1, PK(l1, h1), od, 0, 0, 0);
  od = __builtin_amdgcn_mfma_f32_32x32x16_bf16(pa2, PK(l2, h2), od, 0, 0, 0);
  od = __builtin_amdgcn_mfma_f32_32x32x16_bf16(pa3, PK(l3, h3), od, 0, 0, 0);
#undef PK
}
__device__ __forceinline__ void pv_d0(f32x16* o, int vb, bf16x8 pa0, bf16x8 pa1, bf16x8 pa2, bf16x8 pa3) {
  pv_one<0>(o[0], vb, pa0, pa1, pa2, pa3); pv_one<1>(o[1], vb, pa0, pa1, pa2, pa3); pv_one<2>(o[2], vb, pa0, pa1, pa2, pa3); pv_one<3>(o[3], vb, pa0, pa1, pa2, pa3);
}
__device__ __forceinline__ void attn_unit(const bf16* Qb, const bf16* __restrict__ Kh, const bf16* __restrict__ Vh, bf16* Ob, int seq, char* lds, const int tid,
                                          const float* __restrict__ qg, const float* __restrict__ ropetab, int n0) {
  const int wid = __builtin_amdgcn_readfirstlane(tid >> 6), lane = tid & 63, r32 = lane & 31, hi = lane >> 5;
  bf16* V_lds = (bf16*)lds; bf16* K_lds = (bf16*)(lds + 2 * SHM_V);
  float* ws = (float*)(lds + 2 * SHM_V + 2 * SHM_K) + wid * 64; float* li_l = ws; float* al_l = ws + 32;
  bf16x8 qr[8];
  const bf16* Qw = Qb + (long)(wid * QBLK + r32) * LDQ + hi * 8;
#pragma unroll
  for (int d0 = 0; d0 < 8; ++d0) qr[d0] = *reinterpret_cast<const bf16x8*>(Qw + d0 * 16);
#ifndef NO_QFIX
  {
    float qf[8][8]; float ss = 0.f;
#pragma unroll
    for (int d0 = 0; d0 < 8; ++d0)
#pragma unroll
      for (int e = 0; e < 8; ++e) { const float v = __uint_as_float(((unsigned)(unsigned short)qr[d0][e]) << 16); qf[d0][e] = v; ss += v * v; }
    { auto rr = __builtin_amdgcn_permlane32_swap(__float_as_uint(ss), __float_as_uint(ss), false, false); ss = __uint_as_float(rr[0]) + __uint_as_float(rr[1]); }
    const float rstd = 1.0f / sqrtf(ss * (1.0f / 128.0f) + EPS);
    const int n = n0 + wid * QBLK + r32;
#pragma unroll
    for (int d0 = 0; d0 < 8; ++d0) { const f32x4 g0 = *(const f32x4*)(qg + d0 * 16 + hi * 8), g1 = *(const f32x4*)(qg + d0 * 16 + hi * 8 + 4);
#pragma unroll
      for (int e = 0; e < 4; ++e) { qf[d0][e] *= rstd * g0[e]; qf[d0][4 + e] *= rstd * g1[e]; } }
#pragma unroll
    for (int d0 = 0; d0 < 4; ++d0) { const int pos = d0 < 2 ? (n >> 6) : (n & 63); const float* rp = ropetab + 2 * (pos * 32 + (d0 & 1) * 16 + hi * 8);
#pragma unroll
      for (int e = 0; e < 8; e += 2) { const f32x4 cs = *(const f32x4*)(rp + 2 * e);
        { const float t1 = qf[d0][e], t2 = qf[d0 + 4][e]; qf[d0][e] = t1 * cs[0] - t2 * cs[1]; qf[d0 + 4][e] = t2 * cs[0] + t1 * cs[1]; }
        { const float t1 = qf[d0][e + 1], t2 = qf[d0 + 4][e + 1]; qf[d0][e + 1] = t1 * cs[2] - t2 * cs[3]; qf[d0 + 4][e + 1] = t2 * cs[2] + t1 * cs[3]; } } }
#pragma unroll
    for (int d0 = 0; d0 < 8; ++d0) { u32x4 w = {cvtpk(qf[d0][0], qf[d0][1]), cvtpk(qf[d0][2], qf[d0][3]), cvtpk(qf[d0][4], qf[d0][5]), cvtpk(qf[d0][6], qf[d0][7])}; qr[d0] = *reinterpret_cast<bf16x8*>(&w); }
  }
#endif
  float m_reg = -1e30f, l_reg = 0; f32x16 o[4] = {};
  const int sr = tid >> 4, sc = (tid & 15) * 8, vst0 = v_st(sr, sc), vst1 = v_st(32 + sr, sc);
  const int vb0 = (int)(uintptr_t)V_lds + v_rd_base(lane);
  bf16x8 sr_0vs0, sr_0vs1, sr_0ks0, sr_0ks1, sr_1vs0, sr_1vs1, sr_1ks0, sr_1ks1;
#define LD8(p) (*reinterpret_cast<const bf16x8*>(p))
#define SLOAD(i, k0) do { sr_##i##vs0 = LD8(&Vh[(long)((k0) + sr) * LDK + sc]); sr_##i##vs1 = LD8(&Vh[(long)((k0) + 32 + sr) * LDK + sc]); \
    sr_##i##ks0 = LD8(&Kh[(long)((k0) + sr) * LDK + sc]); sr_##i##ks1 = LD8(&Kh[(long)((k0) + 32 + sr) * LDK + sc]); } while (0)
#define SWRITE(b, i) do { *(bf16x8*)((char*)V_lds + (b) * SHM_V + vst0) = sr_##i##vs0;          \
    *(bf16x8*)((char*)V_lds + (b) * SHM_V + vst1) = sr_##i##vs1; int kc = sc * 2;               \
    *(bf16x8*)((char*)K_lds + (b) * SHM_K + KSWZ(sr, kc)) = sr_##i##ks0;                       \
    *(bf16x8*)((char*)K_lds + (b) * SHM_K + KSWZ(32 + sr, kc)) = sr_##i##ks1; } while (0)
#define SWAIT() asm volatile("s_waitcnt vmcnt(4)" ::: "memory")
#define RESC(a) do { if (__any((a) < 1.f)) { if (hi == 0) al_l[r32] = (a); asm volatile("s_waitcnt lgkmcnt(0)" ::: "memory"); \
    _Pragma("unroll") for (int d = 0; d < 4; ++d) _Pragma("unroll") for (int r = 0; r < 16; ++r) o[d][r] *= al_l[crow(r, hi)]; } } while (0)
  f32x16 pA0, pA1, pB0, pB1; float mnA, mnB, alA, alB; bf16x8 pa0, pa1, pa2, pa3; const int NT = seq / KVBLK;
  SLOAD(0, 0); asm volatile("s_waitcnt vmcnt(0)" ::: "memory"); SWRITE(0, 0); __syncthreads();
  qkt(pA0, pA1, K_lds, qr, r32, hi); partialSM(pA0, pA1, m_reg, mnA, alA);
  SLOAD(1, KVBLK); if (2 < NT) SLOAD(0, 2 * KVBLK);
  SWAIT(); SWRITE(1, 1); __syncthreads();
  for (int j = 1; j + 1 < NT; j += 2) {
    SBAR(); qkt(pB0, pB1, (bf16*)((char*)K_lds + SHM_K), qr, r32, hi);
    finishSM(pA0, pA1, alA, l_reg, pa0, pa1, pa2, pa3); SBAR();
    SLOAD(1, (j + 2) * KVBLK); SBAR();
    pv_d0(o, vb0, pa0, pa1, pa2, pa3); partialSM(pB0, pB1, m_reg, mnB, alB);
    __syncthreads(); SWAIT(); SWRITE(0, 0);
    RESC(alB); __syncthreads();
    SBAR(); qkt(pA0, pA1, K_lds, qr, r32, hi);
    finishSM(pB0, pB1, alB, l_reg, pa0, pa1, pa2, pa3); SBAR();
    if (j + 3 < NT) SLOAD(0, (j + 3) * KVBLK); SBAR();
    pv_d0(o, vb0 + (int)SHM_V, pa0, pa1, pa2, pa3); partialSM(pA0, pA1, m_reg, mnA, alA);
    __syncthreads(); SWAIT(); SWRITE(1, 1);
    RESC(alA); __syncthreads();
  }
  SBAR(); qkt(pB0, pB1, (bf16*)((char*)K_lds + SHM_K), qr, r32, hi);
  finishSM(pA0, pA1, alA, l_reg, pa0, pa1, pa2, pa3); SBAR();
  pv_d0(o, vb0, pa0, pa1, pa2, pa3); partialSM(pB0, pB1, m_reg, mnB, alB);
  __syncthreads(); RESC(alB);
  finishSM(pB0, pB1, alB, l_reg, pa0, pa1, pa2, pa3); SBAR();
  pv_d0(o, vb0 + (int)SHM_V, pa0, pa1, pa2, pa3);
  if (hi == 0) li_l[r32] = l_reg; asm volatile("s_waitcnt lgkmcnt(0)" ::: "memory");
  float rli[16];
#pragma unroll
  for (int r = 0; r < 16; ++r) rli[r] = __builtin_amdgcn_rcpf(li_l[crow(r, hi)]);
  int l2 = __builtin_amdgcn_mbcnt_hi(~0u, __builtin_amdgcn_mbcnt_lo(~0u, 0u)); asm volatile("" : "+v"(l2));
  const int r32b = l2 & 31, hib = l2 >> 5;
  bf16* Ow = Ob + (long)(wid * QBLK) * LDO;
#pragma unroll
  for (int r = 0; r < 16; ++r) { int orow = crow(r, hib);
    _Pragma("unroll") for (int d0 = 0; d0 < 4; ++d0) Ow[(long)orow * LDO + d0 * 32 + r32b] = __float2bfloat16(o[d0][r] * rli[r]); }
  __syncthreads();
#undef LD8
#undef SLOAD
#undef SWRITE
#undef SWAIT
#undef RESC
}
#undef SBAR
}

#define XB_TMO      128
#define XB_XCNT(j)  (256  + 64 * (j))
#define XB_XSUB(j)  (1280 + 64 * (j))
#define XB_XGEN(j)  (2304 + 64 * (j))
#define XB_TOP      3328
#define XB_TOPGEN   3392
#define XCD_BAR_WORDS 3456
#define XB_SPIN_CAP (1u << 18)
__device__ __forceinline__ unsigned xb_ld(unsigned* p)              { return __hip_atomic_load(p, __ATOMIC_RELAXED, __HIP_MEMORY_SCOPE_AGENT); }
__device__ __forceinline__ unsigned xb_add(unsigned* p, unsigned v) { return __hip_atomic_fetch_add(p, v, __ATOMIC_RELAXED, __HIP_MEMORY_SCOPE_AGENT); }
__device__ __forceinline__ unsigned xb_xcc_id() { return (unsigned)__builtin_amdgcn_s_getreg((3 << 11) | 20) & 0xFu; }
#define XB_SPIN(cond, bar) do { unsigned _sp = 0; while (cond) { __builtin_amdgcn_s_sleep(1); \
    if ((++_sp & 255u) == 0u) { if (xb_ld(&(bar)[XB_TMO])) break; if (_sp > XB_SPIN_CAP) { atomicAdd(&(bar)[XB_TMO], 1u); break; } } } } while (0)
struct XcdBarrier { unsigned* bar; unsigned x; volatile LAS unsigned* st; };
__device__ __forceinline__ XcdBarrier xcd_barrier_post(unsigned* bar, volatile LAS unsigned* st) {
    XcdBarrier b; b.bar = bar; b.x = xb_xcc_id(); b.st = st;
    if (threadIdx.x == 0) (void)xb_add(&bar[XB_XCNT(b.x)], 1u);
    return b;
}
__device__ __forceinline__ void xcd_barrier_complete(unsigned* bar, unsigned x, unsigned& nloc, unsigned& nx) {
    const unsigned G = gridDim.x * gridDim.y * gridDim.z;
    unsigned sum, cnt, mine, sp = 0u;
    for (;;) {
        sum = 0u; cnt = 0u; mine = 0u;
#pragma unroll
        for (unsigned j = 0; j < 16; ++j) { const unsigned c = xb_ld(&bar[XB_XCNT(j)]); sum += c; cnt += (c > 0u) ? 1u : 0u; mine = (j == x) ? c : mine; }
        if (sum == G) break;
        __builtin_amdgcn_s_sleep(1);
        if ((++sp & 255u) == 0u) { if (xb_ld(&bar[XB_TMO])) break; if (sp > XB_SPIN_CAP) { atomicAdd(&bar[XB_TMO], 1u); break; } }
    }
    nloc = mine > 0u ? mine : 1u; nx = cnt > 0u ? cnt : 1u;
}
__device__ __forceinline__ void xcd_barrier(const XcdBarrier& b) {
    asm volatile("s_waitcnt vmcnt(0)" ::: "memory");
    __syncthreads();
    if (threadIdx.x == 0) {
        unsigned* bar = b.bar;
        __builtin_amdgcn_s_waitcnt(0);
        unsigned nloc = b.st[0], nx = b.st[1];
        if (nloc == 0u) { xcd_barrier_complete(bar, b.x, nloc, nx); b.st[0] = nloc; b.st[1] = nx; }
        const unsigned old = xb_add(&bar[XB_XSUB(b.x)], 1u);
        const unsigned gen = old / nloc;
        if (old + 1u == (gen + 1u) * nloc) {
            __builtin_amdgcn_fence(__ATOMIC_RELEASE, "agent");
            asm volatile("s_waitcnt vmcnt(0)" ::: "memory");
            const unsigned og = xb_add(&bar[XB_TOP], 1u);
            const unsigned tg = og / nx;
            if (og + 1u == (tg + 1u) * nx) xb_add(&bar[XB_TOPGEN], 1u);
            else XB_SPIN(xb_ld(&bar[XB_TOPGEN]) == tg, bar);
            __builtin_amdgcn_fence(__ATOMIC_ACQUIRE, "agent");
            xb_add(&bar[XB_XGEN(b.x)], 1u);
            asm volatile("s_waitcnt vmcnt(0)" ::: "memory");
        } else {
            XB_SPIN(xb_ld(&bar[XB_XGEN(b.x)]) == gen, bar);
            __builtin_amdgcn_fence(__ATOMIC_ACQUIRE, "agent");
            asm volatile("s_waitcnt vmcnt(0)" ::: "memory");
        }
    }
    __syncthreads();
}

struct Params {
    const float *x, *c, *ctx, *c_ctx, *w_ada, *b_ada, *norm_ffn1, *w_ffn1_in, *w_ffn1_out, *norm_mix, *w_in, *q_norm, *k_norm, *w_ab, *w_fb, *w_out, *norm_ffn2, *w_ffn2_in, *w_ffn2_out;
    float* out; unsigned char* ws; int st_lo, st_hi;
};

__device__ __forceinline__ void transpose_item(const float* __restrict__ W, int K, int N, bf16_t* __restrict__ WT, int kb, int n0, int drow0, int lane, int ldd = 0) {
    if (ldd == 0) ldd = K;
    const int ng = lane & 15, kq = lane >> 4, k0 = 32 * kb + 8 * kq;
    const float* src = W + (size_t)k0 * N + n0 + 4 * ng;
    f32x4 v[8];
#pragma unroll
    for (int i = 0; i < 8; ++i) v[i] = __builtin_nontemporal_load((const f32x4*)(src + (size_t)i * N));
    bf16_t* dst = WT + (size_t)(drow0 + 4 * ng) * ldd + k0;
#pragma unroll
    for (int j = 0; j < 4; ++j) { u32x4 o; o.x = cvt_pk_bf16(v[0][j], v[1][j]); o.y = cvt_pk_bf16(v[2][j], v[3][j]); o.z = cvt_pk_bf16(v[4][j], v[5][j]); o.w = cvt_pk_bf16(v[6][j], v[7][j]);
        *(u32x4*)(dst + (size_t)j * ldd) = o; }
}

__device__ __forceinline__ void prep_phase(const Params& kp_, LAS unsigned char* lds, int tid, int lane, int wave, int G) {
    const Params* kp = &kp_; unsigned char* ws = kp->ws;
    LAS float* tab2048 = (LAS float*)(lds + LDS_MISC);
    LAS float* tab128 = (LAS float*)(lds + LDS_MISC + 8192);
    if (blockIdx.x < 144) {
        LAS float* s_l = (LAS float*)lds;
        LAS float* red = (LAS float*)(lds + 36864);
        for (int i = tid; i < 9216; i += 512) { const int r = i >> 10, k = i & 1023; const float v = (r < 8) ? kp->c[r * 1024 + k] : kp->c_ctx[k]; s_l[i] = v / (1.f + expf(-v)); }
        __syncthreads();
        const int c0 = blockIdx.x * 64, kr = lane >> 4, cgp = lane & 15;
        f32x4 a0 = {}, a1 = {}, a2 = {}, a3 = {}, a4 = {}, a5 = {}, a6 = {}, a7 = {}, a8 = {};
        const float* wp = kp->w_ada + (size_t)(wave * 128 + kr) * NMOD + c0 + 4 * cgp;
#pragma unroll 8
        for (int i = 0; i < 32; ++i) { const f32x4 w = __builtin_nontemporal_load((const f32x4*)(wp + (size_t)i * 4 * NMOD)); const int k = wave * 128 + 4 * i + kr;
            a0 += w * s_l[k]; a1 += w * s_l[1024 + k]; a2 += w * s_l[2048 + k]; a3 += w * s_l[3072 + k]; a4 += w * s_l[4096 + k];
            a5 += w * s_l[5120 + k]; a6 += w * s_l[6144 + k]; a7 += w * s_l[7168 + k]; a8 += w * s_l[8192 + k]; }
#define RED9(a, r) do { _Pragma("unroll") for (int e = 0; e < 4; ++e) { float v = a[e]; v += __shfl_xor(v, 16); v += __shfl_xor(v, 32); if (lane < 16) red[(wave * 9 + r) * 64 + 4 * cgp + e] = v; } } while (0)
        RED9(a0, 0); RED9(a1, 1); RED9(a2, 2); RED9(a3, 3); RED9(a4, 4); RED9(a5, 5); RED9(a6, 6); RED9(a7, 7); RED9(a8, 8);
#undef RED9
        __syncthreads();
        float* mod = (float*)(ws + WS_MOD);
        for (int i = tid; i < 576; i += 512) { const int r = i >> 6, col = i & 63; float s = 0.f;
#pragma unroll
            for (int w = 0; w < 8; ++w) s += red[(w * 9 + r) * 64 + col];
            mod[r * NMOD + c0 + col] = s + kp->b_ada[c0 + col]; }
    }
    __syncthreads();
    const int gw = blockIdx.x * 8 + wave, NGW = G * 8;
    if (blockIdx.x == G - 1) {
        float* rt = (float*)(ws + WS_ROPE);
        for (int i = tid; i < 2048; i += 512) { const int pos = i >> 5, j = i & 31; const float invf = powf(10000.0f, -(float)(2 * j) / 64.0f); const float ang = (float)pos * invf;
            rt[2 * i] = cosf(ang); rt[2 * i + 1] = sinf(ang); }
    }
    constexpr int I_1IN = 32 * 88;
    for (int r = (gw + 1152) % NGW; r < I_1IN; r += NGW) { const int kb = r / 88, n0 = (r % 88) * 64; const int isup = n0 >= DFF, j = isup ? n0 - DFF : n0;
        transpose_item(kp->w_ffn1_in, 1024, 2 * DFF, (bf16_t*)(ws + WS_W1IN), kb, n0, 256 * (j >> 7) + (j & 127) + 128 * isup, lane); }
}

__device__ __forceinline__ void late_weights(const Params& kp_, LAS unsigned char* lds, int tid, int lane, int widx, int nw, int part) {
    const Params* kp = &kp_; unsigned char* ws = kp->ws;
    LAS float* tab2048 = (LAS float*)(lds + LDS_MISC);
    LAS float* tab128 = (LAS float*)(lds + LDS_MISC + 8192);
    for (int i = tid; i < 2048; i += 512) tab2048[i] = cospif((float)i * (1.0f / 1024.0f));
    if (tid < 128) tab128[tid] = cospif((float)tid * (1.0f / 64.0f));
    __syncthreads();
    constexpr int I_FOLD = 1024, I_IN = 32 * 64, I_AB = 32 * 16, I_FB = 16 * 16, I_O = 32 * 16, I_1OUT = 88 * 16;
    if (part != 1) for (int r = widx; r < I_1OUT; r += nw) { const int kb = r >> 4, n0 = (r & 15) * 64; transpose_item(kp->w_ffn1_out, DFF, 1024, (bf16_t*)(ws + WS_W1OUT), kb, n0, n0, lane); }
    if (part == 0) return;
    {
        bf16_t* dft = (bf16_t*)(ws + WS_DFT);
        for (int e8 = widx * 64 + lane; e8 < 1024 * 512; e8 += nw * 64) {
            const int k = e8 >> 9, kp0 = (e8 & 511) * 8, cs = kp0 >> 11, n0 = kp0 & 2047; float v[8];
#pragma unroll
            for (int e = 0; e < 8; ++e) { int idx = (k * (n0 + e)) & 2047; if (cs) idx = (idx + 512) & 2047; v[e] = tab2048[idx] * (1.0f / 512.0f); }
            u32x4 o; o.x = cvt_pk_bf16(v[0], v[1]); o.y = cvt_pk_bf16(v[2], v[3]); o.z = cvt_pk_bf16(v[4], v[5]); o.w = cvt_pk_bf16(v[6], v[7]);
            *(u32x4*)(dft + (size_t)e8 * 8) = o;
        }
    }
    for (int r = widx; r < I_FOLD; r += nw) {
        const int jt = r & 7, g = (r >> 3) & 3, kb = r >> 5, k0 = kb * 32;
        const int jj = jt * 32 + (lane & 31), cs = jj >> 7, m = jj & 127, hi = lane >> 5;
        const float* wrow = kp->w_in + (size_t)(k0 + (lane & 31)) * 4096 + 1536 + g * 128 + hi;
        f32x16 acc = {};
#pragma unroll 8
        for (int s2 = 0; s2 < 64; ++s2) { const int c = 2 * s2 + hi; const float a = wrow[2 * s2]; int idx = (c * m) & 127; if (cs) idx = (idx + 96) & 127;
            acc = __builtin_amdgcn_mfma_f32_32x32x2f32(a, tab128[idx], acc, 0, 0, 0); }
        bf16_t* WfT = (bf16_t*)(ws + WS_WF) + (size_t)(cs * 512 + g * 128 + m) * 1024 + k0 + 4 * hi;
#pragma unroll
        for (int q = 0; q < 4; ++q) { u32x2 o; o.x = cvt_pk_bf16(acc[4 * q], acc[4 * q + 1]); o.y = cvt_pk_bf16(acc[4 * q + 2], acc[4 * q + 3]); *(u32x2*)(WfT + 8 * q) = o; }
    }
    for (int r = widx; r < I_IN; r += nw) { const int kb = r >> 6, n0 = (r & 63) * 64; if (n0 < 1536 || n0 >= 2048) transpose_item(kp->w_in, 1024, 4096, (bf16_t*)(ws + WS_WIN), kb, n0, n0 < 1536 ? n0 : n0 - 512, lane); }
    for (int r = widx; r < I_AB; r += nw) { const int kb = r >> 4, n0 = (r & 15) * 64; transpose_item(kp->w_ab, 1024, 1024, (bf16_t*)(ws + WS_WAB), kb, n0, n0, lane); }
    for (int r = widx; r < I_O; r += nw) { const int kb = r >> 4, n0 = (r & 15) * 64; transpose_item(kp->w_out, 1024, 1024, (bf16_t*)(ws + WS_WO), kb, n0, n0, lane); }
}

template <bool LAT_BF> __device__ __forceinline__ void norm_phase(const float* lat, const float* ctxp, const float* ctxp2, int nrows, const float* gain, const float* mod, int sh_off, int sc_off, bf16_t* A, int gw, int NGW, int lane) {
    for (int r = gw; r < nrows; r += NGW) {
        const bool isctx = r >= NLAT; const float* src = isctx ? ctxp + (size_t)(r - NLAT) * DM : lat + (size_t)r * DM; const int mrow = isctx ? 8 : (r >> 11);
        f32x4 v[4]; float ss = 0.f;
#pragma unroll
        for (int j = 0; j < 4; ++j) { if (LAT_BF && !isctx) { const u32x2 w = __builtin_nontemporal_load((const u32x2*)((const bf16_t*)lat + (size_t)r * DM + 4 * lane + 256 * j)); v[j] = (f32x4){__uint_as_float(w.x << 16), __uint_as_float(w.x & 0xffff0000u), __uint_as_float(w.y << 16), __uint_as_float(w.y & 0xffff0000u)}; } else v[j] = __builtin_nontemporal_load((const f32x4*)(src + 4 * lane + 256 * j)); if (isctx && ctxp2) v[j] += *(const f32x4*)(ctxp2 + (size_t)(r - NLAT) * DM + 4 * lane + 256 * j); ss += (v[j][0] * v[j][0] + v[j][1] * v[j][1]) + (v[j][2] * v[j][2] + v[j][3] * v[j][3]); }
        const float rstd = 1.0f / sqrtf(wave_sum(ss) * (1.0f / DM) + EPS);
        const float* mp = mod + mrow * NMOD;
#pragma unroll
        for (int j = 0; j < 4; ++j) { const int c = 4 * lane + 256 * j; const f32x4 g = *(const f32x4*)(gain + c), sh = *(const f32x4*)(mp + sh_off + c), sc = *(const f32x4*)(mp + sc_off + c);
            const f32x4 o = (v[j] * rstd) * g * (sc + 1.0f) + sh; u32x2 w; w.x = cvt_pk_bf16(o[0], o[1]); w.y = cvt_pk_bf16(o[2], o[3]);
            *(u32x2*)(A + (size_t)r * DM + c) = w; }
    }
}

__device__ __forceinline__ void fix_head(bf16_t* hp, const float* g, const float* ropetab, int n, bool rope, int lane) {
    float t1 = bf2f(hp[lane]), t2 = bf2f(hp[lane + 64]);
    const float rstd = 1.0f / sqrtf(wave_sum(t1 * t1 + t2 * t2) * (1.0f / 128.0f) + EPS);
    t1 = t1 * rstd * g[lane]; t2 = t2 * rstd * g[lane + 64];
    float o1 = t1, o2 = t2;
    if (rope) { const int pos = lane < 32 ? (n >> 6) : (n & 63); const float c = ropetab[2 * (pos * 32 + (lane & 31))], s = ropetab[2 * (pos * 32 + (lane & 31)) + 1]; o1 = t1 * c - t2 * s; o2 = t2 * c + t1 * s; }
    hp[lane] = f2bf(o1); hp[lane + 64] = f2bf(o2);
}
__device__ __forceinline__ void fixup_phase(unsigned char* ws, const float* q_norm, const float* k_norm, int gw, int NGW, int lane) {
    bf16_t* Q = (bf16_t*)(ws + WS_Q); bf16_t* Kb = (bf16_t*)(ws + WS_K); const float* rt = (const float*)(ws + WS_ROPE);
    for (int r = gw; r < NTOK; r += NGW) {
        if (r < NLAT) { const int b = r >> 11, n = r & 2047;
            for (int h = 0; h < 8; ++h) fix_head(Q + (size_t)r * DM + h * 128, q_norm, rt, n, true, lane);
            for (int h = 0; h < 2; ++h) fix_head(Kb + (size_t)(b * SKV + CTXL + n) * 256 + h * 128, k_norm, rt, n, true, lane);
        } else { const int rc = r - NLAT, b = rc >> 8, n = rc & 255;
            for (int h = 0; h < 2; ++h) fix_head(Kb + (size_t)(b * SKV + n) * 256 + h * 128, k_norm, rt, 0, false, lane); }
    }
}

constexpr int NSTEPS = 15;
__host__ __device__ constexpr bool sync_after(int st) { return !(st == 7 || st == 9); }

__global__ void __launch_bounds__(512, 2) mk_fwd(Params p) {
    extern __shared__ __attribute__((aligned(16))) unsigned char lds_raw[];
    LAS unsigned char* lds = (LAS unsigned char*)lds_raw;
    const int G = gridDim.x, c = blockIdx.x, NGW = G * 8;
    const int lo = p.st_lo, hi = p.st_hi;
    unsigned char* const ws = p.ws;
    const float* const mod = (const float*)(ws + WS_MOD);
    bf16_t* const Abuf = (bf16_t*)(ws + WS_A);
#define IN(k) (lo <= (k) && (k) < hi)
    volatile LAS unsigned* bst = (volatile LAS unsigned*)(lds + LDS_MISC + 12288);
    if (threadIdx.x < 2) bst[threadIdx.x] = 0u;
    __syncthreads();
    XcdBarrier gbar; gbar.bar = (unsigned*)(ws + WS_BAR); gbar.x = 0; gbar.st = bst;
    if (hi - lo > 1) gbar = xcd_barrier_post((unsigned*)(ws + WS_BAR), bst);
    if (hi < 0) cg::this_grid().sync();
#define SEAM(k) do { if (IN(k) && IN((k) + 1)) { if (sync_after(k)) xcd_barrier(gbar); else { __syncthreads(); } } } while (0)
#define TIDS() int tid = threadIdx.x; asm volatile("" : "+v"(tid)); const int lane = tid & 63, wave = __builtin_amdgcn_readfirstlane(tid >> 6), gw = c * 8 + wave; (void)lane; (void)gw
#define GEMM1P(PRM, KK, a, b, nm, nn, kd, rm) do { const pg8::Sched S{(a), nullptr, nullptr, (b), nullptr, nullptr, (nm), 1, 1, (nn), 1, 1, (kd), (kd), (kd), (nm) * (nn), 0, 0, G, c, (KK), 0, (KK) / 64, (KK) / 64, (KK) / 64, 0, 0}; \
        const pg8::Epi E{ws, p.out, p.x, p.ctx, (rm), p.k_norm, p.norm_ffn2, (const LAS float*)(lds + LDS_MISC)}; pg8::gemm_phase<true, true, PRM>(lds, S, E, tid); } while (0)
#define GEMM1(KK, a, b, nm, nn, kd, rm) GEMM1P(true, KK, a, b, nm, nn, kd, rm)
    if (IN(0)) { TIDS(); prep_phase(p, lds, tid, lane, wave, G); }
    SEAM(0);
    if (IN(1)) { TIDS(); norm_phase<false>(p.x, p.ctx, nullptr, NTOK, p.norm_ffn1, mod, 0 * DM, 1 * DM, Abuf, gw, NGW, lane); }
    SEAM(1);
    if (IN(2)) { TIDS(); GEMM1(1024, Abuf, (const bf16_t*)(ws + WS_W1IN), NTOK / 256, 22, pg8::K_SWIGLU, 0);
        constexpr int NBUSY = (NTOK / 256) * 22 - 6 * 256;
        int t2 = threadIdx.x; asm volatile("" : "+v"(t2)); const int w2 = __builtin_amdgcn_readfirstlane(t2 >> 6);
        if (G == 256 && c >= NBUSY) late_weights(p, lds, t2, t2 & 63, (c - NBUSY) * 8 + w2, (256 - NBUSY) * 8, 0);
        else if (G != 256) late_weights(p, lds, t2, t2 & 63, c * 8 + w2, NGW, 2); }
    SEAM(2);
    if (IN(3)) { TIDS();
        const bf16_t* Hc = (const bf16_t*)(ws + WS_H) + (size_t)NLAT * DFF;
        const pg8::Sched S{(const bf16_t*)(ws + WS_H), Hc, Hc, (const bf16_t*)(ws + WS_W1OUT), (const bf16_t*)(ws + WS_W1OUT), (const bf16_t*)(ws + WS_W1OUT),
                           64, 8, 8, 4, 4, 4, pg8::K_RES, pg8::K_RESC0, pg8::K_RESC1, 256, 32, 32, G, c, DFF, 0, 44, 22, 22, 0, DFF / 2};
        const pg8::Epi E{ws, p.out, p.x, p.ctx, 0, p.k_norm, p.norm_ffn2, (const LAS float*)(lds + LDS_MISC)}; pg8::gemm_phase<true, true>(lds, S, E, tid);
        if (G == 256 && c >= 64) {
            int t2 = threadIdx.x; asm volatile("" : "+v"(t2)); const int w2 = __builtin_amdgcn_readfirstlane(t2 >> 6);
            late_weights(p, lds, t2, t2 & 63, (c - 64) * 8 + w2, 192 * 8, 1); } }
    SEAM(3);
    if (IN(4)) { TIDS(); norm_phase<true>(p.out, (const float*)(ws + WS_CTX1), (const float*)(ws + WS_CTX1B), NTOK, p.norm_mix, mod, 3 * DM, 4 * DM, Abuf, gw, NGW, lane); }
    SEAM(4);
    if (IN(5)) { TIDS();
        const pg8::Sched S{Abuf, (const bf16_t*)(ws + WS_WF), Abuf + (size_t)NLAT * DM, (const bf16_t*)(ws + WS_WIN), Abuf, (const bf16_t*)(ws + WS_WIN) + (size_t)1024 * DM,
                           64, 4, 8, 14, 64, 2, pg8::K_INPROJ, pg8::K_FTSWAP, pg8::K_CTXKV, 64 * 14, 256, 16, G, c, 1024, 0, 16, 16, 16, 0, 0};
        const pg8::Epi E{ws, p.out, p.x, p.ctx, 0, p.k_norm, p.norm_ffn2, (const LAS float*)(lds + LDS_MISC)}; pg8::gemm_phase<true, true>(lds, S, E, tid);
        if (G == 256 && c >= 144) {
            int t2 = threadIdx.x; asm volatile("" : "+v"(t2)); const int lane = t2 & 63;
            const int w2 = (c - 144) * 8 + __builtin_amdgcn_readfirstlane(t2 >> 6), nw2 = 112 * 8;
            for (int r = w2; r < 32 * 88; r += nw2) { const int kb = r / 88, n0 = (r % 88) * 64; const int isup = n0 >= DFF, j = isup ? n0 - DFF : n0;
                transpose_item(p.w_ffn2_in, 1024, 2 * DFF, (bf16_t*)(ws + WS_W2IN), kb, n0, 256 * (j >> 7) + (j & 127) + 128 * isup, lane); }
            for (int r = w2; r < 88 * 16; r += nw2) { const int kb = r >> 4, n0 = (r & 15) * 64; transpose_item(p.w_ffn2_out, DFF, 1024, (bf16_t*)(ws + WS_W2OUT), kb, n0, n0, lane); }
            for (int r = w2; r < 16 * 16; r += nw2) { const int hf = 0, q = r & 255, kb = q >> 4, n0 = (q & 15) * 64;
                transpose_item(p.w_fb, 512, 1024, (bf16_t*)(ws + WS_WFB2) + hf * 512, kb, n0, n0, lane, 1024); }
        } }
    if (IN(5) && IN(7)) xcd_barrier(gbar);
    if (IN(7)) { TIDS();
        const pg8::Sched S{(const bf16_t*)(ws + WS_DFT), nullptr, nullptr, (const bf16_t*)(ws + WS_FT), nullptr, nullptr, 4, 1, 1, 16, 1, 1, pg8::K_FOUR2, pg8::K_FOUR2, pg8::K_FOUR2, 256, 0, 0, G, c, 4096, 1, 16, 16, 16, 0, 0};
        const pg8::Epi E{ws, p.out, p.x, p.ctx, 0, p.k_norm, p.norm_ffn2, (const LAS float*)(lds + LDS_MISC)}; pg8::gemm_phase<true, true>(lds, S, E, tid);
        if (c < 192) {
        {
            const bf16_t* FTp = (const bf16_t*)(ws + WS_FT); bf16_t* YFp = (bf16_t*)(ws + WS_YF);
            for (int j = gw; j < 4096; j += 192 * 8) { const bf16_t* src = FTp + (size_t)j * 4096 + 32 * lane; float acc_ = 0.f;
#pragma unroll
                for (int q4 = 0; q4 < 4; ++q4) { f32x4 a0, a1; unpack8(*(const u32x4*)(src + 8 * q4), a0, a1); acc_ += (a0[0] - a0[1]) + (a0[2] - a0[3]) + (a1[0] - a1[1]) + (a1[2] - a1[3]); }
                const float tot = wave_sum(acc_) * (1.0f / 512.0f);
                if (lane == 0) YFp[(size_t)((j >> 9) * SEQ + 1024) * 1024 + (j & 511)] = f2bf(tot); }
        }
        {
            int t2 = threadIdx.x; asm volatile("" : "+v"(t2)); const int ln = t2 & 63, wv = __builtin_amdgcn_readfirstlane(t2 >> 6);
            const bf16_t* W2 = (const bf16_t*)(ws + WS_W2IN); float* sw3 = (float*)(ws + WS_SW3);
            for (int n = c * 8 + wv; n < 2 * DFF; n += 192 * 8) {
                const u32x4 w0 = *(const u32x4*)(W2 + (size_t)n * DM + 8 * ln), w1 = *(const u32x4*)(W2 + (size_t)n * DM + 512 + 8 * ln);
                f32x4 a0, a1, a2, a3; unpack8(w0, a0, a1); unpack8(w1, a2, a3);
#pragma unroll
                for (int b = 0; b < 8; ++b) { const float* sh = mod + b * NMOD + 6 * DM + 8 * ln;
                    const f32x4 s0 = *(const f32x4*)sh, s1 = *(const f32x4*)(sh + 4), s2 = *(const f32x4*)(sh + 512), s3 = *(const f32x4*)(sh + 516);
                    const f32x4 pr = a0 * s0 + a1 * s1 + a2 * s2 + a3 * s3; const float d = wave_sum((pr[0] + pr[1]) + (pr[2] + pr[3]));
                    if (ln == 0) sw3[b * (2 * DFF) + n] = d; }
            }
        }
        } }
    SEAM(7);
    if (IN(8)) { TIDS();
        const int x = c & 7, s = c >> 3; const int j0 = 2 * s; int nj = 2; asm volatile("" : "+s"(nj));
#pragma unroll 1
        for (int i = 0; i < nj; ++i) { const int j = j0 + i, kvh = j >> 5, h = kvh * 4 + ((j >> 3) & 3), qb = j & 7;
            att::bf16* Qb = (att::bf16*)(ws + WS_Q) + (size_t)(x * SEQ + qb * 256) * DM + h * 128;
            const att::bf16* Kh = (const att::bf16*)(ws + WS_K) + (size_t)x * SKV * 256 + kvh * 128;
            const att::bf16* Vh = (const att::bf16*)(ws + WS_V) + (size_t)x * SKV * 256 + kvh * 128;
            const int tu = tid;
            att::attn_unit(Qb, Kh, Vh, Qb, SKV, (char*)lds_raw, tu, p.q_norm, (const float*)(ws + WS_ROPE), qb * 256); }
    }
    SEAM(8);
    if (IN(9)) { TIDS();
        const pg8::Sched S{(const bf16_t*)(ws + WS_Q), (const bf16_t*)(ws + WS_YF), nullptr, (const bf16_t*)(ws + WS_WAB), (const bf16_t*)(ws + WS_WFB2), nullptr,
                           64, 64, 1, 4, 4, 1, pg8::K_BRA, pg8::K_BRB, pg8::K_BRB, 256, 256, 0, G, c, 1024, 2, 16, 8, 16, 0, 0};
        const pg8::Epi E{ws, p.out, p.x, p.ctx, 0, p.k_norm, p.norm_ffn2, (const LAS float*)(lds + LDS_MISC)}; pg8::gemm_phase<true, true>(lds, S, E, tid); }
    SEAM(9);
    SEAM(10);
    if (IN(11)) { TIDS(); GEMM1(1024, (const bf16_t*)(ws + WS_GA), (const bf16_t*)(ws + WS_WO), 64, 4, pg8::K_RES, 1); }
    if (IN(11) && IN(13)) xcd_barrier(gbar);
    if (IN(13)) { TIDS();
        {
            LAS float* rs = (LAS float*)(lds + LDS_MISC); const float* st3 = (const float*)(ws + WS_ST3) + (size_t)(c & 7) * 2048 * 16;
            for (int r = tid; r < 2048; r += 512) { const f32x4* sp = (const f32x4*)(st3 + (size_t)r * 16); const f32x4 q = (sp[0] + sp[1]) + (sp[2] + sp[3]);
                rs[r] = 1.0f / sqrtf(((q[0] + q[1]) + (q[2] + q[3])) * (1.0f / DM) + EPS); }
            __syncthreads();
        }
        GEMM1(1024, Abuf, (const bf16_t*)(ws + WS_W2IN), 64, 22, pg8::K_SWIGLU, 3); }
    SEAM(13);
    if (IN(14)) { TIDS(); GEMM1(DFF, (const bf16_t*)(ws + WS_H), (const bf16_t*)(ws + WS_W2OUT), 64, 4, pg8::K_RES, 2); }
#undef IN
#undef SEAM
#undef TIDS
#undef GEMM1
#undef GEMM1P
}

extern "C" void kernel_launch(void* const* d_in, const int* in_sizes, int n_in, void* d_out, int out_size, void* d_ws, size_t ws_size, hipStream_t stream) {
    static int grid = 0;
    if (grid == 0) {
        if (n_in != 19 || out_size != NLAT * DM || ws_size < WS_END) { fprintf(stderr, "kernel_launch: unexpected shapes (n_in %d out %d ws %zu)\n", n_in, out_size, ws_size); grid = -1; return; }
        int dev = 0, cus = 0, per_cu = 0;
        hipGetDevice(&dev); hipDeviceGetAttribute(&cus, hipDeviceAttributeMultiprocessorCount, dev);
        if (hipFuncSetAttribute((const void*)mk_fwd, hipFuncAttributeMaxDynamicSharedMemorySize, LDS_BYTES) != hipSuccess) { fprintf(stderr, "kernel_launch: hipFuncSetAttribute failed\n"); grid = -1; return; }
        hipOccupancyMaxActiveBlocksPerMultiprocessor(&per_cu, (const void*)mk_fwd, 512, LDS_BYTES);
        (void)hipGetLastError();
        if (cus != 256 || per_cu < 1) fprintf(stderr, "kernel_launch: note: cus %d per_cu %d (built for 256 x 1)\n", cus, per_cu);
        grid = 256;
    }
    if (grid < 0) return;
    Params p{};
    const float** pp = (const float**)&p;
    for (int i = 0; i < 19; ++i) pp[i] = (const float*)d_in[i];
    p.out = (float*)d_out; p.ws = (unsigned char*)d_ws;
    if (hipMemsetAsync((char*)d_ws + WS_BAR, 0, BAR_BYTES, stream) != hipSuccess) { fprintf(stderr, "kernel_launch: memset failed\n"); return; }
#if MK_MULTI
    int lo = 0;
    for (int st = 0; st < NSTEPS; ++st) {
        if (sync_after(st) || st == NSTEPS - 1) { p.st_lo = lo; p.st_hi = st + 1; hipLaunchKernelGGL(mk_fwd, dim3(grid), dim3(512), LDS_BYTES, stream, p); lo = st + 1; }
    }
#else
    p.st_lo = 0; p.st_hi = NSTEPS;
    void* args[] = {&p};
    hipError_t e = hipLaunchCooperativeKernel((const void*)mk_fwd, dim3(grid), dim3(512), args, LDS_BYTES, stream);
    if (e != hipSuccess) fprintf(stderr, "cooperative launch failed: %s\n", hipGetErrorString(e));
#endif
}
```
